# Optimizing an MI355X kernel written in HIP

```python
import jax
import jax.numpy as jnp
from jax import lax
import numpy as np

D_MODEL = 1024
BATCH = 8
SEQ = 2048
DEPTH = 2

HEAD_DIM = 64
MIX_WIDTH = D_MODEL
GROUP_WIDTH = MIX_WIDTH // 2
N_HEADS = GROUP_WIDTH // HEAD_DIM
CONV_WIDTH = 31
MOBA_BLOCK = 256
MOBA_TOPK = 3
MOBA_Q_CHUNK = 32
NSA_KV_HEADS = 2
NSA_KV_WIDTH = NSA_KV_HEADS * HEAD_DIM
NSA_CMP_LEN = 32
NSA_CMP_STRIDE = 16
NSA_CMP_HIDDEN = 256
NSA_SEL_BLOCK = 64
NSA_TOPN = 16
NSA_WINDOW = 512
NSA_Q_CHUNK = 64
NSA_FORCE = 1e4
SWA_KV_HEADS = 2
SWA_KV_WIDTH = SWA_KV_HEADS * HEAD_DIM
SWA_WINDOW = 128
BAND_Q_BLOCK = 128
EPS = 1e-6
NEG = -1e30
TINY = 1e-30

EVEN_SIZES = (GROUP_WIDTH, GROUP_WIDTH, GROUP_WIDTH, GROUP_WIDTH, GROUP_WIDTH, GROUP_WIDTH, GROUP_WIDTH)
ODD_SIZES = (GROUP_WIDTH, NSA_KV_WIDTH, NSA_KV_WIDTH, NSA_KV_WIDTH, NSA_KV_WIDTH, NSA_KV_WIDTH,
             NSA_KV_WIDTH, 3 * N_HEADS, GROUP_WIDTH, GROUP_WIDTH, SWA_KV_WIDTH, SWA_KV_WIDTH, GROUP_WIDTH)
EVEN_IN = sum(EVEN_SIZES)
ODD_IN = sum(ODD_SIZES)

kernel_name = 'hybrid_conv_moba_nsa_swa_sink_block'


def _split(t, sizes):
    points = np.cumsum(sizes)[:-1].tolist()
    return jnp.split(t, points, axis=-1)


def _rmsnorm(x, g):
    xf = x.astype(jnp.float32)
    y = xf * lax.rsqrt(jnp.mean(xf * xf, axis=-1, keepdims=True) + EPS)
    return (y * g.astype(jnp.float32)).astype(x.dtype)


def _layernorm(x, g, b):
    xf = x.astype(jnp.float32)
    mu = jnp.mean(xf, axis=-1, keepdims=True)
    xc = xf - mu
    y = xc * lax.rsqrt(jnp.mean(xc * xc, axis=-1, keepdims=True) + EPS)
    return (y * g.astype(jnp.float32) + b.astype(jnp.float32)).astype(x.dtype)


def _split_heads(t, n):
    b, s, _ = t.shape
    return t.reshape(b, s, n, HEAD_DIM).transpose(0, 2, 1, 3)


def _merge_heads(t):
    b, n, s, d = t.shape
    return t.transpose(0, 2, 1, 3).reshape(b, s, n * d)


def _alibi_slopes(n):
    return jnp.asarray(np.power(2.0, -8.0 * np.arange(1, n + 1) / n).astype(np.float32))


def _masked_softmax(s, mask, sink=None):
    s = jnp.where(mask, s, NEG)
    m = jnp.max(s, axis=-1, keepdims=True)
    if sink is not None:
        m = jnp.maximum(m, sink)
    e = jnp.where(mask, jnp.exp(s - m), 0.0)
    den = jnp.sum(e, axis=-1, keepdims=True)
    if sink is not None:
        den = den + jnp.exp(sink - m)
    return e / jnp.maximum(den, TINY)


def _conformer_conv(u_val, u_gate, w_dw, b_dw, ln_g, ln_b):
    c = u_val.shape[-1]
    h = u_val * jax.nn.sigmoid(u_gate)
    h = jnp.pad(h, ((0, 0), (CONV_WIDTH - 1, 0), (0, 0)))
    y = lax.conv_general_dilated(h, w_dw[:, None, :].astype(h.dtype), (1,), 'VALID',
                                 dimension_numbers=('NWC', 'WIO', 'NWC'), feature_group_count=c)
    y = _layernorm(y + b_dw.astype(y.dtype), ln_g, ln_b)
    return jax.nn.silu(y)


def _moba_attention(q, k, v, slopes):
    b, h, s, d = q.shape
    nblk = -(-s // MOBA_BLOCK)
    sp = nblk * MOBA_BLOCK
    padw = ((0, 0), (0, 0), (0, sp - s), (0, 0))
    q, k, v = jnp.pad(q, padw), jnp.pad(k, padw), jnp.pad(v, padw)
    kb = k.reshape(b, h, nblk, MOBA_BLOCK, d)
    vb = v.reshape(b, h, nblk, MOBA_BLOCK, d)
    kmean = jnp.mean(kb.astype(jnp.float32), axis=3)
    n_sel = min(MOBA_TOPK, nblk)
    n_g = n_sel * MOBA_BLOCK
    scale = d ** -0.5
    bi = jnp.arange(b)[:, None, None, None]
    hi = jnp.arange(h)[None, :, None, None]
    offs = jnp.arange(MOBA_BLOCK)
    blk_ids = jnp.arange(nblk)
    sl = slopes[:, None, None]

    def chunk(c):
        t0 = c * MOBA_Q_CHUNK
        own = t0 // MOBA_BLOCK
        qc = lax.dynamic_slice_in_dim(q, t0, MOBA_Q_CHUNK, axis=2)
        tp = t0 + jnp.arange(MOBA_Q_CHUNK)
        gate = jnp.einsum('bhtd,bhnd->bhtn', qc.astype(jnp.float32), kmean)
        gate = jnp.where(blk_ids < own, gate, NEG)
        _, idx = lax.top_k(gate, n_sel)
        ks = kb[bi, hi, idx]
        vs = vb[bi, hi, idx]
        kpos = idx[..., None] * MOBA_BLOCK + offs
        dist = (tp[:, None, None] - kpos).astype(jnp.float32)
        s_sel = jnp.einsum('bhtd,bhtnld->bhtnl', qc, ks).astype(jnp.float32) * scale - sl[..., None] * dist
        m_sel = jnp.broadcast_to((idx < own)[..., None], s_sel.shape)
        k_own = lax.dynamic_index_in_dim(kb, own, axis=2, keepdims=False)
        v_own = lax.dynamic_index_in_dim(vb, own, axis=2, keepdims=False)
        kpos_own = own * MOBA_BLOCK + offs
        dist_own = (tp[:, None] - kpos_own[None, :]).astype(jnp.float32)
        s_own = jnp.einsum('bhtd,bhld->bhtl', qc, k_own).astype(jnp.float32) * scale - sl * dist_own
        m_own = jnp.broadcast_to(dist_own >= 0, s_own.shape)
        scores = jnp.concatenate([s_sel.reshape(b, h, MOBA_Q_CHUNK, n_g), s_own], axis=-1)
        mask = jnp.concatenate([m_sel.reshape(b, h, MOBA_Q_CHUNK, n_g), m_own], axis=-1)
        p = _masked_softmax(scores, mask).astype(v.dtype)
        out = jnp.einsum('bhtm,bhtmd->bhtd', p[..., :n_g], vs.reshape(b, h, MOBA_Q_CHUNK, n_g, d))
        return out + jnp.einsum('bhtl,bhld->bhtd', p[..., n_g:], v_own)

    outs = lax.map(chunk, jnp.arange(sp // MOBA_Q_CHUNK))
    outs = jnp.moveaxis(outs, 0, 2).reshape(b, h, sp, d)
    return outs[:, :, :s]


def _banded_attention(q, k, v, sl, window, sink=None):
    b, g, r, s, d = q.shape
    nq = s // BAND_Q_BLOCK
    span = window + BAND_Q_BLOCK
    padw = ((0, 0), (0, 0), (window, 0), (0, 0))
    kp, vp = jnp.pad(k, padw), jnp.pad(v, padw)
    kidx = jnp.arange(nq)[:, None] * BAND_Q_BLOCK + jnp.arange(span)[None, :]
    kband = kp[:, :, kidx]
    vband = vp[:, :, kidx]
    qb = q.reshape(b, g, r, nq, BAND_Q_BLOCK, d)
    tpos = jnp.arange(s).reshape(nq, BAND_Q_BLOCK)
    kpos = kidx - window
    dist = tpos[:, :, None] - kpos[:, None, :]
    mask = (dist >= 0) & (dist < window) & (kpos[:, None, :] >= 0)
    scores = (jnp.einsum('bgrnqd,bgnkd->bgrnqk', qb, kband).astype(jnp.float32) * d ** -0.5
              - sl[:, :, None, None, None] * dist.astype(jnp.float32))
    sk = None if sink is None else sink.astype(jnp.float32)[:, :, None, None, None]
    p = _masked_softmax(scores, mask, sk)
    out = jnp.einsum('bgrnqk,bgnkd->bgrnqd', p.astype(v.dtype), vband)
    return out.reshape(b, g, r, s, d)


def _compress(x, pos, w1, b1, w2, b2):
    s = x.shape[2]
    n_cmp = (s - NSA_CMP_LEN) // NSA_CMP_STRIDE + 1
    idx = jnp.arange(n_cmp)[:, None] * NSA_CMP_STRIDE + jnp.arange(NSA_CMP_LEN)[None, :]
    blocks = x[:, :, idx] + pos.astype(x.dtype)
    flat = blocks.reshape(blocks.shape[0], blocks.shape[1], n_cmp, NSA_CMP_LEN * x.shape[-1])
    hid = jax.nn.silu(flat @ w1 + b1)
    return hid @ w2 + b2


def _overlap_matrix(n_cmp, nsb):
    start = np.arange(n_cmp)[:, None] * NSA_CMP_STRIDE
    bs = np.arange(nsb)[None, :] * NSA_SEL_BLOCK
    return jnp.asarray(((start < bs + NSA_SEL_BLOCK) & (start + NSA_CMP_LEN > bs)).astype(np.float32))


def _nsa_attention(q, k_cmp, v_cmp, k_slc, v_slc, k_win, v_win, gates, kn_cmp,
                   pos_k, pos_v, kw1, kb1, kw2, kb2, vw1, vb1, vw2, vb2, slopes):
    b, h, s, d = q.shape
    g = k_slc.shape[1]
    r = h // g
    scale = d ** -0.5
    qg = q.reshape(b, g, r, s, d)
    sl = slopes.reshape(g, r)
    tpos = jnp.arange(s)
    kc = _rmsnorm(_compress(k_cmp, pos_k, kw1, kb1, kw2, kb2), kn_cmp)
    vc = _compress(v_cmp, pos_v, vw1, vb1, vw2, vb2)
    n_cmp = kc.shape[2]
    cend = jnp.arange(n_cmp) * NSA_CMP_STRIDE + NSA_CMP_LEN - 1
    dist_c = tpos[:, None] - cend[None, :]
    s_c = (jnp.einsum('bgrtd,bgcd->bgrtc', qg, kc).astype(jnp.float32) * scale
           - sl[:, :, None, None] * dist_c.astype(jnp.float32))
    p_c = _masked_softmax(s_c, dist_c >= 0)
    o_cmp = jnp.einsum('bgrtc,bgcd->bgrtd', p_c.astype(vc.dtype), vc)
    nsb = s // NSA_SEL_BLOCK
    imp = jnp.einsum('bgrtc,cn->bgtn', p_c, _overlap_matrix(n_cmp, nsb))
    blk = jnp.arange(nsb)[None, :]
    cur = (tpos // NSA_SEL_BLOCK)[:, None]
    forced = (blk == 0) | (blk == cur) | (blk == cur - 1)
    imp = jnp.where(forced, NSA_FORCE, imp)
    imp = jnp.where(blk <= cur, imp, NEG)
    n_top = min(NSA_TOPN, nsb)
    _, sel = lax.top_k(imp, n_top)
    kbk = k_slc.reshape(b, g, nsb, NSA_SEL_BLOCK, d)
    vbk = v_slc.reshape(b, g, nsb, NSA_SEL_BLOCK, d)
    bi = jnp.arange(b)[:, None, None, None]
    gi = jnp.arange(g)[None, :, None, None]
    offs = jnp.arange(NSA_SEL_BLOCK)
    n_g = n_top * NSA_SEL_BLOCK

    def chunk(c):
        t0 = c * NSA_Q_CHUNK
        qc = lax.dynamic_slice_in_dim(qg, t0, NSA_Q_CHUNK, axis=3)
        idx = lax.dynamic_slice_in_dim(sel, t0, NSA_Q_CHUNK, axis=2)
        tp = t0 + jnp.arange(NSA_Q_CHUNK)
        ks = kbk[bi, gi, idx]
        vs = vbk[bi, gi, idx]
        kpos = idx[..., None] * NSA_SEL_BLOCK + offs
        dist = (tp[:, None, None] - kpos).astype(jnp.float32)
        sc = (jnp.einsum('bgrtd,bgtnld->bgrtnl', qc, ks).astype(jnp.float32) * scale
              - sl[:, :, None, None, None] * dist[:, :, None])
        mask = jnp.broadcast_to((dist >= 0)[:, :, None], sc.shape)
        p = _masked_softmax(sc.reshape(b, g, r, NSA_Q_CHUNK, n_g), mask.reshape(b, g, r, NSA_Q_CHUNK, n_g))
        return jnp.einsum('bgrtm,bgtmd->bgrtd', p.astype(vs.dtype), vs.reshape(b, g, NSA_Q_CHUNK, n_g, d))

    o_slc = lax.map(chunk, jnp.arange(s // NSA_Q_CHUNK))
    o_slc = jnp.moveaxis(o_slc, 0, 3).reshape(b, g, r, s, d)
    o_win = _banded_attention(qg, k_win, v_win, sl, NSA_WINDOW)
    gt = [jnp.transpose(gates[:, :, i], (0, 2, 1)).reshape(b, g, r, s, 1) for i in range(3)]
    o = gt[0] * o_cmp + gt[1] * o_slc + gt[2] * o_win
    return o.astype(q.dtype).reshape(b, h, s, d)


def setup_inputs(seed: int = 0) -> dict:
    key = jax.random.key(seed)
    keys = iter(jax.random.split(key, 40))
    ne = (DEPTH + 1) // 2
    no = DEPTH // 2

    def nrm(shape, scale):
        return jax.random.normal(next(keys), shape, jnp.float32) * scale

    def gain(shape):
        return 1.0 + nrm(shape, 0.02)

    hd = HEAD_DIM
    flat = NSA_CMP_LEN * hd
    return {
        'x': nrm((BATCH, SEQ, D_MODEL), 1.0),
        'norm_g': gain((DEPTH, D_MODEL)),
        'w_out': nrm((DEPTH, MIX_WIDTH, D_MODEL), MIX_WIDTH ** -0.5),
        'e_w_in': nrm((ne, D_MODEL, EVEN_IN), D_MODEL ** -0.5),
        'a_conv_w': nrm((ne, CONV_WIDTH, GROUP_WIDTH), CONV_WIDTH ** -0.5),
        'a_conv_b': nrm((ne, GROUP_WIDTH), 0.02),
        'a_ln_g': gain((ne, GROUP_WIDTH)),
        'a_ln_b': nrm((ne, GROUP_WIDTH), 0.02),
        'b_qnorm_g': gain((ne, hd)),
        'b_knorm_g': gain((ne, hd)),
        'o_w_in': nrm((no, D_MODEL, ODD_IN), D_MODEL ** -0.5),
        'c_qnorm_g': gain((no, hd)),
        'c_knorm_cmp_g': gain((no, hd)),
        'c_knorm_slc_g': gain((no, hd)),
        'c_knorm_win_g': gain((no, hd)),
        'c_pos_k': nrm((no, NSA_CMP_LEN, hd), 0.02),
        'c_pos_v': nrm((no, NSA_CMP_LEN, hd), 0.02),
        'c_k_w1': nrm((no, flat, NSA_CMP_HIDDEN), flat ** -0.5),
        'c_k_b1': nrm((no, NSA_CMP_HIDDEN), 0.02),
        'c_k_w2': nrm((no, NSA_CMP_HIDDEN, hd), NSA_CMP_HIDDEN ** -0.5),
        'c_k_b2': nrm((no, hd), 0.02),
        'c_v_w1': nrm((no, flat, NSA_CMP_HIDDEN), flat ** -0.5),
        'c_v_b1': nrm((no, NSA_CMP_HIDDEN), 0.02),
        'c_v_w2': nrm((no, NSA_CMP_HIDDEN, hd), NSA_CMP_HIDDEN ** -0.5),
        'c_v_b2': nrm((no, hd), 0.02),
        'd_qnorm_g': gain((no, hd)),
        'd_knorm_g': gain((no, hd)),
        'd_sinks': nrm((no, N_HEADS), 0.5),
    }


def reference(x, norm_g, w_out, e_w_in, a_conv_w, a_conv_b, a_ln_g, a_ln_b, b_qnorm_g, b_knorm_g,
              o_w_in, c_qnorm_g, c_knorm_cmp_g, c_knorm_slc_g, c_knorm_win_g, c_pos_k, c_pos_v,
              c_k_w1, c_k_b1, c_k_w2, c_k_b2, c_v_w1, c_v_b1, c_v_w2, c_v_b2,
              d_qnorm_g, d_knorm_g, d_sinks):
    slopes = _alibi_slopes(N_HEADS)
    bsz, slen, _ = x.shape
    for layer in range(DEPTH):
        h = _rmsnorm(x, norm_g[layer])
        if layer % 2 == 0:
            i = layer // 2
            proj = jnp.einsum('bsd,de->bse', h, e_w_in[i])
            u_val, u_gate, z_a, q_b, k_b, v_b, z_b = _split(proj, EVEN_SIZES)
            y_a = _conformer_conv(u_val, u_gate, a_conv_w[i], a_conv_b[i], a_ln_g[i], a_ln_b[i]) * jax.nn.silu(z_a)
            q = _rmsnorm(_split_heads(q_b, N_HEADS), b_qnorm_g[i])
            k = _rmsnorm(_split_heads(k_b, N_HEADS), b_knorm_g[i])
            v = _split_heads(v_b, N_HEADS)
            y_b = _merge_heads(_moba_attention(q, k, v, slopes)) * jax.nn.silu(z_b)
            y = jnp.concatenate([y_a, y_b], axis=-1)
        else:
            i = layer // 2
            proj = jnp.einsum('bsd,de->bse', h, o_w_in[i])
            (q_c, kc_, vc_, ks_, vs_, kw_, vw_, g_c, z_c, q_d, k_d, v_d, z_d) = _split(proj, ODD_SIZES)
            qc = _rmsnorm(_split_heads(q_c, N_HEADS), c_qnorm_g[i])
            gates = jax.nn.sigmoid(g_c.astype(jnp.float32)).reshape(bsz, slen, 3, N_HEADS)
            o_c = _nsa_attention(
                qc, _split_heads(kc_, NSA_KV_HEADS), _split_heads(vc_, NSA_KV_HEADS),
                _rmsnorm(_split_heads(ks_, NSA_KV_HEADS), c_knorm_slc_g[i]), _split_heads(vs_, NSA_KV_HEADS),
                _rmsnorm(_split_heads(kw_, NSA_KV_HEADS), c_knorm_win_g[i]), _split_heads(vw_, NSA_KV_HEADS),
                gates, c_knorm_cmp_g[i], c_pos_k[i], c_pos_v[i],
                c_k_w1[i], c_k_b1[i], c_k_w2[i], c_k_b2[i], c_v_w1[i], c_v_b1[i], c_v_w2[i], c_v_b2[i], slopes)
            y_c = _merge_heads(o_c) * jax.nn.silu(z_c)
            r = N_HEADS // SWA_KV_HEADS
            qd = _rmsnorm(_split_heads(q_d, N_HEADS), d_qnorm_g[i]).reshape(bsz, SWA_KV_HEADS, r, slen, HEAD_DIM)
            kd = _rmsnorm(_split_heads(k_d, SWA_KV_HEADS), d_knorm_g[i])
            vd = _split_heads(v_d, SWA_KV_HEADS)
            o_d = _banded_attention(qd, kd, vd, slopes.reshape(SWA_KV_HEADS, r), SWA_WINDOW,
                                    d_sinks[i].reshape(SWA_KV_HEADS, r))
            y_d = _merge_heads(o_d.reshape(bsz, N_HEADS, slen, HEAD_DIM)) * jax.nn.silu(z_d)
            y = jnp.concatenate([y_c, y_d], axis=-1)
        x = x + jnp.einsum('bse,ed->bsd', y, w_out[layer]).astype(x.dtype)
    return x
```

```cpp
#include <hip/hip_runtime.h>
#include <stdint.h>
#include <stdio.h>

typedef unsigned short bf16_t;
constexpr int NB = 8, SEQ = 2048, NT = NB * SEQ, DM = 1024;
#define EPSF 1e-6f
#define LOG2E 1.4426950408889634f
#define QSCALE (0.125f * 1.4426950408889634f)

constexpr size_t MiB = 1u << 20;
constexpr size_t WS_CTL = 0, WS_SSQ = 5 * MiB, WS_KMP = 1 * MiB + 512 * 1024, WS_B1P = 1 * MiB + 768 * 1024, WS_GT = 2 * MiB, WS_KC = 4 * MiB, WS_VC = 4 * MiB + 256 * 1024;
constexpr size_t WS_WIN0 = 6 * MiB, WS_WOUT0 = 13 * MiB, WS_WIN1 = 15 * MiB, WS_WOUT1 = 22 * MiB, WS_CW1 = 24 * MiB, WS_CW2 = 26 * MiB;
constexpr size_t WS_XB = 32 * MiB, WS_Y = 64 * MiB;
constexpr size_t WS_G0 = 96 * MiB, WS_ZA = 112 * MiB, WS_QB = 128 * MiB, WS_KB = 144 * MiB, WS_VB = 160 * MiB, WS_ZB = 176 * MiB;
constexpr size_t WS_QC = 96 * MiB, WS_ZC = 112 * MiB, WS_QD = 128 * MiB, WS_ZD = 144 * MiB;
constexpr size_t WS_KCR = 160 * MiB, WS_VCR = 164 * MiB, WS_KS = 168 * MiB, WS_VS = 172 * MiB, WS_KW = 176 * MiB, WS_VW = 180 * MiB, WS_KD = 184 * MiB, WS_VD = 188 * MiB;
constexpr size_t WS_NVTMP = 192 * MiB, WS_END = 200 * MiB;

struct KArgs {
    const float *x, *norm_g, *w_out, *e_w_in, *a_conv_w, *a_conv_b, *a_ln_g, *a_ln_b, *b_qnorm_g, *b_knorm_g, *o_w_in, *c_qnorm_g, *c_knorm_cmp_g, *c_knorm_slc_g,
        *c_knorm_win_g, *c_pos_k, *c_pos_v, *c_k_w1, *c_k_b1, *c_k_w2, *c_k_b2, *c_v_w1, *c_v_b1, *c_v_w2, *c_v_b2, *d_qnorm_g, *d_knorm_g, *d_sinks;
    float* out; unsigned char* ws;
    int ph_lo, ph_hi, flags, pad;
};

__device__ __forceinline__ float bf2f(unsigned v) { return __uint_as_float(v << 16); }
__device__ __forceinline__ unsigned f2bf_u(float f) { unsigned u = __float_as_uint(f); return (u + 0x7fffu + ((u >> 16) & 1u)) >> 16; }
__device__ __forceinline__ bf16_t f2bf(float f) { return (bf16_t)f2bf_u(f); }
__device__ __forceinline__ unsigned pk2(float lo, float hi) { return f2bf_u(lo) | (f2bf_u(hi) << 16); }
__device__ __forceinline__ float fast_silu(float v) { return v * __builtin_amdgcn_rcpf(1.f + __expf(-v)); }
__device__ __forceinline__ float fast_sigmoid(float v) { return __builtin_amdgcn_rcpf(1.f + __expf(-v)); }
struct NvGroup { int col, width, type; const float* gain; float scale; int dkind; void* dst; int ld, idx, col2; };

__device__ __forceinline__ NvGroup nv_group0(const KArgs& P, int gi) {
    NvGroup g; g.gain = nullptr; g.scale = 1.f; g.col2 = 0; g.width = 64;
    const int j = gi & 7;
    switch (gi >> 3) {
    case 0: g.col = 64 * j; g.col2 = 512 + 64 * j; g.type = 4; g.dkind = 0; g.dst = P.ws + WS_G0; g.ld = 512; g.idx = j; break;
    case 1: g.col = 1024 + 64 * j; g.type = 1; g.dkind = 0; g.dst = P.ws + WS_ZA; g.ld = 512; g.idx = j; break;
    case 2: g.col = 1536 + 64 * j; g.type = 2; g.gain = P.b_qnorm_g; g.scale = QSCALE; g.dkind = 1; g.dst = P.ws + WS_QB; g.ld = 8; g.idx = j; break;
    case 3: g.col = 2048 + 64 * j; g.type = 2; g.gain = P.b_knorm_g; g.dkind = 1; g.dst = P.ws + WS_KB; g.ld = 8; g.idx = j; break;
    case 4: g.col = 2560 + 64 * j; g.type = 0; g.dkind = 1; g.dst = P.ws + WS_VB; g.ld = 8; g.idx = j; break;
    default: g.col = 3072 + 64 * j; g.type = 1; g.dkind = 0; g.dst = P.ws + WS_ZB; g.ld = 512; g.idx = j; break;
    }
    return g;
}
__device__ __forceinline__ NvGroup nv_group1(const KArgs& P, int gi) {
    NvGroup g; g.gain = nullptr; g.scale = 1.f; g.col2 = 0; g.width = 64;
    if (gi < 8) { g.col = 64 * gi; g.type = 2; g.gain = P.c_qnorm_g; g.scale = QSCALE; g.dkind = 1; g.dst = P.ws + WS_QC; g.ld = 8; g.idx = gi; return g; }
    gi -= 8;
    if (gi < 12) {
        const int which = gi >> 1, hh = gi & 1;
        g.col = 512 + 128 * which + 64 * hh; g.dkind = 1; g.ld = 2; g.idx = hh;
        g.dst = P.ws + (which == 0 ? WS_KCR : which == 1 ? WS_VCR : which == 2 ? WS_KS : which == 3 ? WS_VS : which == 4 ? WS_KW : WS_VW);
        if (which == 2) { g.type = 2; g.gain = P.c_knorm_slc_g; } else if (which == 4) { g.type = 2; g.gain = P.c_knorm_win_g; } else g.type = 0;
        return g;
    }
    gi -= 12;
    if (gi < 1) { g.col = 1280; g.width = 24; g.type = 3; g.dkind = 2; g.dst = P.ws + WS_GT; g.ld = 32; g.idx = 0; return g; }
    gi -= 1;
    if (gi < 8) { g.col = 1304 + 64 * gi; g.type = 1; g.dkind = 0; g.dst = P.ws + WS_ZC; g.ld = 512; g.idx = gi; return g; }
    gi -= 8;
    if (gi < 8) { g.col = 1816 + 64 * gi; g.type = 2; g.gain = P.d_qnorm_g; g.scale = QSCALE; g.dkind = 1; g.dst = P.ws + WS_QD; g.ld = 8; g.idx = gi; return g; }
    gi -= 8;
    if (gi < 2) { g.col = 2328 + 64 * gi; g.type = 2; g.gain = P.d_knorm_g; g.dkind = 1; g.dst = P.ws + WS_KD; g.ld = 2; g.idx = gi; return g; }
    gi -= 2;
    if (gi < 2) { g.col = 2456 + 64 * gi; g.type = 0; g.dkind = 1; g.dst = P.ws + WS_VD; g.ld = 2; g.idx = gi; return g; }
    gi -= 2;
    g.col = 2584 + 64 * gi; g.type = 1; g.dkind = 0; g.dst = P.ws + WS_ZD; g.ld = 512; g.idx = gi; return g;
}
namespace pg8 {
#define PG8_LAS __attribute__((address_space(3)))
typedef short bf16x8 __attribute__((ext_vector_type(8)));
typedef float f32x4 __attribute__((ext_vector_type(4)));
typedef unsigned u32x4 __attribute__((ext_vector_type(4)));
constexpr int BM = 256, BK = 64, HALF = 128, HTB = HALF * BK * 2  , STAGE_BYTES = 8 * HTB, NXCD = 8, WGM = 8;

__host__ __device__ __forceinline__ int lds_byte(int r, int c) { const int st = (r >> 4) * 2 + (c >> 5), rr = r & 15, cc = c & 31, ob = rr * 64 + cc * 2; return st * 1024 + (ob ^ (((ob >> 9) & 1) << 5)); }
__host__ __device__ __forceinline__ void stage_rc(int b, int& R, int& C) { const int st = b / 1024, sb = b % 1024, swz = sb ^ (((sb >> 9) & 1) << 5); R = (st >> 1) * 16 + swz / 64; C = (st & 1) * 32 + (swz % 64) / 2; }
__host__ __device__ __forceinline__ int perm32(int rho) { const int n = rho >> 4, i = rho & 15; return 8 * (i >> 2) + 4 * n + (i & 3); }

struct Unit { int pm, pn; };
struct Gemm { const bf16_t* A; const bf16_t* Bt; int M, N, K; };

struct StaticOrder {
    int nM, nN, nwg, G, c;
    __host__ __device__ void init(int M, int N, int G_, int c_) { nM = M / BM; nN = N / BM; nwg = nM * nN; G = G_; c = c_; }
    __host__ __device__ bool next(int i, Unit& u) const {
        const long L = (long)i * G + c; if (L >= nwg) return false;
        int wgid = (int)L; { const int q = nwg / NXCD, r = nwg % NXCD, xcd = wgid % NXCD, off = wgid / NXCD; wgid = (xcd < r ? xcd * (q + 1) : r * (q + 1) + (xcd - r) * q) + off; }
        const int nig = WGM * nN, gid = wgid / nig, fm = gid * WGM, gsz = (nM - fm) < WGM ? (nM - fm) : WGM;
        u.pm = fm + ((wgid % nig) % gsz); u.pn = (wgid % nig) / gsz; return true;
    }
    __device__ __forceinline__ void a_ready(const Unit&) const {}
    __device__ __forceinline__ void done(const Unit&) const {}
};

__device__ __forceinline__ unsigned cvt_pk_bf16(float lo, float hi) { unsigned r; asm volatile("v_cvt_pk_bf16_f32 %0, %1, %2" : "=v"(r) : "v"(lo), "v"(hi)); return r; }
template <class Epi, class Sched, bool ALIGN_EPI = false, bool SP2 = false>
__device__ __forceinline__ void gemm_phase(PG8_LAS unsigned char* lds, const Gemm g, const Sched& S, const Epi& E) {
    const int tid = threadIdx.x, wid = __builtin_amdgcn_readfirstlane(tid >> 6), lane = tid & 63, wr = wid >> 2, wc = wid & 3, fr = lane & 15, fq = lane >> 4;
    const int K = g.K, nt = K / BK;
    unsigned voffA[2], voffB[2];
#pragma unroll
    for (int i = 0; i < 2; ++i) { int R, C; stage_rc(tid * 16 + i * 8192, R, C); const int Rb = Epi::PERM ? ((R & ~31) + perm32(R & 31)) : R;
        voffA[i] = (unsigned)(R * K + C) * 2u; voffB[i] = (unsigned)(Rb * K + C) * 2u; }
    const size_t kstep = (size_t)(BK * 2);
    const size_t hstep = (size_t)HALF * K * 2;
    const size_t tstep = 2 * hstep;
    const unsigned ldsw = (unsigned)wid * 1024u;
    const int aoff = lds_byte(wr * 64 + fr, fq * 8), boff = lds_byte(wc * 32 + fr, fq * 8);
#define PG8_SA(b, h) (((b) * 2 + (h)) * HTB)
#define PG8_SB(b, h) ((4 + (b) * 2 + (h)) * HTB)
#define PG8_STAGE(bufoff, gbase, voff) do { _Pragma("unroll") for (int _i = 0; _i < 2; ++_i) \
        __builtin_amdgcn_global_load_lds((const unsigned*)((const char*)(gbase) + (voff)[_i]), (PG8_LAS unsigned*)(lds + (bufoff) + ldsw + _i * 8192), 16, 0, 0); } while (0)
#define PG8_LDA(dst, b, h) do { _Pragma("unroll") for (int m = 0; m < 4; ++m) _Pragma("unroll") for (int k = 0; k < 2; ++k) dst[m][k] = *(const PG8_LAS bf16x8*)(lds + PG8_SA(b, h) + aoff + m * 2048 + k * 1024); } while (0)
#define PG8_LDB(dst, b, h) do { _Pragma("unroll") for (int n = 0; n < 2; ++n) _Pragma("unroll") for (int k = 0; k < 2; ++k) dst[n][k] = *(const PG8_LAS bf16x8*)(lds + PG8_SB(b, h) + boff + n * 2048 + k * 1024); } while (0)
#define PG8_MMA(ai, bj, At, Bt) do { __builtin_amdgcn_s_setprio(1); _Pragma("unroll") for (int m = 0; m < 4; ++m) _Pragma("unroll") for (int n = 0; n < 2; ++n) _Pragma("unroll") for (int k = 0; k < 2; ++k) \
        acc[ai][bj][m][n] = __builtin_amdgcn_mfma_f32_16x16x32_bf16(Bt[n][k], At[m][k], acc[ai][bj][m][n], 0, 0, 0); __builtin_amdgcn_s_setprio(0); } while (0)
#define PG8_WAIT_V(n) asm volatile("s_waitcnt vmcnt(" #n ")" ::: "memory")
#define PG8_WAIT_L(n) asm volatile("s_waitcnt lgkmcnt(" #n ")" ::: "memory")
#define PG8_BAR __builtin_amdgcn_s_barrier()
#define PG8_SCHED __builtin_amdgcn_sched_barrier(0)
    Unit cur, nxt; int ui = 0;
    if (!S.next(0, cur)) return;
    f32x4 acc[2][2][4][2];
#pragma unroll
    for (int a = 0; a < 2; ++a)
#pragma unroll
        for (int b = 0; b < 2; ++b)
#pragma unroll
            for (int m = 0; m < 4; ++m)
#pragma unroll
                for (int n = 0; n < 2; ++n) acc[a][b][m][n] = (f32x4){0.f, 0.f, 0.f, 0.f};
    bf16x8 At[4][2], B0[2][2], B1[2][2];
    const char* cA = (const char*)g.A + (size_t)cur.pm * tstep; const char* cB = (const char*)g.Bt + (size_t)cur.pn * tstep;
    S.a_ready(cur);
    if constexpr (SP2) {
        PG8_STAGE(PG8_SB(0, 0), cB, voffB); PG8_STAGE(PG8_SB(0, 1), cB + hstep, voffB); PG8_STAGE(PG8_SA(0, 0), cA, voffA); PG8_STAGE(PG8_SA(0, 1), cA + hstep, voffA);
        if (wr == 1) PG8_BAR;
        PG8_WAIT_V(2); PG8_BAR;
        PG8_STAGE(PG8_SB(1, 0), cB + kstep, voffB); PG8_STAGE(PG8_SA(1, 0), cA + kstep, voffA); PG8_STAGE(PG8_SB(1, 1), cB + hstep + kstep, voffB);
        PG8_WAIT_V(6); PG8_BAR;
    } else {
        PG8_STAGE(PG8_SB(0, 0), cB, voffB); PG8_STAGE(PG8_SA(0, 0), cA, voffA); PG8_STAGE(PG8_SB(0, 1), cB + hstep, voffB); PG8_STAGE(PG8_SA(0, 1), cA + hstep, voffA);
        if (wr == 1) PG8_BAR;
        PG8_WAIT_V(4); PG8_BAR;
        PG8_STAGE(PG8_SB(1, 0), cB + kstep, voffB); PG8_STAGE(PG8_SA(1, 0), cA + kstep, voffA); PG8_STAGE(PG8_SB(1, 1), cB + hstep + kstep, voffB);
        PG8_WAIT_V(6); PG8_BAR;
    }
    for (;;) {
        const bool has_next = S.next(ui + 1, nxt);
        const char* nA = has_next ? (const char*)g.A + (size_t)nxt.pm * tstep : cA; const char* nB = has_next ? (const char*)g.Bt + (size_t)nxt.pn * tstep : cB;
        for (int t = 0; t < nt; t += 2) {
            const bool last = (t == nt - 2);
            const char* a1 = cA + (size_t)(t + 1) * kstep;
            const char* a2 = last ? nA : cA + (size_t)(t + 2) * kstep; const char* b2 = last ? nB : cB + (size_t)(t + 2) * kstep;
            const char* a3 = a2 + kstep; const char* b3 = b2 + kstep;
            if (last && has_next) S.a_ready(nxt);
            if constexpr (SP2) {
            PG8_LDB(B0, 0, 0); PG8_LDB(B1, 0, 1); PG8_SCHED; PG8_LDA(At, 0, 0); PG8_STAGE(PG8_SA(1, 1), a1 + hstep, voffA);
            PG8_WAIT_V(8); PG8_WAIT_L(0); PG8_BAR; PG8_MMA(0, 0, At, B0); PG8_MMA(0, 1, At, B1); PG8_BAR; PG8_SCHED;
            PG8_LDA(At, 0, 1); PG8_STAGE(PG8_SB(0, 0), b2, voffB); PG8_STAGE(PG8_SB(0, 1), b2 + hstep, voffB); PG8_STAGE(PG8_SA(0, 0), a2, voffA);
            PG8_WAIT_V(8); PG8_WAIT_L(0); PG8_BAR; PG8_MMA(1, 0, At, B0); PG8_MMA(1, 1, At, B1); PG8_BAR; PG8_SCHED;
            PG8_LDB(B0, 1, 0); PG8_LDB(B1, 1, 1); PG8_SCHED; PG8_LDA(At, 1, 0); PG8_STAGE(PG8_SA(0, 1), a2 + hstep, voffA);
            PG8_WAIT_V(8); PG8_WAIT_L(0); PG8_BAR; PG8_MMA(0, 0, At, B0); PG8_MMA(0, 1, At, B1); PG8_BAR; PG8_SCHED;
            PG8_LDA(At, 1, 1); PG8_STAGE(PG8_SB(1, 0), b3, voffB); PG8_STAGE(PG8_SB(1, 1), b3 + hstep, voffB); PG8_STAGE(PG8_SA(1, 0), a3, voffA);
            PG8_WAIT_V(8); PG8_WAIT_L(0); PG8_BAR; PG8_MMA(1, 0, At, B0); PG8_MMA(1, 1, At, B1); PG8_BAR; PG8_SCHED;
            } else {
            PG8_LDB(B0, 0, 0); PG8_SCHED; PG8_LDA(At, 0, 0); PG8_STAGE(PG8_SA(1, 1), a1 + hstep, voffA);
            PG8_WAIT_L(8); PG8_BAR; PG8_WAIT_L(0); PG8_MMA(0, 0, At, B0); PG8_BAR; PG8_SCHED;
            PG8_LDB(B1, 0, 1); PG8_STAGE(PG8_SB(0, 0), b2, voffB);
            PG8_BAR; PG8_WAIT_L(0); PG8_MMA(0, 1, At, B1); PG8_BAR;
            PG8_LDA(At, 0, 1); PG8_STAGE(PG8_SA(0, 0), a2, voffA);
            PG8_BAR; PG8_WAIT_L(0); PG8_MMA(1, 0, At, B0); PG8_BAR; PG8_SCHED;
            PG8_STAGE(PG8_SB(0, 1), b2 + hstep, voffB);
            PG8_WAIT_V(6); PG8_BAR; PG8_MMA(1, 1, At, B1); PG8_BAR;
            PG8_LDB(B0, 1, 0); PG8_SCHED; PG8_LDA(At, 1, 0); PG8_STAGE(PG8_SA(0, 1), a2 + hstep, voffA);
            PG8_WAIT_L(8); PG8_BAR; PG8_WAIT_L(0); PG8_MMA(0, 0, At, B0); PG8_BAR; PG8_SCHED;
            PG8_LDB(B1, 1, 1); PG8_STAGE(PG8_SB(1, 0), b3, voffB);
            PG8_BAR; PG8_WAIT_L(0); PG8_MMA(0, 1, At, B1); PG8_BAR;
            PG8_LDA(At, 1, 1); PG8_STAGE(PG8_SA(1, 0), a3, voffA);
            PG8_BAR; PG8_WAIT_L(0); PG8_MMA(1, 0, At, B0); PG8_BAR; PG8_SCHED;
            PG8_STAGE(PG8_SB(1, 1), b3 + hstep, voffB);
            PG8_WAIT_V(6); PG8_BAR; PG8_MMA(1, 1, At, B1); PG8_BAR;
            }
        }
        if constexpr (ALIGN_EPI) { if (wr == 0) PG8_BAR; }
        if constexpr (!Epi::AFTER_DRAIN) { E(acc, cur, wr, wc, fr, fq); S.done(cur); }
        if (!has_next) break;
#pragma unroll
        for (int a = 0; a < 2; ++a)
#pragma unroll
            for (int b = 0; b < 2; ++b)
#pragma unroll
                for (int m = 0; m < 4; ++m)
#pragma unroll
                    for (int n = 0; n < 2; ++n) acc[a][b][m][n] = (f32x4){0.f, 0.f, 0.f, 0.f};
        cur = nxt; cA = nA; cB = nB; ++ui;
        if constexpr (ALIGN_EPI) { if (wr == 1) PG8_BAR; }
    }
    PG8_WAIT_V(0);
    if constexpr (!ALIGN_EPI) { if (wr == 0) PG8_BAR; }
    PG8_BAR;
    if constexpr (Epi::AFTER_DRAIN) { E.fused(acc, cur, wr, wc, fr, fq, lds, wid, lane); S.done(cur); }
#undef PG8_SA
#undef PG8_SB
#undef PG8_STAGE
#undef PG8_LDA
#undef PG8_LDB
#undef PG8_MMA
#undef PG8_WAIT_V
#undef PG8_WAIT_L
#undef PG8_BAR
#undef PG8_SCHED
}
}
#define GAS __attribute__((address_space(1)))
#define LAS __attribute__((address_space(3)))
typedef unsigned v4u __attribute__((ext_vector_type(4)));
typedef float f32x4 __attribute__((ext_vector_type(4)));
typedef short bf16x8 __attribute__((ext_vector_type(8)));
typedef GAS unsigned gu32;
typedef GAS unsigned long long gu64;
#define RLX_AGENT __ATOMIC_RELAXED, __HIP_MEMORY_SCOPE_AGENT
#define LDS_WAIT() asm volatile("s_waitcnt lgkmcnt(0)" ::: "memory")
#define VM_WAIT() asm volatile("s_waitcnt vmcnt(0)" ::: "memory")
__device__ __forceinline__ unsigned long long rt() { return __builtin_amdgcn_s_memrealtime(); }

#define XB_TMO      128
#define XB_XCNT(j)  (256  + 64 * (j))
#define XB_XSUB(j)  (1280 + 64 * (j))
#define XB_XGEN(j)  (2304 + 64 * (j))
#define XB_TOP      3328
#define XB_TOPGEN   3392
#define XCD_BAR_WORDS 3456
#define XB_SPIN_CAP (1u << 18)

__device__ __forceinline__ unsigned xb_ld(unsigned* p)              { return __hip_atomic_load(p, __ATOMIC_RELAXED, __HIP_MEMORY_SCOPE_AGENT); }
__device__ __forceinline__ unsigned xb_add(unsigned* p, unsigned v) { return __hip_atomic_fetch_add(p, v, __ATOMIC_RELAXED, __HIP_MEMORY_SCOPE_AGENT); }
__device__ __forceinline__ unsigned xb_xcc_id() { return (unsigned)__builtin_amdgcn_s_getreg((3 << 11) | 20) & 0xFu; }
#define XB_SPIN(cond, bar) do { unsigned _sp = 0; while (cond) { __builtin_amdgcn_s_sleep(1); \
    if ((++_sp & 255u) == 0u) { if (xb_ld(&(bar)[XB_TMO])) break; if (_sp > XB_SPIN_CAP) { atomicAdd(&(bar)[XB_TMO], 1u); break; } } } } while (0)

struct XcdBarrier {
    unsigned* bar; unsigned x;
    volatile LAS unsigned* st;
};

__device__ __forceinline__ XcdBarrier xcd_barrier_post(unsigned* bar, volatile LAS unsigned* st) {
    XcdBarrier b; b.bar = bar; b.x = xb_xcc_id(); b.st = st;
    if (threadIdx.x == 0) (void)xb_add(&bar[XB_XCNT(b.x)], 1u);
    return b;
}
__device__ __forceinline__ void xcd_barrier_complete(unsigned* bar, unsigned x, unsigned& nloc, unsigned& nx) {
    const unsigned G = gridDim.x * gridDim.y * gridDim.z;
    unsigned sum, cnt, mine, sp = 0u;
    for (;;) {
        sum = 0u; cnt = 0u; mine = 0u;
#pragma unroll
        for (unsigned j = 0; j < 16; ++j) { const unsigned c = xb_ld(&bar[XB_XCNT(j)]); sum += c; cnt += (c > 0u) ? 1u : 0u; mine = (j == x) ? c : mine; }
        if (sum == G) break;
        __builtin_amdgcn_s_sleep(1);
        if ((++sp & 255u) == 0u) { if (xb_ld(&bar[XB_TMO])) break; if (sp > XB_SPIN_CAP) { atomicAdd(&bar[XB_TMO], 1u); break; } }
    }
    nloc = mine > 0u ? mine : 1u; nx = cnt > 0u ? cnt : 1u;
}

__device__ __forceinline__ void xcd_barrier(const XcdBarrier& b) {
    asm volatile("s_waitcnt vmcnt(0)" ::: "memory");
    __syncthreads();
    if (threadIdx.x == 0) {
        unsigned* bar = b.bar;
        __builtin_amdgcn_s_waitcnt(0);
        unsigned nloc = b.st[0], nx = b.st[1];
        if (nloc == 0u) { xcd_barrier_complete(bar, b.x, nloc, nx); b.st[0] = nloc; b.st[1] = nx; }
        const unsigned old = xb_add(&bar[XB_XSUB(b.x)], 1u);
        const unsigned gen = old / nloc;
        if (old + 1u == (gen + 1u) * nloc) {
            __builtin_amdgcn_fence(__ATOMIC_RELEASE, "agent");
            asm volatile("s_waitcnt vmcnt(0)" ::: "memory");
            const unsigned og = xb_add(&bar[XB_TOP], 1u);
            const unsigned tg = og / nx;
            if (og + 1u == (tg + 1u) * nx) xb_add(&bar[XB_TOPGEN], 1u);
            else XB_SPIN(xb_ld(&bar[XB_TOPGEN]) == tg, bar);
            __builtin_amdgcn_fence(__ATOMIC_ACQUIRE, "agent");
            xb_add(&bar[XB_XGEN(b.x)], 1u);
            asm volatile("s_waitcnt vmcnt(0)" ::: "memory");
        } else {
            XB_SPIN(xb_ld(&bar[XB_XGEN(b.x)]) == gen, bar);
            __builtin_amdgcn_fence(__ATOMIC_ACQUIRE, "agent");
            asm volatile("s_waitcnt vmcnt(0)" ::: "memory");
        }
    }
    __syncthreads();
}

namespace fa {
typedef short bf16x8 __attribute__((ext_vector_type(8)));
typedef short s16x4 __attribute__((ext_vector_type(4)));
typedef float f32x16 __attribute__((ext_vector_type(16)));
typedef unsigned u32x4 __attribute__((ext_vector_type(4)));
typedef short v4i16_t __attribute__((ext_vector_type(4)));
typedef __attribute__((address_space(3))) const char* lds_cptr;
typedef __attribute__((address_space(3))) char* lds_ptr;

constexpr int NSLOT = 3, SLOTB = 8192;
constexpr int LDS_K = 0, LDS_V = NSLOT * SLOTB;
constexpr int LDS_IMP = 2 * NSLOT * SLOTB;
constexpr int LDS_IMPT = LDS_IMP + 4 * 64 * 33 * 4;
constexpr int LDS_SEL = LDS_IMPT + 64 * 33 * 4;
constexpr int LDS_ATTN_END = LDS_SEL + 256;

#define FA_NEG (-__builtin_inff())
__device__ __forceinline__ void glds16(const void* gsrc, unsigned lds_dst) { unsigned keep;
    asm volatile("s_mov_b32 %0, m0\n\ts_mov_b32 m0, %2\n\ts_nop 0\n\tglobal_load_lds_dwordx4 %1, off\n\ts_mov_b32 m0, %0" : "=&s"(keep) : "v"(gsrc), "s"(lds_dst) : "memory"); }
#define FA_WAIT_BAR(N) asm volatile("s_waitcnt vmcnt(" #N ") lgkmcnt(0)\n\ts_barrier" ::: "memory")
__device__ __forceinline__ s16x4 vtr(lds_cptr p) { return __builtin_bit_cast(s16x4, __builtin_amdgcn_ds_read_tr16_b64_v4i16((__attribute__((address_space(3))) v4i16_t*)p)); }
typedef float f32x2_t __attribute__((ext_vector_type(2))); typedef __bf16 bf16x2_t __attribute__((ext_vector_type(2)));
__device__ __forceinline__ unsigned cvtpk(float lo, float hi) { f32x2_t v = {lo, hi}; bf16x2_t b = __builtin_convertvector(v, bf16x2_t); return __builtin_bit_cast(unsigned, b); }

struct RowCtx {
    int hiAbs, loAbs;
    unsigned selmask; int selshift;
    float sk, lb;
};

__device__ __forceinline__ void qk_scores(lds_cptr kslot, int j, const bf16x8 (&qr)[4], const RowCtx& rc, int r32, int hi, int hk, int lk, bool rowok, f32x16& p0, f32x16& p1) {
    const float lbj = rc.sk * (float)(64 * j + 4 * hi) + rc.lb;
#pragma unroll
    for (int r = 0; r < 16; ++r) { const float c = (float)((r & 3) + 8 * (r >> 2)); p0[r] = __builtin_fmaf(rc.sk, c, lbj); p1[r] = __builtin_fmaf(rc.sk, c + 32.f, lbj); }
    const lds_cptr kp = kslot + hi * 1024 + r32 * 16;
#pragma unroll
    for (int d0 = 0; d0 < 4; ++d0) {
        const bf16x8 b0 = *(const __attribute__((address_space(3))) bf16x8*)(kp + d0 * 2048);
        const bf16x8 b1 = *(const __attribute__((address_space(3))) bf16x8*)(kp + d0 * 2048 + 512);
        p0 = __builtin_amdgcn_mfma_f32_32x32x16_bf16(b0, qr[d0], p0, 0, 0, 0);
        p1 = __builtin_amdgcn_mfma_f32_32x32x16_bf16(b1, qr[d0], p1, 0, 0, 0);
    }
    const bool full = (lk <= 0) && (hk >= 63);
    if (!__all(full)) {
        const int a = lk - 4 * hi, b = hk - 4 * hi;
#pragma unroll
        for (int r = 0; r < 16; ++r) { const int c = (r & 3) + 8 * (r >> 2);
            p0[r] = (c >= a && c <= b) ? p0[r] : FA_NEG; p1[r] = (c + 32 >= a && c + 32 <= b) ? p1[r] : FA_NEG; }
    }
    if (!__all(rowok)) {
#pragma unroll
        for (int r = 0; r < 16; ++r) { p0[r] = rowok ? p0[r] : FA_NEG; p1[r] = rowok ? p1[r] : FA_NEG; }
    }
}
__device__ __forceinline__ void pv_accum(lds_cptr vslot, const f32x16& p0, const f32x16& p1, int lane, int hi, f32x16 (&o)[2]) {
    u32x4 pw[4];
    pw[0] = (u32x4){cvtpk(p0[0], p0[1]), cvtpk(p0[2], p0[3]), cvtpk(p0[4], p0[5]), cvtpk(p0[6], p0[7])};
    pw[1] = (u32x4){cvtpk(p0[8], p0[9]), cvtpk(p0[10], p0[11]), cvtpk(p0[12], p0[13]), cvtpk(p0[14], p0[15])};
    pw[2] = (u32x4){cvtpk(p1[0], p1[1]), cvtpk(p1[2], p1[3]), cvtpk(p1[4], p1[5]), cvtpk(p1[6], p1[7])};
    pw[3] = (u32x4){cvtpk(p1[8], p1[9]), cvtpk(p1[10], p1[11]), cvtpk(p1[12], p1[13]), cvtpk(p1[14], p1[15])};
    const lds_cptr vp = vslot + ((lane >> 4) & 1) * 32 + (lane & 3) * 8 + (4 * hi + ((lane & 15) >> 2)) * 64;
#pragma unroll
    for (int d0 = 0; d0 < 2; ++d0)
#pragma unroll
        for (int ks = 0; ks < 4; ++ks) {
            const s16x4 lo = vtr(vp + d0 * 4096 + ks * 1024), hh = vtr(vp + d0 * 4096 + ks * 1024 + 512);
            const bf16x8 vf = (bf16x8){lo[0], lo[1], lo[2], lo[3], hh[0], hh[1], hh[2], hh[3]};
            o[d0] = __builtin_amdgcn_mfma_f32_32x32x16_bf16(vf, __builtin_bit_cast(bf16x8, pw[ks]), o[d0], 0, 0, 0);
        }
}
__device__ __forceinline__ float rowmax32(const f32x16& p0, const f32x16& p1) {
    float a = __builtin_fmaxf(p0[0], p1[0]);
#pragma unroll
    for (int r = 1; r < 16; ++r) a = __builtin_fmaxf(a, __builtin_fmaxf(p0[r], p1[r]));
    return __builtin_fmaxf(a, __shfl_xor(a, 32));
}
__device__ __forceinline__ void tile_compute(lds_cptr kslot, lds_cptr vslot, int j, const bf16x8 (&qr)[4], const RowCtx& rc, int lane, float& m, float& l, f32x16 (&o)[2]) {
    const int r32 = lane & 31, hi = lane >> 5;
    int hk = rc.hiAbs - 64 * j; hk = hk > 63 ? 63 : hk;
    int lk = rc.loAbs - 64 * j; lk = lk < 0 ? 0 : lk;
    const bool rowok = ((rc.selmask >> (j >> rc.selshift)) & 1u) != 0u;
    if (!__any(rowok && lk <= hk)) return;
    f32x16 p0, p1;
    qk_scores(kslot, j, qr, rc, r32, hi, hk, lk, rowok, p0, p1);
    const float mx = rowmax32(p0, p1);
    if (__any(mx > m)) {
        const float mn = __builtin_fmaxf(m, mx), al = __builtin_amdgcn_exp2f(m - mn);
        l *= al; m = mn;
#pragma unroll
        for (int r = 0; r < 16; ++r) { o[0][r] *= al; o[1][r] *= al; }
    }
    float sum = 0.f;
#pragma unroll
    for (int r = 0; r < 16; ++r) { p0[r] = __builtin_amdgcn_exp2f(p0[r] - m); p1[r] = __builtin_amdgcn_exp2f(p1[r] - m); sum += p0[r] + p1[r]; }
    l += sum;
    pv_accum(vslot, p0, p1, lane, hi, o);
}

__device__ __forceinline__ void attn_stream(lds_ptr ring, const bf16_t* Kb, const bf16_t* Vb, int jlo, int jhi, const bf16x8 (&qr)[4], const RowCtx& rc, int wid, int lane,
                                            float& m, float& l, f32x16 (&o)[2]) {
    const int nt = jhi - jlo;
    if (nt <= 0) return;
    const unsigned lds0 = (unsigned)(uintptr_t)ring;
    const bf16_t* ksrc = Kb + (size_t)lane * 64 + wid * 8;
    const bf16_t* vsrc = Vb + (size_t)(16 * (wid & 3) + (lane >> 2)) * 64 + (wid >> 2) * 32 + (lane & 3) * 8;
    const unsigned kdst = lds0 + LDS_K + wid * 1024, vdst = lds0 + LDS_V + wid * 1024;
#define FA_DMA(j_, so_) do { glds16(ksrc + (size_t)(j_) * 4096, (unsigned)__builtin_amdgcn_readfirstlane(kdst + (so_))); glds16(vsrc + (size_t)(j_) * 4096, (unsigned)__builtin_amdgcn_readfirstlane(vdst + (so_))); } while (0)
    FA_DMA(jlo, 0);
    if (nt > 1) FA_DMA(jlo + 1, SLOTB);
    int s_cur = 0, s_nn = 2 * SLOTB;
    for (int i = 0; i < nt; ++i) {
        if (i + 1 < nt) FA_WAIT_BAR(2); else FA_WAIT_BAR(0);
        if (i + 2 < nt) FA_DMA(jlo + i + 2, s_nn);
        tile_compute((lds_cptr)ring + LDS_K + s_cur, (lds_cptr)ring + LDS_V + s_cur, jlo + i, qr, rc, lane, m, l, o);
        s_cur = (s_cur == (NSLOT - 1) * SLOTB) ? 0 : s_cur + SLOTB;
        s_nn = (s_nn == (NSLOT - 1) * SLOTB) ? 0 : s_nn + SLOTB;
    }
    asm volatile("s_waitcnt lgkmcnt(0)\n\ts_barrier" ::: "memory");
#undef FA_DMA
}

__device__ __forceinline__ void acc_scaled(f32x16 (&acc)[2], const f32x16 (&o)[2], float w) {
#pragma unroll
    for (int r = 0; r < 16; ++r) { acc[0][r] += o[0][r] * w; acc[1][r] += o[1][r] * w; }
}
__device__ __forceinline__ void store_o(const f32x16 (&o)[2], float w, const bf16_t* Z, bf16_t* Y, int t, int zcol, int ycol, int hi) {
#pragma unroll
    for (int d0 = 0; d0 < 2; ++d0)
#pragma unroll
        for (int g4 = 0; g4 < 4; ++g4) {
            const int d = 32 * d0 + 8 * g4 + 4 * hi;
            const uint2 z = *(const uint2*)(Z + (size_t)t * 512 + zcol + d);
            const float v0 = o[d0][4 * g4 + 0] * w * bf2f(z.x & 0xffff), v1 = o[d0][4 * g4 + 1] * w * bf2f(z.x >> 16);
            const float v2 = o[d0][4 * g4 + 2] * w * bf2f(z.y & 0xffff), v3 = o[d0][4 * g4 + 3] * w * bf2f(z.y >> 16);
            uint2 y; y.x = cvtpk(v0, v1); y.y = cvtpk(v2, v3);
            *(uint2*)(Y + (size_t)t * 1024 + ycol + d) = y;
        }
}
__device__ __forceinline__ void load_q(bf16x8 (&qr)[4], const bf16_t* Qrow, int hi) {
#pragma unroll
    for (int d0 = 0; d0 < 4; ++d0) qr[d0] = *(const bf16x8*)(Qrow + d0 * 16 + hi * 8);
}

__device__ __forceinline__ void moba_unit(const KArgs& P, lds_ptr ring, int b, int h, int own, int wid, int lane) {
    const bf16_t* QB = (const bf16_t*)(P.ws + WS_QB); const bf16_t* KB = (const bf16_t*)(P.ws + WS_KB); const bf16_t* VB = (const bf16_t*)(P.ws + WS_VB);
    const float* KMP = (const float*)(P.ws + WS_KMP); const bf16_t* ZB = (const bf16_t*)(P.ws + WS_ZB); bf16_t* Y = (bf16_t*)(P.ws + WS_Y);
    const int r32 = lane & 31, hi = lane >> 5;
    const int sq = own * 256 + 32 * wid + r32, t = b * SEQ + sq;
    const size_t hb = (size_t)(b * 8 + h) * SEQ;
    bf16x8 qr[4]; load_q(qr, QB + (hb + sq) * 64, hi);
    float gate[8];
#pragma unroll
    for (int n = 0; n < 8; ++n) {
        float g = -1e30f;
        if (n < own) {
            const float* k0 = KMP + (size_t)(b * 8 + n) * 512 + h * 64 + hi * 8; const float* k1 = k0 + 64 * 512;
            float part = 0.f;
#pragma unroll
            for (int d0 = 0; d0 < 4; ++d0) {
                const float4 a0 = *(const float4*)(k0 + d0 * 16), a1 = *(const float4*)(k0 + d0 * 16 + 4), c0 = *(const float4*)(k1 + d0 * 16), c1 = *(const float4*)(k1 + d0 * 16 + 4);
                part += bf2f((unsigned short)qr[d0][0]) * (a0.x + c0.x) + bf2f((unsigned short)qr[d0][1]) * (a0.y + c0.y) + bf2f((unsigned short)qr[d0][2]) * (a0.z + c0.z) + bf2f((unsigned short)qr[d0][3]) * (a0.w + c0.w)
                      + bf2f((unsigned short)qr[d0][4]) * (a1.x + c1.x) + bf2f((unsigned short)qr[d0][5]) * (a1.y + c1.y) + bf2f((unsigned short)qr[d0][6]) * (a1.z + c1.z) + bf2f((unsigned short)qr[d0][7]) * (a1.w + c1.w);
            }
            g = part + __shfl_xor(part, 32);
        }
        gate[n] = g;
    }
    unsigned sel = 0;
#pragma unroll
    for (int it = 0; it < 3; ++it) {
        float best = -3e38f; int bi = 0;
#pragma unroll
        for (int n = 0; n < 8; ++n) { const bool ok = !((sel >> n) & 1u) && gate[n] > best; best = ok ? gate[n] : best; bi = ok ? n : bi; }
        sel |= 1u << bi;
    }
    sel &= (1u << own) - 1u;
    sel |= 1u << own;
    const float slope2 = exp2f(-(float)(h + 1)) * LOG2E;
    RowCtx rc; rc.hiAbs = sq; rc.loAbs = -(1 << 30); rc.selmask = sel; rc.selshift = 2; rc.sk = slope2; rc.lb = -slope2 * (float)(own * 256);
    float m = -1e30f, l = 0.f; f32x16 o[2];
#pragma unroll
    for (int r = 0; r < 16; ++r) { o[0][r] = 0.f; o[1][r] = 0.f; }
    attn_stream(ring, KB + hb * 64, VB + hb * 64, 0, 4 * own + 4, qr, rc, wid, lane, m, l, o);
    l += __shfl_xor(l, 32);
    const float inv = l > 0.f ? 1.0f / l : 0.f;
    store_o(o, inv, ZB, Y, t, h * 64, 512 + h * 64, hi);
}

__device__ __forceinline__ void swa_unit(const KArgs& P, lds_ptr ring, int b, int g, int c, int wid, int lane) {
    const bf16_t* QD = (const bf16_t*)(P.ws + WS_QD); const bf16_t* KD = (const bf16_t*)(P.ws + WS_KD); const bf16_t* VD = (const bf16_t*)(P.ws + WS_VD);
    const bf16_t* ZD = (const bf16_t*)(P.ws + WS_ZD); bf16_t* Y = (bf16_t*)(P.ws + WS_Y);
    const int r32 = lane & 31, hi = lane >> 5, h = 4 * g + (wid >> 1);
    const int sq = 64 * c + 32 * (wid & 1) + r32, t = b * SEQ + sq;
    bf16x8 qr[4]; load_q(qr, QD + ((size_t)(b * 8 + h) * SEQ + sq) * 64, hi);
    const float slope2 = exp2f(-(float)(h + 1)) * LOG2E;
    RowCtx rc; rc.hiAbs = sq; rc.loAbs = sq - 127; rc.selmask = 0xffffffffu; rc.selshift = 0; rc.sk = slope2; rc.lb = -slope2 * (float)(64 * c);
    float m = P.d_sinks[h] * LOG2E + slope2 * (float)(sq - 64 * c), l = hi == 0 ? 1.f : 0.f; f32x16 o[2];
#pragma unroll
    for (int r = 0; r < 16; ++r) { o[0][r] = 0.f; o[1][r] = 0.f; }
    const size_t gb = (size_t)(b * 2 + g) * SEQ * 64;
    attn_stream(ring, KD + gb, VD + gb, c >= 2 ? c - 2 : 0, c + 1, qr, rc, wid, lane, m, l, o);
    l += __shfl_xor(l, 32);
    store_o(o, 1.0f / l, ZD, Y, t, h * 64, 512 + h * 64, hi);
}

__device__ __forceinline__ void nsa_unit(const KArgs& P, lds_ptr ring, int b, int g, int c, int wid, int lane, int tid) {
    const bf16_t* QC = (const bf16_t*)(P.ws + WS_QC); const bf16_t* KC = (const bf16_t*)(P.ws + WS_KC); const bf16_t* VC = (const bf16_t*)(P.ws + WS_VC);
    const bf16_t* KS = (const bf16_t*)(P.ws + WS_KS); const bf16_t* VS = (const bf16_t*)(P.ws + WS_VS);
    const bf16_t* KW = (const bf16_t*)(P.ws + WS_KW); const bf16_t* VW = (const bf16_t*)(P.ws + WS_VW);
    const float* GT = (const float*)(P.ws + WS_GT); const bf16_t* ZC = (const bf16_t*)(P.ws + WS_ZC); bf16_t* Y = (bf16_t*)(P.ws + WS_Y);
    const int r32 = lane & 31, hi = lane >> 5, hh = wid >> 1, h = 4 * g + hh;
    const int tok = 32 * (wid & 1) + r32, sq = 64 * c + tok, t = b * SEQ + sq;
    bf16x8 qr[4]; load_q(qr, QC + ((size_t)(b * 8 + h) * SEQ + sq) * 64, hi);
    const float slope2 = exp2f(-(float)(h + 1)) * LOG2E;
    const float g0 = GT[(size_t)t * 32 + h], g1 = GT[(size_t)t * 32 + 8 + h], g2 = GT[(size_t)t * 32 + 16 + h];
    f32x16 ot[2], o[2];
#pragma unroll
    for (int r = 0; r < 16; ++r) { ot[0][r] = 0.f; ot[1][r] = 0.f; o[0][r] = 0.f; o[1][r] = 0.f; }
    __attribute__((address_space(3))) float* impH = (__attribute__((address_space(3))) float*)(ring + LDS_IMP);
    __attribute__((address_space(3))) float* impT = (__attribute__((address_space(3))) float*)(ring + LDS_IMPT);
    __attribute__((address_space(3))) unsigned* selS = (__attribute__((address_space(3))) unsigned*)(ring + LDS_SEL);
    {
        const bf16_t* kc = KC + (size_t)(b * 2 + g) * 128 * 64; const bf16_t* vc = VC + (size_t)(b * 2 + g) * 128 * 64;
        const unsigned lds0 = (unsigned)(uintptr_t)ring;
        const bf16_t* ksrc = kc + (size_t)lane * 64 + wid * 8;
        const bf16_t* vsrc = vc + (size_t)(16 * (wid & 3) + (lane >> 2)) * 64 + (wid >> 2) * 32 + (lane & 3) * 8;
        glds16(ksrc, (unsigned)__builtin_amdgcn_readfirstlane(lds0 + LDS_K + wid * 1024)); glds16(vsrc, (unsigned)__builtin_amdgcn_readfirstlane(lds0 + LDS_V + wid * 1024));
        glds16(ksrc + 4096, (unsigned)__builtin_amdgcn_readfirstlane(lds0 + LDS_K + SLOTB + wid * 1024)); glds16(vsrc + 4096, (unsigned)__builtin_amdgcn_readfirstlane(lds0 + LDS_V + SLOTB + wid * 1024));
        FA_WAIT_BAR(0);
        RowCtx rc; int hc = (sq - 31) >> 4; rc.hiAbs = hc > 126 ? 126 : hc; rc.loAbs = -(1 << 30); rc.selmask = 0xffffffffu; rc.selshift = 0; rc.sk = 16.f * slope2; rc.lb = slope2 * (float)(31 - 64 * c);
        f32x16 a0, a1, b0, b1;
        { int hk = rc.hiAbs; hk = hk > 63 ? 63 : hk; qk_scores((lds_cptr)ring + LDS_K, 0, qr, rc, r32, hi, hk, 0, true, a0, a1); }
        { int hk = rc.hiAbs - 64; hk = hk > 63 ? 63 : hk; qk_scores((lds_cptr)ring + LDS_K + SLOTB, 1, qr, rc, r32, hi, hk, 0, true, b0, b1); }
        float mx = __builtin_fmaxf(rowmax32(a0, a1), rowmax32(b0, b1));
        mx = mx > -1e37f ? mx : 0.f;
        float sum = 0.f;
#pragma unroll
        for (int r = 0; r < 16; ++r) { a0[r] = __builtin_amdgcn_exp2f(a0[r] - mx); a1[r] = __builtin_amdgcn_exp2f(a1[r] - mx); b0[r] = __builtin_amdgcn_exp2f(b0[r] - mx); b1[r] = __builtin_amdgcn_exp2f(b1[r] - mx);
            sum += (a0[r] + a1[r]) + (b0[r] + b1[r]); }
        sum += __shfl_xor(sum, 32);
        const float inv = sum > 0.f ? 1.0f / sum : 0.f;
#pragma unroll
        for (int r = 0; r < 16; ++r) { a0[r] *= inv; a1[r] *= inv; b0[r] *= inv; b1[r] *= inv; }
        float ss[16], ee[16];
#pragma unroll
        for (int i = 0; i < 4; ++i) {
            ss[i] = (a0[4 * i] + a0[4 * i + 1]) + (a0[4 * i + 2] + a0[4 * i + 3]); ee[i] = a0[4 * i + 3];
            ss[4 + i] = (a1[4 * i] + a1[4 * i + 1]) + (a1[4 * i + 2] + a1[4 * i + 3]); ee[4 + i] = a1[4 * i + 3];
            ss[8 + i] = (b0[4 * i] + b0[4 * i + 1]) + (b0[4 * i + 2] + b0[4 * i + 3]); ee[8 + i] = b0[4 * i + 3];
            ss[12 + i] = (b1[4 * i] + b1[4 * i + 1]) + (b1[4 * i + 2] + b1[4 * i + 3]); ee[12 + i] = b1[4 * i + 3];
        }
        float ep[16];
#pragma unroll
        for (int k = 0; k < 16; ++k) ep[k] = __shfl_xor(ee[k], 32);
#pragma unroll
        for (int k = 0; k < 16; ++k) {
            const float prev = k > 0 ? ep[k > 0 ? k - 1 : 0] : 0.f;
            const float v = ss[k] + (hi ? ep[k] : prev);
            impH[(hh * 64 + tok) * 33 + 2 * k + hi] = v;
        }
        pv_accum((lds_cptr)ring + LDS_V, a0, a1, lane, hi, o);
        pv_accum((lds_cptr)ring + LDS_V + SLOTB, b0, b1, lane, hi, o);
        acc_scaled(ot, o, g0);
        asm volatile("s_waitcnt lgkmcnt(0)\n\ts_barrier" ::: "memory");
        {
            const int tk = tid >> 3, part = tid & 7;
#pragma unroll
            for (int i = 0; i < 4; ++i) { const int n = 4 * part + i;
                float v = (impH[(0 * 64 + tk) * 33 + n] + impH[(1 * 64 + tk) * 33 + n]) + (impH[(2 * 64 + tk) * 33 + n] + impH[(3 * 64 + tk) * 33 + n]);
                if (n == 0 || n == c || n == c - 1) v = 1e4f;
                if (n > c) v = -1e30f;
                impT[tk * 33 + n] = v; }
            asm volatile("s_waitcnt lgkmcnt(0)\n\ts_barrier" ::: "memory");
            float mine[4]; int rank[4];
#pragma unroll
            for (int i = 0; i < 4; ++i) { mine[i] = impT[tk * 33 + 4 * part + i]; rank[i] = 0; }
#pragma unroll 1
            for (int mI = 0; mI < 32; ++mI) { const float v = impT[tk * 33 + mI];
#pragma unroll
                for (int i = 0; i < 4; ++i) rank[i] += (v > mine[i] || (v == mine[i] && mI < 4 * part + i)) ? 1 : 0; }
            unsigned bits = 0;
#pragma unroll
            for (int i = 0; i < 4; ++i) if (rank[i] < 16) bits |= 1u << (4 * part + i);
            bits |= __shfl_xor(bits, 1); bits |= __shfl_xor(bits, 2); bits |= __shfl_xor(bits, 4);
            if (part == 0) selS[tk] = bits;
            asm volatile("s_waitcnt lgkmcnt(0)\n\ts_barrier" ::: "memory");
        }
    }
    const unsigned sel = selS[tok];
    const size_t gb = (size_t)(b * 2 + g) * SEQ * 64;
    {
        RowCtx rc; rc.hiAbs = sq; rc.loAbs = -(1 << 30); rc.selmask = sel; rc.selshift = 0; rc.sk = slope2; rc.lb = -slope2 * (float)(64 * c);
        float m = -1e30f, l = 0.f;
#pragma unroll
        for (int r = 0; r < 16; ++r) { o[0][r] = 0.f; o[1][r] = 0.f; }
        attn_stream(ring, KS + gb, VS + gb, 0, c + 1, qr, rc, wid, lane, m, l, o);
        l += __shfl_xor(l, 32);
        acc_scaled(ot, o, l > 0.f ? g1 / l : 0.f);
    }
    {
        RowCtx rc; rc.hiAbs = sq; rc.loAbs = sq - 511; rc.selmask = 0xffffffffu; rc.selshift = 0; rc.sk = slope2; rc.lb = -slope2 * (float)(64 * c);
        float m = -1e30f, l = 0.f;
#pragma unroll
        for (int r = 0; r < 16; ++r) { o[0][r] = 0.f; o[1][r] = 0.f; }
        attn_stream(ring, KW + gb, VW + gb, c >= 8 ? c - 8 : 0, c + 1, qr, rc, wid, lane, m, l, o);
        l += __shfl_xor(l, 32);
        acc_scaled(ot, o, l > 0.f ? g2 / l : 0.f);
    }
    store_o(ot, 1.f, ZC, Y, t, h * 64, h * 64, hi);
}
}
namespace fm {
typedef short bf16x8 __attribute__((ext_vector_type(8)));
typedef float f32x4 __attribute__((ext_vector_type(4)));
typedef float f32x2 __attribute__((ext_vector_type(2)));
__device__ __forceinline__ float wave_sum(float v) {
#pragma unroll
    for (int o = 1; o < 64; o <<= 1) v += __shfl_xor(v, o);
    return v;
}
__device__ __forceinline__ void conv_phase(const KArgs& P, LAS unsigned char* lds, int vcu, int G, int tid, int wave, int lane) {
    const bf16_t* G0 = (const bf16_t*)(P.ws + WS_G0); const bf16_t* ZA = (const bf16_t*)(P.ws + WS_ZA); bf16_t* Y = (bf16_t*)(P.ws + WS_Y);
    LAS float* cy = (LAS float*)lds;
    const int cp = tid & 255, sb = tid >> 8;
    float w0[31], w1[31];
#pragma unroll
    for (int j = 0; j < 31; ++j) { const float2 w = *(const float2*)(P.a_conv_w + j * 512 + 2 * cp); w0[j] = w.x; w1[j] = w.y; }
    const float2 bias = *(const float2*)(P.a_conv_b + 2 * cp);
    const float4 ga = *(const float4*)(P.a_ln_g + 4 * lane), gb = *(const float4*)(P.a_ln_g + 256 + 4 * lane);
    const float4 ba = *(const float4*)(P.a_ln_b + 4 * lane), bb2 = *(const float4*)(P.a_ln_b + 256 + 4 * lane);
    for (int u = vcu; u < 512; u += G) {
        const int t0 = u * 32, s0 = t0 & (SEQ - 1);
        float acc0[16], acc1[16];
#pragma unroll
        for (int o = 0; o < 16; ++o) { acc0[o] = bias.x; acc1[o] = bias.y; }
        const int sbase = s0 + 16 * sb - 30;
        const bf16_t* gp = G0 + (size_t)(t0 + 16 * sb - 30) * 512 + 2 * cp;
#pragma unroll
        for (int i = 0; i < 46; ++i) {
            const bool ok = sbase + i >= 0;
            const unsigned v = *(const unsigned*)(ok ? gp + i * 512 : G0);
            const float x0 = ok ? bf2f(v & 0xffff) : 0.f, x1 = ok ? bf2f(v >> 16) : 0.f;
#pragma unroll
            for (int o = 0; o < 16; ++o) { const int j = i - o; if (j >= 0 && j <= 30) { acc0[o] += x0 * w0[j]; acc1[o] += x1 * w1[j]; } }
        }
#pragma unroll
        for (int o = 0; o < 16; ++o) { f32x2 r; r.x = acc0[o]; r.y = acc1[o]; *(LAS f32x2*)(cy + (16 * sb + o) * 512 + 2 * cp) = r; }
        __syncthreads();
#pragma unroll
        for (int k = 0; k < 4; ++k) {
            const int tok = 4 * wave + k, t = t0 + tok;
            f32x4 a = *(const LAS f32x4*)(cy + tok * 512 + 4 * lane), b = *(const LAS f32x4*)(cy + tok * 512 + 256 + 4 * lane);
            const float mean = wave_sum((a.x + a.y) + (a.z + a.w) + (b.x + b.y) + (b.z + b.w)) * (1.0f / 512);
            a.x -= mean; a.y -= mean; a.z -= mean; a.w -= mean; b.x -= mean; b.y -= mean; b.z -= mean; b.w -= mean;
            const float var = wave_sum((a.x * a.x + a.y * a.y) + (a.z * a.z + a.w * a.w) + (b.x * b.x + b.y * b.y) + (b.z * b.z + b.w * b.w)) * (1.0f / 512);
            const float rstd = 1.0f / sqrtf(var + EPSF);
            const uint2 za = *(const uint2*)(ZA + (size_t)t * 512 + 4 * lane), zb = *(const uint2*)(ZA + (size_t)t * 512 + 256 + 4 * lane);
            float y0 = fast_silu(a.x * rstd * ga.x + ba.x) * bf2f(za.x & 0xffff), y1 = fast_silu(a.y * rstd * ga.y + ba.y) * bf2f(za.x >> 16);
            float y2 = fast_silu(a.z * rstd * ga.z + ba.z) * bf2f(za.y & 0xffff), y3 = fast_silu(a.w * rstd * ga.w + ba.w) * bf2f(za.y >> 16);
            uint2 o; o.x = pk2(y0, y1); o.y = pk2(y2, y3);
            *(uint2*)(Y + (size_t)t * 1024 + 4 * lane) = o;
            y0 = fast_silu(b.x * rstd * gb.x + bb2.x) * bf2f(zb.x & 0xffff); y1 = fast_silu(b.y * rstd * gb.y + bb2.y) * bf2f(zb.x >> 16);
            y2 = fast_silu(b.z * rstd * gb.z + bb2.z) * bf2f(zb.y & 0xffff); y3 = fast_silu(b.w * rstd * gb.w + bb2.w) * bf2f(zb.y >> 16);
            o.x = pk2(y0, y1); o.y = pk2(y2, y3);
            *(uint2*)(Y + (size_t)t * 1024 + 256 + 4 * lane) = o;
        }
        __syncthreads();
    }
}

__device__ __forceinline__ void cmp_unit(const KArgs& P, LAS unsigned char* lds, int u, int tid, int wave, int lane) {
    const int kv = u >> 7, bg = (u >> 3) & 15, rb = u & 7, fr = lane & 15, fq = lane >> 4;
    const bf16_t* X = (const bf16_t*)(P.ws + (kv == 0 ? WS_KCR : WS_VCR)) + ((size_t)bg * SEQ + 256 * rb) * 64;
    const bf16_t* W1t = (const bf16_t*)(P.ws + WS_CW1) + (size_t)kv * 256 * 2048;
    const bf16_t* W2t = (const bf16_t*)(P.ws + WS_CW2) + (size_t)kv * 64 * 256;
    const float* B1P = (const float*)(P.ws + WS_B1P) + (size_t)kv * 16 * 256;
    LAS bf16_t* hidS = (LAS bf16_t*)lds;
    LAS float* outS = (LAS float*)(lds + 16 * 264 * 2);
    {
        const int n0 = 32 * wave;
        f32x4 acc0 = {0.f, 0.f, 0.f, 0.f}, acc1 = {0.f, 0.f, 0.f, 0.f};
        const bf16_t* ap = X + (size_t)fr * 1024 + 8 * fq;
        const bf16_t* bp0 = W1t + (size_t)(n0 + fr) * 2048 + 8 * fq; const bf16_t* bp1 = bp0 + 16 * 2048;
#pragma unroll 8
        for (int k0 = 0; k0 < 2048; k0 += 32) {
            const bf16x8 a = *(const bf16x8*)(ap + k0), b0 = *(const bf16x8*)(bp0 + k0), b1 = *(const bf16x8*)(bp1 + k0);
            acc0 = __builtin_amdgcn_mfma_f32_16x16x32_bf16(a, b0, acc0, 0, 0, 0);
            acc1 = __builtin_amdgcn_mfma_f32_16x16x32_bf16(a, b1, acc1, 0, 0, 0);
        }
        const float* b1 = kv == 0 ? P.c_k_b1 : P.c_v_b1;
#pragma unroll
        for (int f = 0; f < 2; ++f) {
            const int n = n0 + 16 * f + fr;
            float bias = b1[n];
#pragma unroll
            for (int kc = 0; kc < 16; ++kc) bias += B1P[kc * 256 + n];
#pragma unroll
            for (int r = 0; r < 4; ++r) { const float v = (f == 0 ? acc0[r] : acc1[r]) + bias; hidS[(4 * fq + r) * 264 + n] = f2bf(fast_silu(v)); }
        }
    }
    __syncthreads();
    if (wave < 4) {
        const int d0 = 16 * wave;
        f32x4 acc = {0.f, 0.f, 0.f, 0.f};
#pragma unroll
        for (int k0 = 0; k0 < 256; k0 += 32) {
            const bf16x8 a = *(const LAS bf16x8*)(hidS + fr * 264 + k0 + 8 * fq);
            const bf16x8 b = *(const bf16x8*)(W2t + (size_t)(d0 + fr) * 256 + k0 + 8 * fq);
            acc = __builtin_amdgcn_mfma_f32_16x16x32_bf16(a, b, acc, 0, 0, 0);
        }
        const float b2 = (kv == 0 ? P.c_k_b2 : P.c_v_b2)[d0 + fr];
#pragma unroll
        for (int r = 0; r < 4; ++r) outS[(4 * fq + r) * 65 + d0 + fr] = acc[r] + b2;
    }
    __syncthreads();
    {
        bf16_t* dst = (bf16_t*)(P.ws + (kv == 0 ? WS_KC : WS_VC)) + (size_t)bg * 128 * 64;
#pragma unroll
        for (int k = 0; k < 2; ++k) {
            const int row = 2 * wave + k, c = 16 * rb + row;
            float v = outS[row * 65 + lane];
            if (kv == 0) { const float ss = wave_sum(v * v); v = v * (1.0f / sqrtf(ss * (1.0f / 64) + EPSF)) * P.c_knorm_cmp_g[lane]; }
            dst[(size_t)c * 64 + lane] = c < 127 ? f2bf(v) : (bf16_t)0;
        }
    }
    __syncthreads();
}

__device__ __forceinline__ void b1p_item(const KArgs& P, int it, int lane) {
    const int kv = it >> 6, kc = (it >> 2) & 15, n = (it & 3) * 64 + lane;
    const float* pos = kv == 0 ? P.c_pos_k : P.c_pos_v; const float* w1 = kv == 0 ? P.c_k_w1 : P.c_v_w1;
    float s = 0.f;
#pragma unroll 16
    for (int k = kc * 128; k < kc * 128 + 128; ++k) s += pos[k] * w1[(size_t)k * 256 + n];
    ((float*)(P.ws + WS_B1P))[((size_t)kv * 16 + kc) * 256 + n] = s;
}
}
__device__ __forceinline__ NvGroup fast_group(const KArgs& P, int layer, int pn, int wc) {
    if (layer == 0) {
        if (pn < 4) { NvGroup g; g.gain = nullptr; g.scale = 1.f; g.width = 32; g.type = 4; g.col = 128 * pn + 32 * wc; g.col2 = 512 + g.col; g.dkind = 0; g.dst = P.ws + WS_G0; g.ld = 512; g.idx = 0; return g; }
        return nv_group0(P, 8 + 4 * (pn - 4) + wc);
    }
    int gi;
    if (pn < 2) gi = 4 * pn + wc;
    else if (pn < 4) gi = 21 + 4 * (pn - 2) + wc;
    else if (pn < 6) gi = 29 + 4 * (pn - 4) + wc;
    else if (pn < 8) gi = 41 + 4 * (pn - 6) + wc;
    else if (pn == 8) gi = 8 + wc;
    else if (pn == 9) gi = wc < 2 ? 12 + wc : 16 + (wc - 2);
    else if (pn == 10) gi = wc < 2 ? 14 + wc : 18 + (wc - 2);
    else if (pn == 11) gi = wc < 2 ? 37 + wc : 39 + (wc - 2);
    else { if (wc != 0) { NvGroup g; g.gain = nullptr; g.scale = 1.f; g.width = 0; g.type = 5; g.col = 0; g.col2 = 0; g.dkind = 0; g.dst = nullptr; g.ld = 0; g.idx = 0; return g; } gi = 20; }
    return nv_group1(P, gi);
}
constexpr int NTILE_IN0 = 14, NTILE_IN1 = 13;


struct EpiIn {
    static constexpr bool PERM = true, AFTER_DRAIN = false;
    KArgs P; int layer;
    __device__ __forceinline__ void operator()(const pg8::f32x4 (&acc)[2][2][4][2], const pg8::Unit& u, int wr, int wc, int fr, int fq) const {
        const NvGroup g = fast_group(P, layer, u.pn, wc);
        if (g.type == 5) return;
        const float* SSQ = (const float*)(P.ws + WS_SSQ);
        const bool do_km = (layer == 0 && g.type == 2 && u.pn >= 8);
        float gn[16], km[16];
#pragma unroll
        for (int i = 0; i < 16; ++i) { gn[i] = 1.f; km[i] = 0.f; }
        if (g.type == 2) {
#pragma unroll
            for (int bj = 0; bj < 2; ++bj)
#pragma unroll
                for (int i = 0; i < 8; ++i) gn[8 * bj + i] = g.gain[32 * bj + 8 * fq + i] * g.scale;
        }
#pragma unroll
        for (int ai = 0; ai < 2; ++ai)
#pragma unroll
            for (int m = 0; m < 4; ++m) {
                const int t = u.pm * 256 + ai * 128 + wr * 64 + m * 16 + fr, b = t >> 11, s = t & 2047;
                const float4* sq = (const float4*)(SSQ + (size_t)t * 16);
                const float4 q0 = sq[0], q1 = sq[1], q2 = sq[2], q3 = sq[3];
                const float ssq = ((q0.x + q0.y) + (q0.z + q0.w)) + ((q1.x + q1.y) + (q1.z + q1.w)) + ((q2.x + q2.y) + (q2.z + q2.w)) + ((q3.x + q3.y) + (q3.z + q3.w));
                const float rstd = 1.0f / sqrtf(ssq * (1.0f / DM) + EPSF);
                float v[16];
#pragma unroll
                for (int bj = 0; bj < 2; ++bj)
#pragma unroll
                    for (int n = 0; n < 2; ++n)
#pragma unroll
                        for (int r = 0; r < 4; ++r) v[8 * bj + 4 * n + r] = acc[ai][bj][m][n][r] * rstd;
                if (g.type == 4) {
                    pg8::u32x4 w;
                    float o[8];
#pragma unroll
                    for (int i = 0; i < 8; ++i) o[i] = v[i] * fast_sigmoid(v[8 + i]);
                    w.x = pg8::cvt_pk_bf16(o[0], o[1]); w.y = pg8::cvt_pk_bf16(o[2], o[3]); w.z = pg8::cvt_pk_bf16(o[4], o[5]); w.w = pg8::cvt_pk_bf16(o[6], o[7]);
                    *(pg8::u32x4*)((bf16_t*)g.dst + (size_t)t * 512 + g.col + 8 * fq) = w;
                    continue;
                }
                if (g.type == 3) {
                    if (fq < 3) {
                        float4 o0, o1;
                        o0.x = fast_sigmoid(v[0]); o0.y = fast_sigmoid(v[1]); o0.z = fast_sigmoid(v[2]); o0.w = fast_sigmoid(v[3]);
                        o1.x = fast_sigmoid(v[4]); o1.y = fast_sigmoid(v[5]); o1.z = fast_sigmoid(v[6]); o1.w = fast_sigmoid(v[7]);
                        float* gp = (float*)g.dst + (size_t)t * 32 + 8 * fq;
                        *(float4*)gp = o0; *(float4*)(gp + 4) = o1;
                    }
                    continue;
                }
                if (g.type == 1) {
#pragma unroll
                    for (int i = 0; i < 16; ++i) v[i] = fast_silu(v[i]);
                } else if (g.type == 2) {
                    float ss = 0.f;
#pragma unroll
                    for (int i = 0; i < 16; ++i) ss += v[i] * v[i];
                    ss += __shfl_xor(ss, 16); ss += __shfl_xor(ss, 32);
                    const float nrm = 1.0f / sqrtf(ss * (1.0f / 64) + EPSF);
#pragma unroll
                    for (int i = 0; i < 16; ++i) v[i] = v[i] * nrm * gn[i];
                    if (do_km) {
#pragma unroll
                        for (int i = 0; i < 16; ++i) km[i] += v[i];
                    }
                }
                bf16_t* dp = g.dkind == 0 ? (bf16_t*)g.dst + (size_t)t * g.ld + g.idx * 64 + 8 * fq
                                          : (bf16_t*)g.dst + ((size_t)(b * g.ld + g.idx) * SEQ + s) * 64 + 8 * fq;
#pragma unroll
                for (int bj = 0; bj < 2; ++bj) {
                    pg8::u32x4 w;
                    w.x = pg8::cvt_pk_bf16(v[8 * bj + 0], v[8 * bj + 1]); w.y = pg8::cvt_pk_bf16(v[8 * bj + 2], v[8 * bj + 3]);
                    w.z = pg8::cvt_pk_bf16(v[8 * bj + 4], v[8 * bj + 5]); w.w = pg8::cvt_pk_bf16(v[8 * bj + 6], v[8 * bj + 7]);
                    *(pg8::u32x4*)(dp + 32 * bj) = w;
                }
            }
        if (do_km) {
#pragma unroll
            for (int i = 0; i < 16; ++i) { float a = km[i]; a += __shfl_xor(a, 1); a += __shfl_xor(a, 2); a += __shfl_xor(a, 4); a += __shfl_xor(a, 8); km[i] = a * (1.0f / 256); }
            if (fr == 0) {
                float* kp = (float*)(P.ws + WS_KMP) + ((size_t)wr * 64 + u.pm) * 512 + g.idx * 64 + 8 * fq;
#pragma unroll
                for (int bj = 0; bj < 2; ++bj) {
                    float4 o0, o1; o0.x = km[8 * bj + 0]; o0.y = km[8 * bj + 1]; o0.z = km[8 * bj + 2]; o0.w = km[8 * bj + 3];
                    o1.x = km[8 * bj + 4]; o1.y = km[8 * bj + 5]; o1.z = km[8 * bj + 6]; o1.w = km[8 * bj + 7];
                    *(float4*)(kp + 32 * bj) = o0; *(float4*)(kp + 32 * bj + 4) = o1;
                }
            }
        }
    }
};

struct EpiOut {
    static constexpr bool PERM = true, AFTER_DRAIN = false;
    const float* res; float* out; bf16_t* XB; float* SSQ; int layer;
    __device__ __forceinline__ void operator()(const pg8::f32x4 (&acc)[2][2][4][2], const pg8::Unit& u, int wr, int wc, int fr, int fq) const {
        const int col0 = u.pn * 256 + wc * 32 + 8 * fq;
#pragma unroll
        for (int ai = 0; ai < 2; ++ai)
#pragma unroll
            for (int m = 0; m < 4; ++m) {
                const int t = u.pm * 256 + ai * 128 + wr * 64 + m * 16 + fr;
                float ss = 0.f;
#pragma unroll
                for (int bj = 0; bj < 2; ++bj) {
                    const size_t o = (size_t)t * DM + col0 + 128 * bj;
                    const pg8::f32x4 r0 = *(const pg8::f32x4*)(res + o), r1 = *(const pg8::f32x4*)(res + o + 4);
                    const pg8::f32x4 x0 = r0 + acc[ai][bj][m][0], x1 = r1 + acc[ai][bj][m][1];
                    *(pg8::f32x4*)(out + o) = x0; *(pg8::f32x4*)(out + o + 4) = x1;
                    if (layer == 0) {
                        pg8::u32x4 w; w.x = pg8::cvt_pk_bf16(x0[0], x0[1]); w.y = pg8::cvt_pk_bf16(x0[2], x0[3]); w.z = pg8::cvt_pk_bf16(x1[0], x1[1]); w.w = pg8::cvt_pk_bf16(x1[2], x1[3]);
                        *(pg8::u32x4*)(XB + o) = w;
                        ss += (x0[0] * x0[0] + x0[1] * x0[1]) + (x0[2] * x0[2] + x0[3] * x0[3]) + (x1[0] * x1[0] + x1[1] * x1[1]) + (x1[2] * x1[2] + x1[3] * x1[3]);
                    }
                }
                if (layer == 0) { ss += __shfl_xor(ss, 16); ss += __shfl_xor(ss, 32); if (fq == 0) SSQ[(size_t)t * 16 + u.pn * 4 + wc] = ss; }
            }
    }
};

__device__ __forceinline__ void cvt_item(const float* __restrict__ W, int ldw, const float* __restrict__ gain, bf16_t* __restrict__ Bt, int Kd, int k0, int drow0, int src0, int vw, LAS float* scr, int lane) {
#pragma unroll 8
    for (int i = 0; i < 32; ++i) { const int kk = 2 * i + (lane >> 5), c = lane & 31;
        float v = 0.f; if (c < vw) { v = W[(size_t)(k0 + kk) * ldw + src0 + c]; if (gain) v *= gain[k0 + kk]; }
        scr[kk * 33 + c] = v; }
    LDS_WAIT(); asm volatile("" ::: "memory");
    const int c = lane & 7;
#pragma unroll
    for (int j = 0; j < 4; ++j) { const int n = (lane >> 3) + 8 * j; const LAS float* s = scr + (8 * c) * 33 + n;
        v4u o; o.x = pk2(s[0 * 33], s[1 * 33]); o.y = pk2(s[2 * 33], s[3 * 33]); o.z = pk2(s[4 * 33], s[5 * 33]); o.w = pk2(s[6 * 33], s[7 * 33]);
        *(v4u*)(Bt + (size_t)(drow0 + n) * Kd + k0 + 8 * c) = o; }
    LDS_WAIT(); asm volatile("" ::: "memory");
}
__device__ __forceinline__ void cvt_in_item(const KArgs& P, int layer, int it, LAS float* scr, int lane) {
    const int kb = it & 15, blk = it >> 4, pn = blk >> 3, pb = blk & 7, wc = pb & 3, bj = pb >> 2;
    const NvGroup g = fast_group(P, layer, pn, wc);
    int src0 = 0, vw = 0;
    if (g.type == 4) { src0 = bj ? g.col2 : g.col; vw = 32; }
    else if (g.type != 5) { src0 = g.col + 32 * bj; vw = g.width - 32 * bj; vw = vw < 0 ? 0 : (vw > 32 ? 32 : vw); }
    const float* W = layer == 0 ? P.e_w_in : P.o_w_in; const int ldw = layer == 0 ? 3584 : 3096;
    bf16_t* Bt = (bf16_t*)(P.ws + (layer == 0 ? WS_WIN0 : WS_WIN1));
    cvt_item(W, ldw, P.norm_g + layer * DM, Bt, DM, 64 * kb, 256 * pn + 128 * bj + 32 * wc, src0, vw, scr, lane);
}
__device__ __forceinline__ void p0_prologue(const KArgs& P, LAS unsigned char* lds, int vcu, int G, int wave, int lane) {
    LAS float* scr = (LAS float*)(lds + wave * 16384);
    const int gw = vcu * 8 + wave, NGW = G * 8;
    constexpr int I_IN0 = NTILE_IN0 * 8 * 16, I_IN1 = NTILE_IN1 * 8 * 16, I_OUT = 32 * 16, I_W1 = 8 * 32, I_W2 = 2 * 4;
    constexpr int I_B1P = 128;
    constexpr int NITEMS = I_B1P + I_IN0 + I_IN1 + 2 * I_OUT + 2 * I_W1 + 2 * I_W2;
    for (int it = gw; it < NITEMS; it += NGW) {
        int r = it;
        if (r < I_B1P) { fm::b1p_item(P, r, lane); continue; } r -= I_B1P;
        if (r < I_IN0) { cvt_in_item(P, 0, r, scr, lane); continue; } r -= I_IN0;
        if (r < I_IN1) { cvt_in_item(P, 1, r, scr, lane); continue; } r -= I_IN1;
        if (r < 2 * I_OUT) { const int l = r / I_OUT; r -= l * I_OUT; const int kb = r & 15, nb = r >> 4;
            cvt_item(P.w_out + (size_t)l * DM * DM, DM, nullptr, (bf16_t*)(P.ws + (l == 0 ? WS_WOUT0 : WS_WOUT1)), DM, 64 * kb, 32 * nb, 32 * nb, 32, scr, lane); continue; }
        r -= 2 * I_OUT;
        if (r < 2 * I_W1) { const int kv = r / I_W1; r -= kv * I_W1; const int kb = r & 31, nb = r >> 5;
            cvt_item(kv == 0 ? P.c_k_w1 : P.c_v_w1, 256, nullptr, (bf16_t*)(P.ws + WS_CW1) + (size_t)kv * 256 * 2048, 2048, 64 * kb, 32 * nb, 32 * nb, 32, scr, lane); continue; }
        r -= 2 * I_W1;
        { const int kv = r / I_W2; r -= kv * I_W2; const int kb = r & 3, nb = r >> 2;
            cvt_item(kv == 0 ? P.c_k_w2 : P.c_v_w2, 64, nullptr, (bf16_t*)(P.ws + WS_CW2) + (size_t)kv * 64 * 256, 256, 64 * kb, 32 * nb, 32 * nb, 32, scr, lane); }
    }
    bf16_t* XB = (bf16_t*)(P.ws + WS_XB); float* SSQ = (float*)(P.ws + WS_SSQ);
    for (int m = gw; m < NT; m += NGW) {
        const float4* r = (const float4*)(P.x + (size_t)m * DM);
        float s = 0.f;
#pragma unroll
        for (int j = 0; j < 4; ++j) {
            const float4 v = r[lane + 64 * j];
            s += v.x * v.x + v.y * v.y + v.z * v.z + v.w * v.w;
            uint2 o; o.x = pg8::cvt_pk_bf16(v.x, v.y); o.y = pg8::cvt_pk_bf16(v.z, v.w);
            *(uint2*)(XB + (size_t)m * DM + (lane + 64 * j) * 4) = o;
        }
#pragma unroll
        for (int o = 1; o < 64; o <<= 1) s += __shfl_xor(s, o);
        if (lane < 4) { float4 q; q.x = lane == 0 ? s : 0.f; q.y = 0.f; q.z = 0.f; q.w = 0.f; *(float4*)(SSQ + (size_t)m * 16 + lane * 4) = q; }
    }
}

constexpr int RING_BYTES = 131072, LDSCTL_OFF = RING_BYTES, MISC_OFF = LDSCTL_OFF + 320, LDS_BYTES = 147456;
constexpr int CW_BAR = 4096;
constexpr int NPHASE = 8;

__global__ void __launch_bounds__(512, 2) mk_fwd(KArgs P) {
    extern __shared__ __attribute__((aligned(16))) unsigned char lds_raw[];
    LAS unsigned char* lds = (LAS unsigned char*)lds_raw;
    volatile LAS unsigned* MISC = (volatile LAS unsigned*)(lds + MISC_OFF);
    const int tid = threadIdx.x, lane = tid & 63, wave = __builtin_amdgcn_readfirstlane(tid >> 6);
    const int G = gridDim.x, bx = blockIdx.x, vcu = (G % 8 == 0) ? (bx % 8) * (G / 8) + bx / 8 : bx;
    for (int u = tid; u < (LDS_BYTES - LDSCTL_OFF) / 4; u += 512) ((LAS unsigned*)(lds + LDSCTL_OFF))[u] = 0u;
    __syncthreads();
    const int lo = P.ph_lo, hi = P.ph_hi;
    XcdBarrier bar; bar.bar = (unsigned*)(P.ws + WS_CTL) + CW_BAR; bar.x = 0; bar.st = nullptr;
    if (hi - lo > 1) bar = xcd_barrier_post((unsigned*)(P.ws + WS_CTL) + CW_BAR, MISC + 8);
#define IN(k) (lo <= (k) && (k) < hi)
#define SEAM(k) do { if (IN(k) && IN((k) + 1)) xcd_barrier(bar); } while (0)

    if (IN(0)) { p0_prologue(P, lds, vcu, G, wave, lane); SEAM(0); }
    if (IN(1)) {
        pg8::Gemm g{(const bf16_t*)(P.ws + WS_XB), (const bf16_t*)(P.ws + WS_WIN0), NT, NTILE_IN0 * 256, DM}; pg8::StaticOrder S; S.init(NT, NTILE_IN0 * 256, G, bx);
        EpiIn E{P, 0};
        pg8::gemm_phase<EpiIn, pg8::StaticOrder, true, true>(lds, g, S, E);
        SEAM(1);
    }
    if (IN(2)) {
        if (P.flags & 1) for (int k = vcu; k < 512; k += G) { const int kk = k < 256 ? k : k - 256, bh = kk >> 2, own = k < 256 ? 7 - (kk & 3) : (kk & 3);
            fa::moba_unit(P, (fa::lds_ptr)lds, bh >> 3, bh & 7, own, wave, lane); }
        if (P.flags & 8) fm::conv_phase(P, lds, vcu, G, tid, wave, lane);
        SEAM(2);
    }
    if (IN(3)) {
        pg8::Gemm g{(const bf16_t*)(P.ws + WS_Y), (const bf16_t*)(P.ws + WS_WOUT0), NT, DM, DM}; pg8::StaticOrder S; S.init(NT, DM, G, bx);
        EpiOut E{P.x, P.out, (bf16_t*)(P.ws + WS_XB), (float*)(P.ws + WS_SSQ), 0};
        pg8::gemm_phase<EpiOut, pg8::StaticOrder, true, true>(lds, g, S, E);
        SEAM(3);
    }
    if (IN(4)) {
        pg8::Gemm g{(const bf16_t*)(P.ws + WS_XB), (const bf16_t*)(P.ws + WS_WIN1), NT, NTILE_IN1 * 256, DM}; pg8::StaticOrder S; S.init(NT, NTILE_IN1 * 256, G, bx);
        EpiIn E{P, 1};
        pg8::gemm_phase<EpiIn, pg8::StaticOrder, true, true>(lds, g, S, E);
        SEAM(4);
    }
    if (IN(5)) {
        if (P.flags & 16) for (int k = vcu; k < 256; k += G) fm::cmp_unit(P, lds, k, tid, wave, lane);
        SEAM(5);
    }
    if (IN(6)) {
        if (P.flags & 2) for (int k = vcu; k < 512; k += G) { const int kk = k < 256 ? k : k - 256, bg = kk >> 4, c = k < 256 ? 31 - (kk & 15) : (kk & 15);
            fa::nsa_unit(P, (fa::lds_ptr)lds, bg >> 1, bg & 1, c, wave, lane, tid); }
        if (P.flags & 4) for (int k = vcu; k < 512; k += G) { const int kk = k < 256 ? k : k - 256, bg = kk >> 4, c = k < 256 ? 31 - (kk & 15) : (kk & 15);
            fa::swa_unit(P, (fa::lds_ptr)lds, bg >> 1, bg & 1, c, wave, lane); }
        SEAM(6);
    }
    if (IN(7)) {
        pg8::Gemm g{(const bf16_t*)(P.ws + WS_Y), (const bf16_t*)(P.ws + WS_WOUT1), NT, DM, DM}; pg8::StaticOrder S; S.init(NT, DM, G, bx);
        EpiOut E{P.out, P.out, nullptr, nullptr, 1};
        pg8::gemm_phase<EpiOut, pg8::StaticOrder, true, true>(lds, g, S, E);
    }
#undef IN
#undef SEAM
}
static void fill_args(KArgs& a, void* const* d_in, void* d_out, void* d_ws) {
    const float** p = (const float**)&a;
    for (int i = 0; i < 28; ++i) p[i] = (const float*)d_in[i];
    a.out = (float*)d_out; a.ws = (unsigned char*)d_ws; a.ph_lo = 0; a.ph_hi = NPHASE; a.flags = 31; a.pad = 0;
}
static int g_grid = 0;
extern "C" void kernel_launch(void* const* d_in, const int* in_sizes, int n_in, void* d_out, int out_size, void* d_ws, size_t ws_size, hipStream_t stream) {
    if (n_in != 28 || out_size != NT * DM || ws_size < WS_END) { fprintf(stderr, "kernel_launch: unexpected shapes n_in %d out %d ws %zu\n", n_in, out_size, ws_size); return; }
    if (g_grid == 0) {
        int dev = 0, cus = 0;
        if (hipGetDevice(&dev) != hipSuccess || hipDeviceGetAttribute(&cus, hipDeviceAttributeMultiprocessorCount, dev) != hipSuccess) { fprintf(stderr, "kernel_launch: device query failed\n"); g_grid = -1; return; }
        if (hipFuncSetAttribute((const void*)mk_fwd, hipFuncAttributeMaxDynamicSharedMemorySize, LDS_BYTES) != hipSuccess) { fprintf(stderr, "kernel_launch: hipFuncSetAttribute failed\n"); g_grid = -1; return; }
        int per_cu = 0;
        if (hipOccupancyMaxActiveBlocksPerMultiprocessor(&per_cu, (const void*)mk_fwd, 512, LDS_BYTES) != hipSuccess || per_cu < 1) { fprintf(stderr, "kernel_launch: occupancy query says %d blocks/CU\n", per_cu); }
        (void)hipGetLastError();
        g_grid = cus;
    }
    if (g_grid < 0) return;
    KArgs a{}; fill_args(a, d_in, d_out, d_ws);
    (void)hipMemsetAsync((char*)d_ws + WS_CTL, 0, 64 * 1024, stream);
    hipLaunchKernelGGL(mk_fwd, dim3(g_grid), dim3(512), LDS_BYTES, stream, a);
}
```

```cpp
#include <hip/hip_runtime.h>
#include <stdint.h>
#include <stdio.h>

typedef unsigned short bf16_t;
constexpr int NB = 8, SEQ = 2048, NT = NB * SEQ, DM = 1024;
#define EPSF 1e-6f
#define LOG2E 1.4426950408889634f
#define QSCALE (0.125f * 1.4426950408889634f)

constexpr size_t MiB = 1u << 20;
constexpr size_t WS_CTL = 0, WS_SSQ = 5 * MiB, WS_KMP = 1 * MiB + 512 * 1024, WS_B1P = 1 * MiB + 768 * 1024, WS_GT = 2 * MiB, WS_KC = 4 * MiB, WS_VC = 4 * MiB + 256 * 1024;
constexpr size_t WS_WIN0 = 6 * MiB, WS_WOUT0 = 13 * MiB, WS_WIN1 = 15 * MiB, WS_WOUT1 = 22 * MiB, WS_CW1 = 24 * MiB, WS_CW2 = 26 * MiB, WS_WGATE = 27 * MiB;
constexpr size_t WS_XB = 32 * MiB, WS_Y = 64 * MiB;
constexpr size_t WS_G0 = 96 * MiB, WS_ZA = 112 * MiB, WS_QB = 128 * MiB, WS_KB = 144 * MiB, WS_VB = 160 * MiB, WS_ZB = 176 * MiB;
constexpr size_t WS_QC = 96 * MiB, WS_ZC = 112 * MiB, WS_QD = 128 * MiB, WS_ZD = 144 * MiB;
constexpr size_t WS_KCR = 160 * MiB, WS_VCR = 164 * MiB, WS_KS = 168 * MiB, WS_VS = 172 * MiB, WS_KW = 176 * MiB, WS_VW = 180 * MiB, WS_KD = 184 * MiB, WS_VD = 188 * MiB;
constexpr size_t WS_NVTMP = 192 * MiB, WS_END = 200 * MiB;

struct KArgs {
    const float *x, *norm_g, *w_out, *e_w_in, *a_conv_w, *a_conv_b, *a_ln_g, *a_ln_b, *b_qnorm_g, *b_knorm_g, *o_w_in, *c_qnorm_g, *c_knorm_cmp_g, *c_knorm_slc_g,
        *c_knorm_win_g, *c_pos_k, *c_pos_v, *c_k_w1, *c_k_b1, *c_k_w2, *c_k_b2, *c_v_w1, *c_v_b1, *c_v_w2, *c_v_b2, *d_qnorm_g, *d_knorm_g, *d_sinks;
    float* out; unsigned char* ws;
    int ph_lo, ph_hi, flags, pad;
};

__device__ __forceinline__ float bf2f(unsigned v) { return __uint_as_float(v << 16); }
__device__ __forceinline__ unsigned f2bf_u(float f) { unsigned u = __float_as_uint(f); return (u + 0x7fffu + ((u >> 16) & 1u)) >> 16; }
__device__ __forceinline__ bf16_t f2bf(float f) { return (bf16_t)f2bf_u(f); }
__device__ __forceinline__ unsigned pk2(float lo, float hi) { return f2bf_u(lo) | (f2bf_u(hi) << 16); }
__device__ __forceinline__ float fast_silu(float v) { return v * __builtin_amdgcn_rcpf(1.f + __expf(-v)); }
__device__ __forceinline__ float fast_sigmoid(float v) { return __builtin_amdgcn_rcpf(1.f + __expf(-v)); }
struct NvGroup { int col, width, type; const float* gain; float scale; int dkind; void* dst; int ld, idx, col2; };

__device__ __forceinline__ NvGroup nv_group0(const KArgs& P, int gi) {
    NvGroup g; g.gain = nullptr; g.scale = 1.f; g.col2 = 0; g.width = 64;
    const int j = gi & 7;
    switch (gi >> 3) {
    case 0: g.col = 64 * j; g.col2 = 512 + 64 * j; g.type = 4; g.dkind = 0; g.dst = P.ws + WS_G0; g.ld = 512; g.idx = j; break;
    case 1: g.col = 1024 + 64 * j; g.type = 1; g.dkind = 0; g.dst = P.ws + WS_ZA; g.ld = 512; g.idx = j; break;
    case 2: g.col = 1536 + 64 * j; g.type = 2; g.gain = P.b_qnorm_g; g.scale = QSCALE; g.dkind = 1; g.dst = P.ws + WS_QB; g.ld = 8; g.idx = j; break;
    case 3: g.col = 2048 + 64 * j; g.type = 2; g.gain = P.b_knorm_g; g.dkind = 1; g.dst = P.ws + WS_KB; g.ld = 8; g.idx = j; break;
    case 4: g.col = 2560 + 64 * j; g.type = 0; g.dkind = 1; g.dst = P.ws + WS_VB; g.ld = 8; g.idx = j; break;
    default: g.col = 3072 + 64 * j; g.type = 1; g.dkind = 0; g.dst = P.ws + WS_ZB; g.ld = 512; g.idx = j; break;
    }
    return g;
}
__device__ __forceinline__ NvGroup nv_group1(const KArgs& P, int gi) {
    NvGroup g; g.gain = nullptr; g.scale = 1.f; g.col2 = 0; g.width = 64;
    if (gi < 8) { g.col = 64 * gi; g.type = 2; g.gain = P.c_qnorm_g; g.scale = QSCALE; g.dkind = 1; g.dst = P.ws + WS_QC; g.ld = 8; g.idx = gi; return g; }
    gi -= 8;
    if (gi < 12) {
        const int which = gi >> 1, hh = gi & 1;
        g.col = 512 + 128 * which + 64 * hh; g.dkind = 1; g.ld = 2; g.idx = hh;
        g.dst = P.ws + (which == 0 ? WS_KCR : which == 1 ? WS_VCR : which == 2 ? WS_KS : which == 3 ? WS_VS : which == 4 ? WS_KW : WS_VW);
        if (which == 2) { g.type = 2; g.gain = P.c_knorm_slc_g; } else if (which == 4) { g.type = 2; g.gain = P.c_knorm_win_g; } else g.type = 0;
        return g;
    }
    gi -= 12;
    if (gi < 1) { g.col = 1280; g.width = 24; g.type = 3; g.dkind = 2; g.dst = P.ws + WS_GT; g.ld = 32; g.idx = 0; return g; }
    gi -= 1;
    if (gi < 8) { g.col = 1304 + 64 * gi; g.type = 1; g.dkind = 0; g.dst = P.ws + WS_ZC; g.ld = 512; g.idx = gi; return g; }
    gi -= 8;
    if (gi < 8) { g.col = 1816 + 64 * gi; g.type = 2; g.gain = P.d_qnorm_g; g.scale = QSCALE; g.dkind = 1; g.dst = P.ws + WS_QD; g.ld = 8; g.idx = gi; return g; }
    gi -= 8;
    if (gi < 2) { g.col = 2328 + 64 * gi; g.type = 2; g.gain = P.d_knorm_g; g.dkind = 1; g.dst = P.ws + WS_KD; g.ld = 2; g.idx = gi; return g; }
    gi -= 2;
    if (gi < 2) { g.col = 2456 + 64 * gi; g.type = 0; g.dkind = 1; g.dst = P.ws + WS_VD; g.ld = 2; g.idx = gi; return g; }
    gi -= 2;
    g.col = 2584 + 64 * gi; g.type = 1; g.dkind = 0; g.dst = P.ws + WS_ZD; g.ld = 512; g.idx = gi; return g;
}
namespace pg8 {
#define PG8_LAS __attribute__((address_space(3)))
typedef short bf16x8 __attribute__((ext_vector_type(8)));
typedef float f32x4 __attribute__((ext_vector_type(4)));
typedef unsigned u32x4 __attribute__((ext_vector_type(4)));
constexpr int BM = 256, BK = 64, HALF = 128, HTB = HALF * BK * 2  , STAGE_BYTES = 8 * HTB, NXCD = 8, WGM = 8;

__host__ __device__ __forceinline__ int lds_byte(int r, int c) { const int st = (r >> 4) * 2 + (c >> 5), rr = r & 15, cc = c & 31, ob = rr * 64 + cc * 2; return st * 1024 + (ob ^ (((ob >> 9) & 1) << 5)); }
__host__ __device__ __forceinline__ void stage_rc(int b, int& R, int& C) { const int st = b / 1024, sb = b % 1024, swz = sb ^ (((sb >> 9) & 1) << 5); R = (st >> 1) * 16 + swz / 64; C = (st & 1) * 32 + (swz % 64) / 2; }
__host__ __device__ __forceinline__ int perm32(int rho) { const int n = rho >> 4, i = rho & 15; return 8 * (i >> 2) + 4 * n + (i & 3); }

struct Unit { int pm, pn; };
struct Gemm { const bf16_t* A; const bf16_t* Bt; int M, N, K; };

struct StaticOrder {
    int nM, nN, nwg, G, c;
    __host__ __device__ void init(int M, int N, int G_, int c_) { nM = M / BM; nN = N / BM; nwg = nM * nN; G = G_; c = c_; }
    __host__ __device__ bool next(int i, Unit& u) const {
        const long L = (long)i * G + c; if (L >= nwg) return false;
        int wgid = (int)L; { const int q = nwg / NXCD, r = nwg % NXCD, xcd = wgid % NXCD, off = wgid / NXCD; wgid = (xcd < r ? xcd * (q + 1) : r * (q + 1) + (xcd - r) * q) + off; }
        const int nig = WGM * nN, gid = wgid / nig, fm = gid * WGM, gsz = (nM - fm) < WGM ? (nM - fm) : WGM;
        u.pm = fm + ((wgid % nig) % gsz); u.pn = (wgid % nig) / gsz; return true;
    }
    __device__ __forceinline__ void a_ready(const Unit&) const {}
    __device__ __forceinline__ void done(const Unit&) const {}
};

__device__ __forceinline__ unsigned cvt_pk_bf16(float lo, float hi) { unsigned r; asm volatile("v_cvt_pk_bf16_f32 %0, %1, %2" : "=v"(r) : "v"(lo), "v"(hi)); return r; }
template <class Epi, class Sched, bool ALIGN_EPI = false, bool SP2 = false>
__device__ __forceinline__ void gemm_phase(PG8_LAS unsigned char* lds, const Gemm g, const Sched& S, const Epi& E) {
    const int tid = threadIdx.x, wid = __builtin_amdgcn_readfirstlane(tid >> 6), lane = tid & 63, wr = wid >> 2, wc = wid & 3, fr = lane & 15, fq = lane >> 4;
    const int K = g.K, nt = K / BK;
    unsigned voffA[2], voffB[2];
#pragma unroll
    for (int i = 0; i < 2; ++i) { int R, C; stage_rc(tid * 16 + i * 8192, R, C); const int Rb = Epi::PERM ? ((R & ~31) + perm32(R & 31)) : R;
        voffA[i] = (unsigned)(R * K + C) * 2u; voffB[i] = (unsigned)(Rb * K + C) * 2u; }
    const size_t kstep = (size_t)(BK * 2);
    const size_t hstep = (size_t)HALF * K * 2;
    const size_t tstep = 2 * hstep;
    const unsigned ldsw = (unsigned)wid * 1024u;
    const int aoff = lds_byte(wr * 64 + fr, fq * 8), boff = lds_byte(wc * 32 + fr, fq * 8);
#define PG8_SA(b, h) (((b) * 2 + (h)) * HTB)
#define PG8_SB(b, h) ((4 + (b) * 2 + (h)) * HTB)
#define PG8_STAGE(bufoff, gbase, voff) do { _Pragma("unroll") for (int _i = 0; _i < 2; ++_i) \
        __builtin_amdgcn_global_load_lds((const unsigned*)((const char*)(gbase) + (voff)[_i]), (PG8_LAS unsigned*)(lds + (bufoff) + ldsw + _i * 8192), 16, 0, 0); } while (0)
#define PG8_LDA(dst, b, h) do { _Pragma("unroll") for (int m = 0; m < 4; ++m) _Pragma("unroll") for (int k = 0; k < 2; ++k) dst[m][k] = *(const PG8_LAS bf16x8*)(lds + PG8_SA(b, h) + aoff + m * 2048 + k * 1024); } while (0)
#define PG8_LDB(dst, b, h) do { _Pragma("unroll") for (int n = 0; n < 2; ++n) _Pragma("unroll") for (int k = 0; k < 2; ++k) dst[n][k] = *(const PG8_LAS bf16x8*)(lds + PG8_SB(b, h) + boff + n * 2048 + k * 1024); } while (0)
#define PG8_MMA(ai, bj, At, Bt) do { __builtin_amdgcn_s_setprio(1); _Pragma("unroll") for (int m = 0; m < 4; ++m) _Pragma("unroll") for (int n = 0; n < 2; ++n) _Pragma("unroll") for (int k = 0; k < 2; ++k) \
        acc[ai][bj][m][n] = __builtin_amdgcn_mfma_f32_16x16x32_bf16(Bt[n][k], At[m][k], acc[ai][bj][m][n], 0, 0, 0); __builtin_amdgcn_s_setprio(0); } while (0)
#define PG8_WAIT_V(n) asm volatile("s_waitcnt vmcnt(" #n ")" ::: "memory")
#define PG8_WAIT_L(n) asm volatile("s_waitcnt lgkmcnt(" #n ")" ::: "memory")
#define PG8_BAR __builtin_amdgcn_s_barrier()
#define PG8_SCHED __builtin_amdgcn_sched_barrier(0)
    Unit cur, nxt; int ui = 0;
    if (!S.next(0, cur)) return;
    f32x4 acc[2][2][4][2];
#pragma unroll
    for (int a = 0; a < 2; ++a)
#pragma unroll
        for (int b = 0; b < 2; ++b)
#pragma unroll
            for (int m = 0; m < 4; ++m)
#pragma unroll
                for (int n = 0; n < 2; ++n) acc[a][b][m][n] = (f32x4){0.f, 0.f, 0.f, 0.f};
    bf16x8 At[4][2], B0[2][2], B1[2][2];
    const char* cA = (const char*)g.A + (size_t)cur.pm * tstep; const char* cB = (const char*)g.Bt + (size_t)cur.pn * tstep;
    S.a_ready(cur);
    if constexpr (SP2) {
        PG8_STAGE(PG8_SB(0, 0), cB, voffB); PG8_STAGE(PG8_SB(0, 1), cB + hstep, voffB); PG8_STAGE(PG8_SA(0, 0), cA, voffA); PG8_STAGE(PG8_SA(0, 1), cA + hstep, voffA);
        if (wr == 1) PG8_BAR;
        PG8_WAIT_V(2); PG8_BAR;
        PG8_STAGE(PG8_SB(1, 0), cB + kstep, voffB); PG8_STAGE(PG8_SA(1, 0), cA + kstep, voffA); PG8_STAGE(PG8_SB(1, 1), cB + hstep + kstep, voffB);
        PG8_WAIT_V(6); PG8_BAR;
    } else {
        PG8_STAGE(PG8_SB(0, 0), cB, voffB); PG8_STAGE(PG8_SA(0, 0), cA, voffA); PG8_STAGE(PG8_SB(0, 1), cB + hstep, voffB); PG8_STAGE(PG8_SA(0, 1), cA + hstep, voffA);
        if (wr == 1) PG8_BAR;
        PG8_WAIT_V(4); PG8_BAR;
        PG8_STAGE(PG8_SB(1, 0), cB + kstep, voffB); PG8_STAGE(PG8_SA(1, 0), cA + kstep, voffA); PG8_STAGE(PG8_SB(1, 1), cB + hstep + kstep, voffB);
        PG8_WAIT_V(6); PG8_BAR;
    }
    for (;;) {
        const bool has_next = S.next(ui + 1, nxt);
        const char* nA = has_next ? (const char*)g.A + (size_t)nxt.pm * tstep : cA; const char* nB = has_next ? (const char*)g.Bt + (size_t)nxt.pn * tstep : cB;
        for (int t = 0; t < nt; t += 2) {
            const bool last = (t == nt - 2);
            const char* a1 = cA + (size_t)(t + 1) * kstep;
            const char* a2 = last ? nA : cA + (size_t)(t + 2) * kstep; const char* b2 = last ? nB : cB + (size_t)(t + 2) * kstep;
            const char* a3 = a2 + kstep; const char* b3 = b2 + kstep;
            if (last && has_next) S.a_ready(nxt);
            if constexpr (SP2) {
            PG8_LDB(B0, 0, 0); PG8_LDB(B1, 0, 1); PG8_SCHED; PG8_LDA(At, 0, 0); PG8_STAGE(PG8_SA(1, 1), a1 + hstep, voffA);
            PG8_WAIT_V(8); PG8_WAIT_L(0); PG8_BAR; PG8_MMA(0, 0, At, B0); PG8_MMA(0, 1, At, B1); PG8_BAR; PG8_SCHED;
            PG8_LDA(At, 0, 1); PG8_STAGE(PG8_SB(0, 0), b2, voffB); PG8_STAGE(PG8_SB(0, 1), b2 + hstep, voffB); PG8_STAGE(PG8_SA(0, 0), a2, voffA);
            PG8_WAIT_V(8); PG8_WAIT_L(0); PG8_BAR; PG8_MMA(1, 0, At, B0); PG8_MMA(1, 1, At, B1); PG8_BAR; PG8_SCHED;
            PG8_LDB(B0, 1, 0); PG8_LDB(B1, 1, 1); PG8_SCHED; PG8_LDA(At, 1, 0); PG8_STAGE(PG8_SA(0, 1), a2 + hstep, voffA);
            PG8_WAIT_V(8); PG8_WAIT_L(0); PG8_BAR; PG8_MMA(0, 0, At, B0); PG8_MMA(0, 1, At, B1); PG8_BAR; PG8_SCHED;
            PG8_LDA(At, 1, 1); PG8_STAGE(PG8_SB(1, 0), b3, voffB); PG8_STAGE(PG8_SB(1, 1), b3 + hstep, voffB); PG8_STAGE(PG8_SA(1, 0), a3, voffA);
            PG8_WAIT_V(8); PG8_WAIT_L(0); PG8_BAR; PG8_MMA(1, 0, At, B0); PG8_MMA(1, 1, At, B1); PG8_BAR; PG8_SCHED;
            } else {
            PG8_LDB(B0, 0, 0); PG8_SCHED; PG8_LDA(At, 0, 0); PG8_STAGE(PG8_SA(1, 1), a1 + hstep, voffA);
            PG8_WAIT_L(8); PG8_BAR; PG8_WAIT_L(0); PG8_MMA(0, 0, At, B0); PG8_BAR; PG8_SCHED;
            PG8_LDB(B1, 0, 1); PG8_STAGE(PG8_SB(0, 0), b2, voffB);
            PG8_BAR; PG8_WAIT_L(0); PG8_MMA(0, 1, At, B1); PG8_BAR;
            PG8_LDA(At, 0, 1); PG8_STAGE(PG8_SA(0, 0), a2, voffA);
            PG8_BAR; PG8_WAIT_L(0); PG8_MMA(1, 0, At, B0); PG8_BAR; PG8_SCHED;
            PG8_STAGE(PG8_SB(0, 1), b2 + hstep, voffB);
            PG8_WAIT_V(6); PG8_BAR; PG8_MMA(1, 1, At, B1); PG8_BAR;
            PG8_LDB(B0, 1, 0); PG8_SCHED; PG8_LDA(At, 1, 0); PG8_STAGE(PG8_SA(0, 1), a2 + hstep, voffA);
            PG8_WAIT_L(8); PG8_BAR; PG8_WAIT_L(0); PG8_MMA(0, 0, At, B0); PG8_BAR; PG8_SCHED;
            PG8_LDB(B1, 1, 1); PG8_STAGE(PG8_SB(1, 0), b3, voffB);
            PG8_BAR; PG8_WAIT_L(0); PG8_MMA(0, 1, At, B1); PG8_BAR;
            PG8_LDA(At, 1, 1); PG8_STAGE(PG8_SA(1, 0), a3, voffA);
            PG8_BAR; PG8_WAIT_L(0); PG8_MMA(1, 0, At, B0); PG8_BAR; PG8_SCHED;
            PG8_STAGE(PG8_SB(1, 1), b3 + hstep, voffB);
            PG8_WAIT_V(6); PG8_BAR; PG8_MMA(1, 1, At, B1); PG8_BAR;
            }
        }
        if constexpr (ALIGN_EPI) { if (wr == 0) PG8_BAR; }
        if constexpr (!Epi::AFTER_DRAIN) { E(acc, cur, wr, wc, fr, fq); S.done(cur); }
        if (!has_next) break;
#pragma unroll
        for (int a = 0; a < 2; ++a)
#pragma unroll
            for (int b = 0; b < 2; ++b)
#pragma unroll
                for (int m = 0; m < 4; ++m)
#pragma unroll
                    for (int n = 0; n < 2; ++n) acc[a][b][m][n] = (f32x4){0.f, 0.f, 0.f, 0.f};
        cur = nxt; cA = nA; cB = nB; ++ui;
        if constexpr (ALIGN_EPI) { if (wr == 1) PG8_BAR; }
    }
    PG8_WAIT_V(0);
    if constexpr (!ALIGN_EPI) { if (wr == 0) PG8_BAR; }
    PG8_BAR;
    if constexpr (Epi::AFTER_DRAIN) { E.fused(acc, cur, wr, wc, fr, fq, lds, wid, lane); S.done(cur); }
#undef PG8_SA
#undef PG8_SB
#undef PG8_STAGE
#undef PG8_LDA
#undef PG8_LDB
#undef PG8_MMA
#undef PG8_WAIT_V
#undef PG8_WAIT_L
#undef PG8_BAR
#undef PG8_SCHED
}
}
#define GAS __attribute__((address_space(1)))
#define LAS __attribute__((address_space(3)))
typedef unsigned v4u __attribute__((ext_vector_type(4)));
typedef float f32x4 __attribute__((ext_vector_type(4)));
typedef short bf16x8 __attribute__((ext_vector_type(8)));
typedef GAS unsigned gu32;
typedef GAS unsigned long long gu64;
#define RLX_AGENT __ATOMIC_RELAXED, __HIP_MEMORY_SCOPE_AGENT
#define LDS_WAIT() asm volatile("s_waitcnt lgkmcnt(0)" ::: "memory")
#define VM_WAIT() asm volatile("s_waitcnt vmcnt(0)" ::: "memory")
__device__ __forceinline__ unsigned long long rt() { return __builtin_amdgcn_s_memrealtime(); }

#define XB_TMO      128
#define XB_XCNT(j)  (256  + 64 * (j))
#define XB_XSUB(j)  (1280 + 64 * (j))
#define XB_XGEN(j)  (2304 + 64 * (j))
#define XB_TOP      3328
#define XB_TOPGEN   3392
#define XCD_BAR_WORDS 3456
#define XB_SPIN_CAP (1u << 18)

__device__ __forceinline__ unsigned xb_ld(unsigned* p)              { return __hip_atomic_load(p, __ATOMIC_RELAXED, __HIP_MEMORY_SCOPE_AGENT); }
__device__ __forceinline__ unsigned xb_add(unsigned* p, unsigned v) { return __hip_atomic_fetch_add(p, v, __ATOMIC_RELAXED, __HIP_MEMORY_SCOPE_AGENT); }
__device__ __forceinline__ unsigned xb_xcc_id() { return (unsigned)__builtin_amdgcn_s_getreg((3 << 11) | 20) & 0xFu; }
#define XB_SPIN(cond, bar) do { unsigned _sp = 0; while (cond) { __builtin_amdgcn_s_sleep(1); \
    if ((++_sp & 255u) == 0u) { if (xb_ld(&(bar)[XB_TMO])) break; if (_sp > XB_SPIN_CAP) { atomicAdd(&(bar)[XB_TMO], 1u); break; } } } } while (0)

struct XcdBarrier {
    unsigned* bar; unsigned x;
    volatile LAS unsigned* st;
};

__device__ __forceinline__ XcdBarrier xcd_barrier_post(unsigned* bar, volatile LAS unsigned* st) {
    XcdBarrier b; b.bar = bar; b.x = xb_xcc_id(); b.st = st;
    if (threadIdx.x == 0) (void)xb_add(&bar[XB_XCNT(b.x)], 1u);
    return b;
}
__device__ __forceinline__ void xcd_barrier_complete(unsigned* bar, unsigned x, unsigned& nloc, unsigned& nx) {
    const unsigned G = gridDim.x * gridDim.y * gridDim.z;
    unsigned sum, cnt, mine, sp = 0u;
    for (;;) {
        sum = 0u; cnt = 0u; mine = 0u;
#pragma unroll
        for (unsigned j = 0; j < 16; ++j) { const unsigned c = xb_ld(&bar[XB_XCNT(j)]); sum += c; cnt += (c > 0u) ? 1u : 0u; mine = (j == x) ? c : mine; }
        if (sum == G) break;
        __builtin_amdgcn_s_sleep(1);
        if ((++sp & 255u) == 0u) { if (xb_ld(&bar[XB_TMO])) break; if (sp > XB_SPIN_CAP) { atomicAdd(&bar[XB_TMO], 1u); break; } }
    }
    nloc = mine > 0u ? mine : 1u; nx = cnt > 0u ? cnt : 1u;
}

__device__ __forceinline__ void xcd_barrier(const XcdBarrier& b) {
    asm volatile("s_waitcnt vmcnt(0)" ::: "memory");
    __syncthreads();
    if (threadIdx.x == 0) {
        unsigned* bar = b.bar;
        __builtin_amdgcn_s_waitcnt(0);
        unsigned nloc = b.st[0], nx = b.st[1];
        if (nloc == 0u) { xcd_barrier_complete(bar, b.x, nloc, nx); b.st[0] = nloc; b.st[1] = nx; }
        const unsigned old = xb_add(&bar[XB_XSUB(b.x)], 1u);
        const unsigned gen = old / nloc;
        if (old + 1u == (gen + 1u) * nloc) {
            __builtin_amdgcn_fence(__ATOMIC_RELEASE, "agent");
            asm volatile("s_waitcnt vmcnt(0)" ::: "memory");
            const unsigned og = xb_add(&bar[XB_TOP], 1u);
            const unsigned tg = og / nx;
            if (og + 1u == (tg + 1u) * nx) xb_add(&bar[XB_TOPGEN], 1u);
            else XB_SPIN(xb_ld(&bar[XB_TOPGEN]) == tg, bar);
            __builtin_amdgcn_fence(__ATOMIC_ACQUIRE, "agent");
            xb_add(&bar[XB_XGEN(b.x)], 1u);
            asm volatile("s_waitcnt vmcnt(0)" ::: "memory");
        } else {
            XB_SPIN(xb_ld(&bar[XB_XGEN(b.x)]) == gen, bar);
            __builtin_amdgcn_fence(__ATOMIC_ACQUIRE, "agent");
            asm volatile("s_waitcnt vmcnt(0)" ::: "memory");
        }
    }
    __syncthreads();
}

namespace fa {
typedef short bf16x8 __attribute__((ext_vector_type(8)));
typedef short s16x4 __attribute__((ext_vector_type(4)));
typedef float f32x16 __attribute__((ext_vector_type(16)));
typedef unsigned u32x4 __attribute__((ext_vector_type(4)));
typedef short v4i16_t __attribute__((ext_vector_type(4)));
typedef __attribute__((address_space(3))) const char* lds_cptr;
typedef __attribute__((address_space(3))) char* lds_ptr;

constexpr int NSLOT = 3, SLOTB = 8192;
constexpr int LDS_K = 0, LDS_V = NSLOT * SLOTB;
constexpr int LDS_IMP = 2 * NSLOT * SLOTB;
constexpr int LDS_IMPT = LDS_IMP + 4 * 64 * 33 * 4;
constexpr int LDS_SEL = 131072 - 256;
constexpr int LDS_OT = LDS_IMP;
static_assert(LDS_OT + 65536 <= LDS_SEL && LDS_IMPT + 64 * 33 * 4 <= LDS_SEL, "attention LDS map");

#define FA_NEG (-__builtin_inff())
__device__ __forceinline__ void glds16(const void* gsrc, unsigned lds_dst) { unsigned keep;
    asm volatile("s_mov_b32 %0, m0\n\ts_mov_b32 m0, %2\n\ts_nop 0\n\tglobal_load_lds_dwordx4 %1, off\n\ts_mov_b32 m0, %0" : "=&s"(keep) : "v"(gsrc), "s"(lds_dst) : "memory"); }
#define FA_WAIT_BAR(N) asm volatile("s_waitcnt vmcnt(" #N ") lgkmcnt(0)\n\ts_barrier" ::: "memory")
__device__ __forceinline__ s16x4 vtr(lds_cptr p) { return __builtin_bit_cast(s16x4, __builtin_amdgcn_ds_read_tr16_b64_v4i16((__attribute__((address_space(3))) v4i16_t*)p)); }
typedef float f32x2_t __attribute__((ext_vector_type(2))); typedef __bf16 bf16x2_t __attribute__((ext_vector_type(2)));
__device__ __forceinline__ unsigned cvtpk(float lo, float hi) { f32x2_t v = {lo, hi}; bf16x2_t b = __builtin_convertvector(v, bf16x2_t); return __builtin_bit_cast(unsigned, b); }

__device__ __forceinline__ unsigned char* launder(unsigned char* p) { asm volatile("" : "+s"(p)); return p; }
struct RowCtx {
    int hiAbs, loAbs;
    unsigned selmask; int selshift;
    float sk, lb;
};

__device__ __forceinline__ void qk_scores(lds_cptr kslot, int j, const bf16x8 (&qr)[4], const RowCtx& rc, int r32, int hi, int hk, int lk, bool rowok, f32x16& p0, f32x16& p1) {
    const float lbj = rc.sk * (float)(64 * j + 4 * hi) + rc.lb;
#pragma unroll
    for (int r = 0; r < 16; ++r) { const float c = (float)((r & 3) + 8 * (r >> 2)); p0[r] = __builtin_fmaf(rc.sk, c, lbj); p1[r] = __builtin_fmaf(rc.sk, c + 32.f, lbj); }
    const lds_cptr kp = kslot + hi * 1024 + r32 * 16;
#pragma unroll
    for (int d0 = 0; d0 < 4; ++d0) {
        const bf16x8 b0 = *(const __attribute__((address_space(3))) bf16x8*)(kp + d0 * 2048);
        const bf16x8 b1 = *(const __attribute__((address_space(3))) bf16x8*)(kp + d0 * 2048 + 512);
        p0 = __builtin_amdgcn_mfma_f32_32x32x16_bf16(b0, qr[d0], p0, 0, 0, 0);
        p1 = __builtin_amdgcn_mfma_f32_32x32x16_bf16(b1, qr[d0], p1, 0, 0, 0);
    }
    const bool full = (lk <= 0) && (hk >= 63);
    if (!__all(full)) {
        const int a = lk - 4 * hi, b = hk - 4 * hi;
#pragma unroll
        for (int r = 0; r < 16; ++r) { const int c = (r & 3) + 8 * (r >> 2);
            p0[r] = (c >= a && c <= b) ? p0[r] : FA_NEG; p1[r] = (c + 32 >= a && c + 32 <= b) ? p1[r] : FA_NEG; }
    }
    if (!__all(rowok)) {
#pragma unroll
        for (int r = 0; r < 16; ++r) { p0[r] = rowok ? p0[r] : FA_NEG; p1[r] = rowok ? p1[r] : FA_NEG; }
    }
}
__device__ __forceinline__ void pv_accum(lds_cptr vslot, const f32x16& p0, const f32x16& p1, int lane, int hi, f32x16 (&o)[2]) {
    u32x4 pw[4];
    pw[0] = (u32x4){cvtpk(p0[0], p0[1]), cvtpk(p0[2], p0[3]), cvtpk(p0[4], p0[5]), cvtpk(p0[6], p0[7])};
    pw[1] = (u32x4){cvtpk(p0[8], p0[9]), cvtpk(p0[10], p0[11]), cvtpk(p0[12], p0[13]), cvtpk(p0[14], p0[15])};
    pw[2] = (u32x4){cvtpk(p1[0], p1[1]), cvtpk(p1[2], p1[3]), cvtpk(p1[4], p1[5]), cvtpk(p1[6], p1[7])};
    pw[3] = (u32x4){cvtpk(p1[8], p1[9]), cvtpk(p1[10], p1[11]), cvtpk(p1[12], p1[13]), cvtpk(p1[14], p1[15])};
    const lds_cptr vp = vslot + ((lane >> 4) & 1) * 32 + (lane & 3) * 8 + (4 * hi + ((lane & 15) >> 2)) * 64;
#pragma unroll
    for (int d0 = 0; d0 < 2; ++d0)
#pragma unroll
        for (int ks = 0; ks < 4; ++ks) {
            const s16x4 lo = vtr(vp + d0 * 4096 + ks * 1024), hh = vtr(vp + d0 * 4096 + ks * 1024 + 512);
            const bf16x8 vf = (bf16x8){lo[0], lo[1], lo[2], lo[3], hh[0], hh[1], hh[2], hh[3]};
            o[d0] = __builtin_amdgcn_mfma_f32_32x32x16_bf16(vf, __builtin_bit_cast(bf16x8, pw[ks]), o[d0], 0, 0, 0);
        }
}
__device__ __forceinline__ float rowmax32(const f32x16& p0, const f32x16& p1) {
    float a = __builtin_fmaxf(p0[0], p1[0]);
#pragma unroll
    for (int r = 1; r < 16; ++r) a = __builtin_fmaxf(a, __builtin_fmaxf(p0[r], p1[r]));
    return __builtin_fmaxf(a, __shfl_xor(a, 32));
}
__device__ __forceinline__ void tile_compute(lds_cptr kslot, lds_cptr vslot, int j, const bf16x8 (&qr)[4], const RowCtx& rc, int lane, float& m, float& l, f32x16 (&o)[2]) {
    const int r32 = lane & 31, hi = lane >> 5;
    int hk = rc.hiAbs - 64 * j; hk = hk > 63 ? 63 : hk;
    int lk = rc.loAbs - 64 * j; lk = lk < 0 ? 0 : lk;
    const bool rowok = ((rc.selmask >> (j >> rc.selshift)) & 1u) != 0u;
    if (!__any(rowok && lk <= hk)) return;
    f32x16 p0, p1;
    qk_scores(kslot, j, qr, rc, r32, hi, hk, lk, rowok, p0, p1);
    const float mx = rowmax32(p0, p1);
    if (__any(mx > m)) {
        const float mn = __builtin_fmaxf(m, mx), al = __builtin_amdgcn_exp2f(m - mn);
        l *= al; m = mn;
#pragma unroll
        for (int r = 0; r < 16; ++r) { o[0][r] *= al; o[1][r] *= al; }
    }
    float sum = 0.f;
#pragma unroll
    for (int r = 0; r < 16; ++r) { p0[r] = __builtin_amdgcn_exp2f(p0[r] - m); p1[r] = __builtin_amdgcn_exp2f(p1[r] - m); sum += p0[r] + p1[r]; }
    l += sum;
    pv_accum(vslot, p0, p1, lane, hi, o);
}

__device__ __forceinline__ void attn_stream(lds_ptr ring, const bf16_t* Kb, const bf16_t* Vb, int jlo, int jhi, const bf16x8 (&qr)[4], const RowCtx& rc, int wid, int lane,
                                            float& m, float& l, f32x16 (&o)[2]) {
    const int nt = jhi - jlo;
    if (nt <= 0) return;
    const unsigned lds0 = (unsigned)(uintptr_t)ring;
    const bf16_t* ksrc = Kb + (size_t)lane * 64 + wid * 8;
    const bf16_t* vsrc = Vb + (size_t)(16 * (wid & 3) + (lane >> 2)) * 64 + (wid >> 2) * 32 + (lane & 3) * 8;
    const unsigned kdst = lds0 + LDS_K + wid * 1024, vdst = lds0 + LDS_V + wid * 1024;
#define FA_DMA(j_, so_) do { glds16(ksrc + (size_t)(j_) * 4096, (unsigned)__builtin_amdgcn_readfirstlane(kdst + (so_))); glds16(vsrc + (size_t)(j_) * 4096, (unsigned)__builtin_amdgcn_readfirstlane(vdst + (so_))); } while (0)
    FA_DMA(jlo, 0);
    if (nt > 1) FA_DMA(jlo + 1, SLOTB);
    int s_cur = 0, s_nn = 2 * SLOTB;
    for (int i = 0; i < nt; ++i) {
        if (i + 1 < nt) FA_WAIT_BAR(2); else FA_WAIT_BAR(0);
        if (i + 2 < nt) FA_DMA(jlo + i + 2, s_nn);
        tile_compute((lds_cptr)ring + LDS_K + s_cur, (lds_cptr)ring + LDS_V + s_cur, jlo + i, qr, rc, lane, m, l, o);
        s_cur = (s_cur == (NSLOT - 1) * SLOTB) ? 0 : s_cur + SLOTB;
        s_nn = (s_nn == (NSLOT - 1) * SLOTB) ? 0 : s_nn + SLOTB;
    }
    asm volatile("s_waitcnt lgkmcnt(0)\n\ts_barrier" ::: "memory");
#undef FA_DMA
}

struct RowCtx2 { int hiAbs, loAbs; unsigned selmask; int selshift; float slope2; int kp_mul, kp_off; };
#define FA_THR 16.0f
#define FA_SBAR() __builtin_amdgcn_sched_barrier(0)
__device__ __forceinline__ void attn_stream2(lds_ptr ring, const bf16_t* Kb, const bf16_t* Vb, int jlo, int jhi, const bf16x8 (&qr)[4], const RowCtx2& rc, int wid, int lane,
                                             float& m, float& l, f32x16 (&o)[2], bool chk) {
    const int nt = jhi - jlo;
    if (nt <= 0) return;
    const int r32 = lane & 31, hi = lane >> 5;
    const unsigned lds0 = (unsigned)(uintptr_t)ring;
    const bf16_t* ksrc = Kb + (size_t)lane * 64 + wid * 8;
    const bf16_t* vsrc = Vb + (size_t)(16 * (wid & 3) + (lane >> 2)) * 64 + (wid >> 2) * 32 + (lane & 3) * 8;
    const unsigned kdst = lds0 + LDS_K + wid * 1024, vdst = lds0 + LDS_V + wid * 1024;
#define FA_DMAK(j_, so_) glds16(ksrc + (size_t)(j_) * 4096, (unsigned)__builtin_amdgcn_readfirstlane(kdst + (so_)))
#define FA_DMAV(j_, so_) glds16(vsrc + (size_t)(j_) * 4096, (unsigned)__builtin_amdgcn_readfirstlane(vdst + (so_)))
    FA_DMAK(jlo, 0);
    if (nt > 1) FA_DMAK(jlo + 1, SLOTB);
    FA_DMAV(jlo, 0);
    const lds_cptr kbase = (lds_cptr)ring + LDS_K + hi * 1024 + r32 * 16;
    const lds_cptr vbase = (lds_cptr)ring + LDS_V + ((lane >> 4) & 1) * 32 + (lane & 3) * 8 + (4 * hi + ((lane & 15) >> 2)) * 64;
    const float skm = rc.slope2 * (float)rc.kp_mul;
    u32x4 pw[4];
    bool prev = false;
    int s_k = 0, s_vprev = 2 * SLOTB, s_knn = 2 * SLOTB, s_vn = SLOTB;
#define FA_NEXT(x) ((x) == (NSLOT - 1) * SLOTB ? 0 : (x) + SLOTB)
#define FA_VREADS(vf, so_) do { _Pragma("unroll") for (int d0_ = 0; d0_ < 2; ++d0_) _Pragma("unroll") for (int ks_ = 0; ks_ < 4; ++ks_) { \
        const s16x4 lo_ = vtr(vbase + (so_) + d0_ * 4096 + ks_ * 1024), hh_ = vtr(vbase + (so_) + d0_ * 4096 + ks_ * 1024 + 512); \
        vf[d0_ * 4 + ks_] = (bf16x8){lo_[0], lo_[1], lo_[2], lo_[3], hh_[0], hh_[1], hh_[2], hh_[3]}; } } while (0)
#define FA_PV(vf, pw) do { _Pragma("unroll") for (int d0_ = 0; d0_ < 2; ++d0_) _Pragma("unroll") for (int ks_ = 0; ks_ < 4; ++ks_) \
        o[d0_] = __builtin_amdgcn_mfma_f32_32x32x16_bf16(vf[d0_ * 4 + ks_], __builtin_bit_cast(bf16x8, pw[ks_]), o[d0_], 0, 0, 0); } while (0)
    for (int i = 0; i < nt; ++i) {
        if (i + 1 < nt) FA_WAIT_BAR(2); else FA_WAIT_BAR(1);
        if (i + 2 < nt) FA_DMAK(jlo + i + 2, s_knn);
        if (i + 1 < nt) FA_DMAV(jlo + i + 1, s_vn);
        const int j = jlo + i;
        int hk = rc.hiAbs - 64 * j; hk = hk > 63 ? 63 : hk;
        int lk = rc.loAbs - 64 * j; lk = lk < 0 ? 0 : lk;
        const bool rowok = ((rc.selmask >> (j >> rc.selshift)) & 1u) != 0u;
        const bool cur = __any(rowok && lk <= hk) != 0;
        bf16x8 kf[8], vf[8];
        if (cur) {
#pragma unroll
            for (int d0 = 0; d0 < 4; ++d0) { kf[2 * d0] = *(const __attribute__((address_space(3))) bf16x8*)(kbase + s_k + d0 * 2048); kf[2 * d0 + 1] = *(const __attribute__((address_space(3))) bf16x8*)(kbase + s_k + d0 * 2048 + 512); }
        }
        if (prev) FA_VREADS(vf, s_vprev);
        f32x16 s0, s1;
        if (cur) {
            const float lbj = rowok ? rc.slope2 * (float)(rc.kp_mul * (64 * j + 4 * hi) + rc.kp_off) - m : FA_NEG;
#pragma unroll
            for (int r = 0; r < 16; ++r) { const float c = (float)((r & 3) + 8 * (r >> 2)); s0[r] = __builtin_fmaf(skm, c, lbj); s1[r] = __builtin_fmaf(skm, c + 32.f, lbj); }
        }
        FA_SBAR();
        if (cur) {
#pragma unroll
            for (int d0 = 0; d0 < 4; ++d0) { s0 = __builtin_amdgcn_mfma_f32_32x32x16_bf16(kf[2 * d0], qr[d0], s0, 0, 0, 0); s1 = __builtin_amdgcn_mfma_f32_32x32x16_bf16(kf[2 * d0 + 1], qr[d0], s1, 0, 0, 0); }
        }
        if (prev) FA_PV(vf, pw);
        FA_SBAR();
        if (cur) {
            const bool full = (lk <= 0) && (hk >= 63);
            if (!__all(full)) {
                const int a = lk - 4 * hi, b = hk - 4 * hi;
#pragma unroll
                for (int r = 0; r < 16; ++r) { const int c = (r & 3) + 8 * (r >> 2);
                    s0[r] = (c >= a && c <= b) ? s0[r] : FA_NEG; s1[r] = (c + 32 >= a && c + 32 <= b) ? s1[r] : FA_NEG; }
            }
            if (chk) {
            float mx = __builtin_fmaxf(s0[0], s1[0]);
#pragma unroll
            for (int r = 1; r < 16; ++r) mx = __builtin_fmaxf(mx, __builtin_fmaxf(s0[r], s1[r]));
            if (__any(mx > FA_THR)) {
                mx = __builtin_fmaxf(mx, __shfl_xor(mx, 32));
                const float dl = __builtin_fmaxf(mx, 0.f), f = __builtin_amdgcn_exp2f(-dl);
                m += dl; l *= f;
#pragma unroll
                for (int r = 0; r < 16; ++r) { s0[r] -= dl; s1[r] -= dl; o[0][r] *= f; o[1][r] *= f; }
            }
            }
            float sum_ = 0.f;
#pragma unroll
            for (int r = 0; r < 16; ++r) { s0[r] = __builtin_amdgcn_exp2f(s0[r]); s1[r] = __builtin_amdgcn_exp2f(s1[r]); sum_ += s0[r] + s1[r]; }
            l += sum_;
            pw[0] = (u32x4){cvtpk(s0[0], s0[1]), cvtpk(s0[2], s0[3]), cvtpk(s0[4], s0[5]), cvtpk(s0[6], s0[7])}; pw[1] = (u32x4){cvtpk(s0[8], s0[9]), cvtpk(s0[10], s0[11]), cvtpk(s0[12], s0[13]), cvtpk(s0[14], s0[15])};
            pw[2] = (u32x4){cvtpk(s1[0], s1[1]), cvtpk(s1[2], s1[3]), cvtpk(s1[4], s1[5]), cvtpk(s1[6], s1[7])}; pw[3] = (u32x4){cvtpk(s1[8], s1[9]), cvtpk(s1[10], s1[11]), cvtpk(s1[12], s1[13]), cvtpk(s1[14], s1[15])};
        }
        prev = cur;
        s_vprev = s_k; s_k = FA_NEXT(s_k); s_knn = FA_NEXT(s_knn); s_vn = FA_NEXT(s_vn);
    }
    FA_WAIT_BAR(0);
    if (prev) {
        bf16x8 vf[8];
        FA_VREADS(vf, s_vprev);
        FA_PV(vf, pw);
    }
    asm volatile("s_waitcnt lgkmcnt(0)\n\ts_barrier" ::: "memory");
#undef FA_DMAK
#undef FA_DMAV
#undef FA_NEXT
#undef FA_VREADS
#undef FA_PV
}

__device__ __forceinline__ void acc_scaled(f32x16 (&acc)[2], const f32x16 (&o)[2], float w) {
#pragma unroll
    for (int r = 0; r < 16; ++r) { acc[0][r] += o[0][r] * w; acc[1][r] += o[1][r] * w; }
}
__device__ __forceinline__ void store_o(const f32x16 (&o)[2], float w, const bf16_t* Z, bf16_t* Y, int t, int zcol, int ycol, int hi) {
#pragma unroll
    for (int d0 = 0; d0 < 2; ++d0)
#pragma unroll
        for (int g4 = 0; g4 < 4; ++g4) {
            const int d = 32 * d0 + 8 * g4 + 4 * hi;
            const uint2 z = *(const uint2*)(Z + (size_t)t * 512 + zcol + d);
            const float v0 = o[d0][4 * g4 + 0] * w * bf2f(z.x & 0xffff), v1 = o[d0][4 * g4 + 1] * w * bf2f(z.x >> 16);
            const float v2 = o[d0][4 * g4 + 2] * w * bf2f(z.y & 0xffff), v3 = o[d0][4 * g4 + 3] * w * bf2f(z.y >> 16);
            uint2 y; y.x = cvtpk(v0, v1); y.y = cvtpk(v2, v3);
            *(uint2*)(Y + (size_t)t * 1024 + ycol + d) = y;
        }
}
__device__ __forceinline__ bool need_maxcheck(const bf16x8 (&qr)[4], const float* gk, int lane, float refslack) {
    float qn = 0.f;
#pragma unroll
    for (int d0 = 0; d0 < 4; ++d0)
#pragma unroll
        for (int i = 0; i < 8; ++i) { const float v = bf2f((unsigned short)qr[d0][i]); qn += v * v; }
    qn += __shfl_xor(qn, 32);
    float gm = __builtin_fabsf(gk[lane]);
#pragma unroll
    for (int o = 1; o < 64; o <<= 1) gm = __builtin_fmaxf(gm, __shfl_xor(gm, o));
    const float bound = sqrtf(qn) * gm * 8.04f + refslack;
    return __any(!(bound <= FA_THR)) != 0;
}
__device__ __forceinline__ void load_q(bf16x8 (&qr)[4], const bf16_t* Qrow, int hi) {
#pragma unroll
    for (int d0 = 0; d0 < 4; ++d0) qr[d0] = *(const bf16x8*)(Qrow + d0 * 16 + hi * 8);
}

#ifdef PROBE_A
#define FA_STAMP(n) do { if (blockIdx.x == 0 && threadIdx.x == 0) ((volatile __attribute__((address_space(3))) unsigned*)(ring + 131072 + 320))[16 + (n)] = (unsigned)__builtin_amdgcn_s_memrealtime(); } while (0)
#else
#define FA_STAMP(n) do {} while (0)
#endif
__device__ __forceinline__ void moba_unit(const KArgs& P, lds_ptr ring, int b, int h, int own, int wid, int lane) {
    unsigned char* ws = launder(P.ws); asm volatile("" : "+v"(lane));
    const bf16_t* QB = (const bf16_t*)(ws + WS_QB); const bf16_t* KB = (const bf16_t*)(ws + WS_KB); const bf16_t* VB = (const bf16_t*)(ws + WS_VB);
    const float* KMP = (const float*)(ws + WS_KMP); const bf16_t* ZB = (const bf16_t*)(ws + WS_ZB); bf16_t* Y = (bf16_t*)(ws + WS_Y);
    const int r32 = lane & 31, hi = lane >> 5;
    const int sq = own * 256 + 32 * wid + r32, t = b * SEQ + sq;
    const size_t hb = (size_t)(b * 8 + h) * SEQ;
    FA_STAMP(own == 7 ? 24 : 28);
    bf16x8 qr[4]; load_q(qr, QB + (hb + sq) * 64, hi);
    float gate[8];
#pragma unroll
    for (int n = 0; n < 8; ++n) gate[n] = -1e30f;
    if (own > 0) {
        float qf[32];
#pragma unroll
        for (int d0 = 0; d0 < 4; ++d0)
#pragma unroll
            for (int i = 0; i < 8; ++i) qf[8 * d0 + i] = bf2f((unsigned short)qr[d0][i]);
#pragma unroll
        for (int n = 0; n < 7; ++n) {
            const int nn = n < own ? n : own - 1;
            const float* k0 = KMP + (size_t)(b * 8 + nn) * 512 + h * 64 + hi * 8; const float* k1 = k0 + 64 * 512;
            float part = 0.f;
#pragma unroll
            for (int d0 = 0; d0 < 4; ++d0) {
                const float4 a0 = *(const float4*)(k0 + d0 * 16), a1 = *(const float4*)(k0 + d0 * 16 + 4), c0 = *(const float4*)(k1 + d0 * 16), c1 = *(const float4*)(k1 + d0 * 16 + 4);
                part += qf[8 * d0 + 0] * (a0.x + c0.x) + qf[8 * d0 + 1] * (a0.y + c0.y) + qf[8 * d0 + 2] * (a0.z + c0.z) + qf[8 * d0 + 3] * (a0.w + c0.w)
                      + qf[8 * d0 + 4] * (a1.x + c1.x) + qf[8 * d0 + 5] * (a1.y + c1.y) + qf[8 * d0 + 6] * (a1.z + c1.z) + qf[8 * d0 + 7] * (a1.w + c1.w);
            }
            const float g = part + __shfl_xor(part, 32);
            gate[n] = n < own ? g : -1e30f;
        }
    }
    unsigned sel = 0;
#pragma unroll
    for (int it = 0; it < 3; ++it) {
        float best = -3e38f; int bi = 0;
#pragma unroll
        for (int n = 0; n < 8; ++n) { const bool ok = !((sel >> n) & 1u) && gate[n] > best; best = ok ? gate[n] : best; bi = ok ? n : bi; }
        sel |= 1u << bi;
    }
    sel &= (1u << own) - 1u;
    sel |= 1u << own;
    const float slope2 = exp2f(-(float)(h + 1)) * LOG2E;
    RowCtx2 rc; rc.hiAbs = sq; rc.loAbs = -(1 << 30); rc.selmask = sel; rc.selshift = 2; rc.slope2 = slope2; rc.kp_mul = 1; rc.kp_off = -sq;
    float m = 0.f, l = 0.f; f32x16 o[2];
#pragma unroll
    for (int r = 0; r < 16; ++r) { o[0][r] = 0.f; o[1][r] = 0.f; }
    FA_STAMP(own == 7 ? 25 : 29);
    attn_stream2(ring, KB + hb * 64, VB + hb * 64, 0, 4 * own + 4, qr, rc, wid, lane, m, l, o, need_maxcheck(qr, P.b_knorm_g, lane, 0.f));
    FA_STAMP(own == 7 ? 26 : 30);
    l += __shfl_xor(l, 32);
    const float inv = l > 0.f ? 1.0f / l : 0.f;
    store_o(o, inv, ZB, Y, t, h * 64, 512 + h * 64, hi);
    FA_STAMP(own == 7 ? 27 : 31);
}

__device__ __forceinline__ void swa_unit(const KArgs& P, lds_ptr ring, int b, int g, int c, int wid, int lane) {
    unsigned char* ws = launder(P.ws); asm volatile("" : "+v"(lane));
    const bf16_t* QD = (const bf16_t*)(ws + WS_QD); const bf16_t* KD = (const bf16_t*)(ws + WS_KD); const bf16_t* VD = (const bf16_t*)(ws + WS_VD);
    const bf16_t* ZD = (const bf16_t*)(ws + WS_ZD); bf16_t* Y = (bf16_t*)(ws + WS_Y);
    const int r32 = lane & 31, hi = lane >> 5, h = 4 * g + (wid >> 1);
    const int sq = 64 * c + 32 * (wid & 1) + r32, t = b * SEQ + sq;
    bf16x8 qr[4]; load_q(qr, QD + ((size_t)(b * 8 + h) * SEQ + sq) * 64, hi);
    const float slope2 = exp2f(-(float)(h + 1)) * LOG2E;
    RowCtx2 rc; rc.hiAbs = sq; rc.loAbs = sq - 127; rc.selmask = 0xffffffffu; rc.selshift = 0; rc.slope2 = slope2; rc.kp_mul = 1; rc.kp_off = -sq;
    float m = P.d_sinks[h] * LOG2E, l = hi == 0 ? 1.f : 0.f; f32x16 o[2];
#pragma unroll
    for (int r = 0; r < 16; ++r) { o[0][r] = 0.f; o[1][r] = 0.f; }
    const size_t gb = (size_t)(b * 2 + g) * SEQ * 64;
    attn_stream2(ring, KD + gb, VD + gb, c >= 2 ? c - 2 : 0, c + 1, qr, rc, wid, lane, m, l, o, need_maxcheck(qr, P.d_knorm_g, lane, __builtin_fabsf(m)));
    l += __shfl_xor(l, 32);
    store_o(o, 1.0f / l, ZD, Y, t, h * 64, 512 + h * 64, hi);
}

__device__ __forceinline__ void nsa_unit(const KArgs& P, lds_ptr ring, int b, int g, int c, int wid, int lane, int tid) {
    unsigned char* ws = launder(P.ws); asm volatile("" : "+v"(lane));
    const bf16_t* QC = (const bf16_t*)(ws + WS_QC); const bf16_t* KC = (const bf16_t*)(ws + WS_KC); const bf16_t* VC = (const bf16_t*)(ws + WS_VC);
    const bf16_t* KS = (const bf16_t*)(ws + WS_KS); const bf16_t* VS = (const bf16_t*)(ws + WS_VS);
    const bf16_t* KW = (const bf16_t*)(ws + WS_KW); const bf16_t* VW = (const bf16_t*)(ws + WS_VW);
    const float* GT = (const float*)(ws + WS_GT); const bf16_t* ZC = (const bf16_t*)(ws + WS_ZC); bf16_t* Y = (bf16_t*)(ws + WS_Y);
    const int r32 = lane & 31, hi = lane >> 5, hh = wid >> 1, h = 4 * g + hh;
    const int tok = 32 * (wid & 1) + r32, sq = 64 * c + tok, t = b * SEQ + sq;
    bf16x8 qr[4]; load_q(qr, QC + ((size_t)(b * 8 + h) * SEQ + sq) * 64, hi);
    const float slope2 = exp2f(-(float)(h + 1)) * LOG2E;
    const float g0 = GT[(size_t)t * 32 + h], g1 = GT[(size_t)t * 32 + 8 + h], g2 = GT[(size_t)t * 32 + 16 + h];
    f32x16 o[2];
#pragma unroll
    for (int r = 0; r < 16; ++r) { o[0][r] = 0.f; o[1][r] = 0.f; }
    __attribute__((address_space(3))) float* otS = (__attribute__((address_space(3))) float*)(ring + LDS_OT) + wid * 2048 + lane;
    __attribute__((address_space(3))) float* impH = (__attribute__((address_space(3))) float*)(ring + LDS_IMP);
    __attribute__((address_space(3))) float* impT = (__attribute__((address_space(3))) float*)(ring + LDS_IMPT);
    __attribute__((address_space(3))) unsigned* selS = (__attribute__((address_space(3))) unsigned*)(ring + LDS_SEL);
    {
        const bf16_t* kc = KC + (size_t)(b * 2 + g) * 128 * 64; const bf16_t* vc = VC + (size_t)(b * 2 + g) * 128 * 64;
        const unsigned lds0 = (unsigned)(uintptr_t)ring;
        const bf16_t* ksrc = kc + (size_t)lane * 64 + wid * 8;
        const bf16_t* vsrc = vc + (size_t)(16 * (wid & 3) + (lane >> 2)) * 64 + (wid >> 2) * 32 + (lane & 3) * 8;
        glds16(ksrc, (unsigned)__builtin_amdgcn_readfirstlane(lds0 + LDS_K + wid * 1024)); glds16(vsrc, (unsigned)__builtin_amdgcn_readfirstlane(lds0 + LDS_V + wid * 1024));
        glds16(ksrc + 4096, (unsigned)__builtin_amdgcn_readfirstlane(lds0 + LDS_K + SLOTB + wid * 1024)); glds16(vsrc + 4096, (unsigned)__builtin_amdgcn_readfirstlane(lds0 + LDS_V + SLOTB + wid * 1024));
        FA_WAIT_BAR(0);
        RowCtx rc; int hc = (sq - 31) >> 4; rc.hiAbs = hc > 126 ? 126 : hc; rc.loAbs = -(1 << 30); rc.selmask = 0xffffffffu; rc.selshift = 0; rc.sk = 16.f * slope2; rc.lb = slope2 * (float)(31 - 64 * c);
        f32x16 a0, a1, b0, b1;
        { int hk = rc.hiAbs; hk = hk > 63 ? 63 : hk; qk_scores((lds_cptr)ring + LDS_K, 0, qr, rc, r32, hi, hk, 0, true, a0, a1); }
        { int hk = rc.hiAbs - 64; hk = hk > 63 ? 63 : hk; qk_scores((lds_cptr)ring + LDS_K + SLOTB, 1, qr, rc, r32, hi, hk, 0, true, b0, b1); }
        float mx = __builtin_fmaxf(rowmax32(a0, a1), rowmax32(b0, b1));
        mx = mx > -1e37f ? mx : 0.f;
        float sum = 0.f;
#pragma unroll
        for (int r = 0; r < 16; ++r) { a0[r] = __builtin_amdgcn_exp2f(a0[r] - mx); a1[r] = __builtin_amdgcn_exp2f(a1[r] - mx); b0[r] = __builtin_amdgcn_exp2f(b0[r] - mx); b1[r] = __builtin_amdgcn_exp2f(b1[r] - mx);
            sum += (a0[r] + a1[r]) + (b0[r] + b1[r]); }
        sum += __shfl_xor(sum, 32);
        const float inv = sum > 0.f ? 1.0f / sum : 0.f;
#pragma unroll
        for (int r = 0; r < 16; ++r) { a0[r] *= inv; a1[r] *= inv; b0[r] *= inv; b1[r] *= inv; }
        float ss[16], ee[16];
#pragma unroll
        for (int i = 0; i < 4; ++i) {
            ss[i] = (a0[4 * i] + a0[4 * i + 1]) + (a0[4 * i + 2] + a0[4 * i + 3]); ee[i] = a0[4 * i + 3];
            ss[4 + i] = (a1[4 * i] + a1[4 * i + 1]) + (a1[4 * i + 2] + a1[4 * i + 3]); ee[4 + i] = a1[4 * i + 3];
            ss[8 + i] = (b0[4 * i] + b0[4 * i + 1]) + (b0[4 * i + 2] + b0[4 * i + 3]); ee[8 + i] = b0[4 * i + 3];
            ss[12 + i] = (b1[4 * i] + b1[4 * i + 1]) + (b1[4 * i + 2] + b1[4 * i + 3]); ee[12 + i] = b1[4 * i + 3];
        }
        float ep[16];
#pragma unroll
        for (int k = 0; k < 16; ++k) ep[k] = __shfl_xor(ee[k], 32);
#pragma unroll
        for (int k = 0; k < 16; ++k) {
            const float prev = k > 0 ? ep[k > 0 ? k - 1 : 0] : 0.f;
            const float v = ss[k] + (hi ? ep[k] : prev);
            impH[(hh * 64 + tok) * 33 + 2 * k + hi] = v;
        }
        pv_accum((lds_cptr)ring + LDS_V, a0, a1, lane, hi, o);
        pv_accum((lds_cptr)ring + LDS_V + SLOTB, b0, b1, lane, hi, o);
        asm volatile("s_waitcnt lgkmcnt(0)\n\ts_barrier" ::: "memory");
        {
            const int tk = tid >> 3, part = tid & 7;
#pragma unroll
            for (int i = 0; i < 4; ++i) { const int n = 4 * part + i;
                float v = (impH[(0 * 64 + tk) * 33 + n] + impH[(1 * 64 + tk) * 33 + n]) + (impH[(2 * 64 + tk) * 33 + n] + impH[(3 * 64 + tk) * 33 + n]);
                if (n == 0 || n == c || n == c - 1) v = 1e4f;
                if (n > c) v = -1e30f;
                impT[tk * 33 + n] = v; }
            asm volatile("s_waitcnt lgkmcnt(0)\n\ts_barrier" ::: "memory");
            float mine[4]; int rank[4];
#pragma unroll
            for (int i = 0; i < 4; ++i) { mine[i] = impT[tk * 33 + 4 * part + i]; rank[i] = 0; }
#pragma unroll 1
            for (int mI = 0; mI < 32; ++mI) { const float v = impT[tk * 33 + mI];
#pragma unroll
                for (int i = 0; i < 4; ++i) rank[i] += (v > mine[i] || (v == mine[i] && mI < 4 * part + i)) ? 1 : 0; }
            unsigned bits = 0;
#pragma unroll
            for (int i = 0; i < 4; ++i) if (rank[i] < 16) bits |= 1u << (4 * part + i);
            bits |= __shfl_xor(bits, 1); bits |= __shfl_xor(bits, 2); bits |= __shfl_xor(bits, 4);
            if (part == 0) selS[tk] = bits;
            asm volatile("s_waitcnt lgkmcnt(0)\n\ts_barrier" ::: "memory");
        }
    }
    const unsigned sel = selS[tok];
    const size_t gb = (size_t)(b * 2 + g) * SEQ * 64;
#pragma unroll
    for (int r = 0; r < 16; ++r) { otS[r * 64] = o[0][r] * g0; otS[(16 + r) * 64] = o[1][r] * g0; }
    {
        RowCtx2 rc; rc.hiAbs = sq; rc.loAbs = -(1 << 30); rc.selmask = sel; rc.selshift = 0; rc.slope2 = slope2; rc.kp_mul = 1; rc.kp_off = -sq;
        float m = 0.f, l = 0.f;
#pragma unroll
        for (int r = 0; r < 16; ++r) { o[0][r] = 0.f; o[1][r] = 0.f; }
        attn_stream2(ring, KS + gb, VS + gb, 0, c + 1, qr, rc, wid, lane, m, l, o, need_maxcheck(qr, P.c_knorm_slc_g, lane, 0.f));
        l += __shfl_xor(l, 32);
        const float w1 = l > 0.f ? g1 / l : 0.f;
#pragma unroll
        for (int r = 0; r < 16; ++r) { otS[r * 64] += o[0][r] * w1; otS[(16 + r) * 64] += o[1][r] * w1; }
    }
    {
        RowCtx2 rc; rc.hiAbs = sq; rc.loAbs = sq - 511; rc.selmask = 0xffffffffu; rc.selshift = 0; rc.slope2 = slope2; rc.kp_mul = 1; rc.kp_off = -sq;
        float m = 0.f, l = 0.f;
#pragma unroll
        for (int r = 0; r < 16; ++r) { o[0][r] = 0.f; o[1][r] = 0.f; }
        attn_stream2(ring, KW + gb, VW + gb, c >= 8 ? c - 8 : 0, c + 1, qr, rc, wid, lane, m, l, o, need_maxcheck(qr, P.c_knorm_win_g, lane, 0.f));
        l += __shfl_xor(l, 32);
        const float w2 = l > 0.f ? g2 / l : 0.f;
#pragma unroll
        for (int r = 0; r < 16; ++r) { o[0][r] = o[0][r] * w2 + otS[r * 64]; o[1][r] = o[1][r] * w2 + otS[(16 + r) * 64]; }
    }
    store_o(o, 1.f, ZC, Y, t, h * 64, h * 64, hi);
}
}
namespace fm {
typedef short bf16x8 __attribute__((ext_vector_type(8)));
typedef float f32x4 __attribute__((ext_vector_type(4)));
typedef float f32x2 __attribute__((ext_vector_type(2)));
__device__ __forceinline__ float wave_sum(float v) {
#pragma unroll
    for (int o = 1; o < 64; o <<= 1) v += __shfl_xor(v, o);
    return v;
}
struct ConvW { float w0[31], w1[31]; float2 bias; float4 ga, gb, ba, bb2; };
__device__ __forceinline__ void conv_load_w(const KArgs& P, ConvW& W, int tid, int lane) {
    const int cp = tid & 255;
#pragma unroll
    for (int j = 0; j < 31; ++j) { const float2 w = *(const float2*)(P.a_conv_w + j * 512 + 2 * cp); W.w0[j] = w.x; W.w1[j] = w.y; }
    W.bias = *(const float2*)(P.a_conv_b + 2 * cp);
    W.ga = *(const float4*)(P.a_ln_g + 4 * lane); W.gb = *(const float4*)(P.a_ln_g + 256 + 4 * lane);
    W.ba = *(const float4*)(P.a_ln_b + 4 * lane); W.bb2 = *(const float4*)(P.a_ln_b + 256 + 4 * lane);
}
__device__ __forceinline__ void conv_unit(const KArgs& P, LAS unsigned char* lds, int u, const ConvW& W, int tid, int wave, int lane) {
    const bf16_t* G0 = (const bf16_t*)(P.ws + WS_G0); const bf16_t* ZA = (const bf16_t*)(P.ws + WS_ZA); bf16_t* Y = (bf16_t*)(P.ws + WS_Y);
    LAS float* cy = (LAS float*)lds;
    const int cp = tid & 255, sb = tid >> 8;
    {
        const int t0 = u * 32, s0 = t0 & (SEQ - 1);
        float acc0[16], acc1[16];
#pragma unroll
        for (int o = 0; o < 16; ++o) { acc0[o] = W.bias.x; acc1[o] = W.bias.y; }
        const int sbase = s0 + 16 * sb - 30, tmin = t0 - s0, tb = t0 + 16 * sb - 30;
        unsigned xv[46];
#pragma unroll
        for (int i = 0; i < 46; ++i) { int row = tb + i; row = row < tmin ? tmin : row; xv[i] = *(const unsigned*)(G0 + (size_t)row * 512 + 2 * cp); }
#pragma unroll
        for (int i = 0; i < 46; ++i) {
            const bool ok = sbase + i >= 0;
            const float x0 = ok ? bf2f(xv[i] & 0xffff) : 0.f, x1 = ok ? bf2f(xv[i] >> 16) : 0.f;
#pragma unroll
            for (int o = 0; o < 16; ++o) { const int j = i - o; if (j >= 0 && j <= 30) { acc0[o] += x0 * W.w0[j]; acc1[o] += x1 * W.w1[j]; } }
        }
#pragma unroll
        for (int o = 0; o < 16; ++o) { f32x2 r; r.x = acc0[o]; r.y = acc1[o]; *(LAS f32x2*)(cy + (16 * sb + o) * 512 + 2 * cp) = r; }
        __syncthreads();
#pragma unroll
        for (int k = 0; k < 4; ++k) {
            const int tok = 4 * wave + k, t = t0 + tok;
            f32x4 a = *(const LAS f32x4*)(cy + tok * 512 + 4 * lane), b = *(const LAS f32x4*)(cy + tok * 512 + 256 + 4 * lane);
            const float mean = wave_sum((a.x + a.y) + (a.z + a.w) + (b.x + b.y) + (b.z + b.w)) * (1.0f / 512);
            a.x -= mean; a.y -= mean; a.z -= mean; a.w -= mean; b.x -= mean; b.y -= mean; b.z -= mean; b.w -= mean;
            const float var = wave_sum((a.x * a.x + a.y * a.y) + (a.z * a.z + a.w * a.w) + (b.x * b.x + b.y * b.y) + (b.z * b.z + b.w * b.w)) * (1.0f / 512);
            const float rstd = 1.0f / sqrtf(var + EPSF);
            const uint2 za = *(const uint2*)(ZA + (size_t)t * 512 + 4 * lane), zb = *(const uint2*)(ZA + (size_t)t * 512 + 256 + 4 * lane);
            float y0 = fast_silu(a.x * rstd * W.ga.x + W.ba.x) * bf2f(za.x & 0xffff), y1 = fast_silu(a.y * rstd * W.ga.y + W.ba.y) * bf2f(za.x >> 16);
            float y2 = fast_silu(a.z * rstd * W.ga.z + W.ba.z) * bf2f(za.y & 0xffff), y3 = fast_silu(a.w * rstd * W.ga.w + W.ba.w) * bf2f(za.y >> 16);
            uint2 o; o.x = pk2(y0, y1); o.y = pk2(y2, y3);
            *(uint2*)(Y + (size_t)t * 1024 + 4 * lane) = o;
            y0 = fast_silu(b.x * rstd * W.gb.x + W.bb2.x) * bf2f(zb.x & 0xffff); y1 = fast_silu(b.y * rstd * W.gb.y + W.bb2.y) * bf2f(zb.x >> 16);
            y2 = fast_silu(b.z * rstd * W.gb.z + W.bb2.z) * bf2f(zb.y & 0xffff); y3 = fast_silu(b.w * rstd * W.gb.w + W.bb2.w) * bf2f(zb.y >> 16);
            o.x = pk2(y0, y1); o.y = pk2(y2, y3);
            *(uint2*)(Y + (size_t)t * 1024 + 256 + 4 * lane) = o;
        }
        __syncthreads();
    }
}

__device__ __forceinline__ void cmp_unit(const KArgs& P, LAS unsigned char* lds, int u, int tid, int wave, int lane) {
    const int kv = u >> 7, bg = (u >> 3) & 15, rb = u & 7, fr = lane & 15, fq = lane >> 4;
    const bf16_t* X = (const bf16_t*)(P.ws + (kv == 0 ? WS_KCR : WS_VCR)) + ((size_t)bg * SEQ + 256 * rb) * 64;
    const bf16_t* W1f = (const bf16_t*)(P.ws + WS_CW1) + (size_t)kv * 256 * 2048;
    const bf16_t* W2t = (const bf16_t*)(P.ws + WS_CW2) + (size_t)kv * 64 * 256;
    const float* B1P = (const float*)(P.ws + WS_B1P) + (size_t)kv * 16 * 256;
    LAS unsigned char* xs = lds;
    LAS bf16_t* hidS = (LAS bf16_t*)(lds + 272 * 128);
    LAS float* outS = (LAS float*)(lds + 272 * 128 + 16 * 264 * 2);
    const bf16_t* bp0 = W1f + (size_t)(2 * wave) * 64 * 512 + lane * 8; const bf16_t* bp1 = bp0 + 64 * 512;
    bf16x8 bb[4][8];
#define CMP_LOADB(buf, ch) do { _Pragma("unroll") for (int q_ = 0; q_ < 4; ++q_) { bb[buf][2 * q_] = *(const bf16x8*)(bp0 + (size_t)(4 * (ch) + q_) * 512); bb[buf][2 * q_ + 1] = *(const bf16x8*)(bp1 + (size_t)(4 * (ch) + q_) * 512); } } while (0)
    CMP_LOADB(0, 0); CMP_LOADB(1, 1); CMP_LOADB(2, 2);
#pragma unroll
    for (int i = 0; i < 5; ++i) { const int idx = tid + 512 * i;
        if (idx < 2176) { const int t = idx >> 3, c = idx & 7; const uint4 v = *(const uint4*)(X + (size_t)t * 64 + c * 8);
            *(LAS v4u*)(xs + t * 128 + ((c ^ ((t >> 4) & 7)) << 4)) = (v4u){v.x, v.y, v.z, v.w}; } }
    __syncthreads();
    {
        const int n0 = 32 * wave;
        f32x4 acc0 = {0.f, 0.f, 0.f, 0.f}, acc1 = {0.f, 0.f, 0.f, 0.f};
#pragma unroll
        for (int ch = 0; ch < 16; ++ch) {
            if (ch + 3 < 16) CMP_LOADB((ch + 3) & 3, ch + 3);
#pragma unroll
            for (int q = 0; q < 4; ++q) {
                const int ks = 4 * ch + q, tau = ks >> 1, c = (ks & 1) * 4 + fq, t = 16 * fr + tau;
                const bf16x8 a = *(const LAS bf16x8*)(xs + t * 128 + ((c ^ ((t >> 4) & 7)) << 4));
                acc0 = __builtin_amdgcn_mfma_f32_16x16x32_bf16(a, bb[ch & 3][2 * q], acc0, 0, 0, 0);
                acc1 = __builtin_amdgcn_mfma_f32_16x16x32_bf16(a, bb[ch & 3][2 * q + 1], acc1, 0, 0, 0);
            }
        }
#undef CMP_LOADB
        const float* b1 = kv == 0 ? P.c_k_b1 : P.c_v_b1;
#pragma unroll
        for (int f = 0; f < 2; ++f) {
            const int n = n0 + 16 * f + fr;
            float bias = b1[n];
#pragma unroll
            for (int kc = 0; kc < 16; ++kc) bias += B1P[kc * 256 + n];
#pragma unroll
            for (int r = 0; r < 4; ++r) { const float v = (f == 0 ? acc0[r] : acc1[r]) + bias; hidS[(4 * fq + r) * 264 + n] = f2bf(fast_silu(v)); }
        }
    }
    __syncthreads();
    if (wave < 4) {
        const int d0 = 16 * wave;
        f32x4 acc = {0.f, 0.f, 0.f, 0.f};
#pragma unroll
        for (int k0 = 0; k0 < 256; k0 += 32) {
            const bf16x8 a = *(const LAS bf16x8*)(hidS + fr * 264 + k0 + 8 * fq);
            const bf16x8 b = *(const bf16x8*)(W2t + (size_t)(d0 + fr) * 256 + k0 + 8 * fq);
            acc = __builtin_amdgcn_mfma_f32_16x16x32_bf16(a, b, acc, 0, 0, 0);
        }
        const float b2 = (kv == 0 ? P.c_k_b2 : P.c_v_b2)[d0 + fr];
#pragma unroll
        for (int r = 0; r < 4; ++r) outS[(4 * fq + r) * 65 + d0 + fr] = acc[r] + b2;
    }
    __syncthreads();
    {
        bf16_t* dst = (bf16_t*)(P.ws + (kv == 0 ? WS_KC : WS_VC)) + (size_t)bg * 128 * 64;
#pragma unroll
        for (int k = 0; k < 2; ++k) {
            const int row = 2 * wave + k, c = 16 * rb + row;
            float v = outS[row * 65 + lane];
            if (kv == 0) { const float ss = wave_sum(v * v); v = v * (1.0f / sqrtf(ss * (1.0f / 64) + EPSF)) * P.c_knorm_cmp_g[lane]; }
            dst[(size_t)c * 64 + lane] = c < 127 ? f2bf(v) : (bf16_t)0;
        }
    }
    __syncthreads();
}

__device__ __forceinline__ void gate_unit(const KArgs& P, LAS unsigned char* lds, int u, int tid, int wave, int lane) {
    const bf16_t* XB = (const bf16_t*)(P.ws + WS_XB); const bf16_t* WG = (const bf16_t*)(P.ws + WS_WGATE); const float* SSQ = (const float*)(P.ws + WS_SSQ); float* GT = (float*)(P.ws + WS_GT);
    const int fr = lane & 15, fq = lane >> 4, mf = wave & 3, kh = wave >> 2, t0 = 64 * u + 16 * mf;
    constexpr int ROWB = 2064;
    LAS float* part = (LAS float*)(lds + 32 * ROWB);
#pragma unroll
    for (int i = 0; i < 8; ++i) { const int idx = tid + 512 * i, n = idx >> 7, ch = idx & 127;
        const uint4 v = *(const uint4*)(WG + (size_t)n * DM + ch * 8);
        *(LAS v4u*)(lds + n * ROWB + ch * 16) = (v4u){v.x, v.y, v.z, v.w}; }
    bf16x8 a[16];
    const bf16_t* ap = XB + (size_t)(t0 + fr) * DM + kh * 512 + 8 * fq;
#pragma unroll
    for (int i = 0; i < 16; ++i) a[i] = *(const bf16x8*)(ap + 32 * i);
    __syncthreads();
    f32x4 acc0 = {0.f, 0.f, 0.f, 0.f}, acc1 = {0.f, 0.f, 0.f, 0.f};
    const LAS unsigned char* bp = lds + fr * ROWB + (kh * 512 + 8 * fq) * 2;
#pragma unroll
    for (int i = 0; i < 16; ++i) {
        const bf16x8 b0 = *(const LAS bf16x8*)(bp + 64 * i), b1 = *(const LAS bf16x8*)(bp + 16 * ROWB + 64 * i);
        acc0 = __builtin_amdgcn_mfma_f32_16x16x32_bf16(a[i], b0, acc0, 0, 0, 0);
        acc1 = __builtin_amdgcn_mfma_f32_16x16x32_bf16(a[i], b1, acc1, 0, 0, 0);
    }
    if (kh == 1) {
#pragma unroll
        for (int r = 0; r < 4; ++r) { part[(mf * 64 + lane) * 8 + r] = acc0[r]; part[(mf * 64 + lane) * 8 + 4 + r] = acc1[r]; }
    }
    __syncthreads();
    if (kh == 0) {
#pragma unroll
        for (int r = 0; r < 4; ++r) {
            const int t = t0 + 4 * fq + r;
            const float4* sq = (const float4*)(SSQ + (size_t)t * 16);
            const float4 q0 = sq[0], q1 = sq[1], q2 = sq[2], q3 = sq[3];
            const float ssq = ((q0.x + q0.y) + (q0.z + q0.w)) + ((q1.x + q1.y) + (q1.z + q1.w)) + ((q2.x + q2.y) + (q2.z + q2.w)) + ((q3.x + q3.y) + (q3.z + q3.w));
            const float rstd = 1.0f / sqrtf(ssq * (1.0f / DM) + EPSF);
            GT[(size_t)t * 32 + fr] = fast_sigmoid((acc0[r] + part[(mf * 64 + lane) * 8 + r]) * rstd);
            if (fr < 8) GT[(size_t)t * 32 + 16 + fr] = fast_sigmoid((acc1[r] + part[(mf * 64 + lane) * 8 + 4 + r]) * rstd);
        }
    }
    __syncthreads();
}

__device__ __forceinline__ void b1p_item(const KArgs& P, int it, int lane) {
    const int kv = it >> 6, kc = (it >> 2) & 15, n = (it & 3) * 64 + lane;
    const float* pos = kv == 0 ? P.c_pos_k : P.c_pos_v; const float* w1 = kv == 0 ? P.c_k_w1 : P.c_v_w1;
    float s = 0.f;
#pragma unroll 16
    for (int k = kc * 128; k < kc * 128 + 128; ++k) s += pos[k] * w1[(size_t)k * 256 + n];
    ((float*)(P.ws + WS_B1P))[((size_t)kv * 16 + kc) * 256 + n] = s;
}
__device__ __forceinline__ void w1f_item(const KArgs& P, int it, int lane) {
    const int kv = it >> 7, nf = (it >> 3) & 15, ks8 = it & 7, fr = lane & 15, fq = lane >> 4;
    const float* w1 = kv == 0 ? P.c_k_w1 : P.c_v_w1;
    bf16_t* dst = (bf16_t*)(P.ws + WS_CW1) + (size_t)kv * 256 * 2048 + (size_t)nf * 64 * 512 + lane * 8;
#pragma unroll
    for (int q = 0; q < 8; ++q) {
        const int ks = ks8 * 8 + q;
        const float* src = w1 + (size_t)(32 * ks + 8 * fq) * 256 + 16 * nf + fr;
        float v[8];
#pragma unroll
        for (int j = 0; j < 8; ++j) v[j] = src[j * 256];
        uint4 o; o.x = pk2(v[0], v[1]); o.y = pk2(v[2], v[3]); o.z = pk2(v[4], v[5]); o.w = pk2(v[6], v[7]);
        *(uint4*)(dst + (size_t)ks * 512) = o;
    }
}
}
__device__ __forceinline__ NvGroup fast_group(const KArgs& P, int layer, int pn, int wc) {
    if (layer == 0) {
        if (pn < 4) { NvGroup g; g.gain = nullptr; g.scale = 1.f; g.width = 32; g.type = 4; g.col = 128 * pn + 32 * wc; g.col2 = 512 + g.col; g.dkind = 0; g.dst = P.ws + WS_G0; g.ld = 512; g.idx = 0; return g; }
        return nv_group0(P, 8 + 4 * (pn - 4) + wc);
    }
    int gi;
    if (pn < 2) gi = 4 * pn + wc;
    else if (pn < 4) gi = 21 + 4 * (pn - 2) + wc;
    else if (pn < 6) gi = 29 + 4 * (pn - 4) + wc;
    else if (pn < 8) gi = 41 + 4 * (pn - 6) + wc;
    else if (pn == 8) gi = 8 + wc;
    else if (pn == 9) gi = wc < 2 ? 12 + wc : 16 + (wc - 2);
    else if (pn == 10) gi = wc < 2 ? 14 + wc : 18 + (wc - 2);
    else if (pn == 11) gi = wc < 2 ? 37 + wc : 39 + (wc - 2);
    else { NvGroup g; g.gain = nullptr; g.scale = 1.f; g.width = 0; g.type = 5; g.col = 0; g.col2 = 0; g.dkind = 0; g.dst = nullptr; g.ld = 0; g.idx = 0; return g; }
    return nv_group1(P, gi);
}
constexpr int NTILE_IN0 = 14, NTILE_IN1 = 12;


struct EpiIn {
    static constexpr bool PERM = true, AFTER_DRAIN = false;
    KArgs P; int layer;
    __device__ __forceinline__ void operator()(const pg8::f32x4 (&acc)[2][2][4][2], const pg8::Unit& u, int wr, int wc, int fr, int fq) const {
        const NvGroup g = fast_group(P, layer, u.pn, wc);
        if (g.type == 5) return;
        const float* SSQ = (const float*)(P.ws + WS_SSQ);
        const bool do_km = (layer == 0 && g.type == 2 && u.pn >= 8);
        float gn[16], km[16];
#pragma unroll
        for (int i = 0; i < 16; ++i) { gn[i] = 1.f; km[i] = 0.f; }
        if (g.type == 2) {
#pragma unroll
            for (int bj = 0; bj < 2; ++bj)
#pragma unroll
                for (int i = 0; i < 8; ++i) gn[8 * bj + i] = g.gain[32 * bj + 8 * fq + i] * g.scale;
        }
#pragma unroll
        for (int ai = 0; ai < 2; ++ai)
#pragma unroll
            for (int m = 0; m < 4; ++m) {
                const int t = u.pm * 256 + ai * 128 + wr * 64 + m * 16 + fr, b = t >> 11, s = t & 2047;
                const float4* sq = (const float4*)(SSQ + (size_t)t * 16);
                const float4 q0 = sq[0], q1 = sq[1], q2 = sq[2], q3 = sq[3];
                const float ssq = ((q0.x + q0.y) + (q0.z + q0.w)) + ((q1.x + q1.y) + (q1.z + q1.w)) + ((q2.x + q2.y) + (q2.z + q2.w)) + ((q3.x + q3.y) + (q3.z + q3.w));
                const float rstd = 1.0f / sqrtf(ssq * (1.0f / DM) + EPSF);
                float v[16];
#pragma unroll
                for (int bj = 0; bj < 2; ++bj)
#pragma unroll
                    for (int n = 0; n < 2; ++n)
#pragma unroll
                        for (int r = 0; r < 4; ++r) v[8 * bj + 4 * n + r] = acc[ai][bj][m][n][r] * rstd;
                if (g.type == 4) {
                    pg8::u32x4 w;
                    float o[8];
#pragma unroll
                    for (int i = 0; i < 8; ++i) o[i] = v[i] * fast_sigmoid(v[8 + i]);
                    w.x = pg8::cvt_pk_bf16(o[0], o[1]); w.y = pg8::cvt_pk_bf16(o[2], o[3]); w.z = pg8::cvt_pk_bf16(o[4], o[5]); w.w = pg8::cvt_pk_bf16(o[6], o[7]);
                    *(pg8::u32x4*)((bf16_t*)g.dst + (size_t)t * 512 + g.col + 8 * fq) = w;
                    continue;
                }
                if (g.type == 3) {
                    if (fq < 3) {
                        float4 o0, o1;
                        o0.x = fast_sigmoid(v[0]); o0.y = fast_sigmoid(v[1]); o0.z = fast_sigmoid(v[2]); o0.w = fast_sigmoid(v[3]);
                        o1.x = fast_sigmoid(v[4]); o1.y = fast_sigmoid(v[5]); o1.z = fast_sigmoid(v[6]); o1.w = fast_sigmoid(v[7]);
                        float* gp = (float*)g.dst + (size_t)t * 32 + 8 * fq;
                        *(float4*)gp = o0; *(float4*)(gp + 4) = o1;
                    }
                    continue;
                }
                if (g.type == 1) {
#pragma unroll
                    for (int i = 0; i < 16; ++i) v[i] = fast_silu(v[i]);
                } else if (g.type == 2) {
                    float ss = 0.f;
#pragma unroll
                    for (int i = 0; i < 16; ++i) ss += v[i] * v[i];
                    ss += __shfl_xor(ss, 16); ss += __shfl_xor(ss, 32);
                    const float nrm = 1.0f / sqrtf(ss * (1.0f / 64) + EPSF);
#pragma unroll
                    for (int i = 0; i < 16; ++i) v[i] = v[i] * nrm * gn[i];
                    if (do_km) {
#pragma unroll
                        for (int i = 0; i < 16; ++i) km[i] += v[i];
                    }
                }
                bf16_t* dp = g.dkind == 0 ? (bf16_t*)g.dst + (size_t)t * g.ld + g.idx * 64 + 8 * fq
                                          : (bf16_t*)g.dst + ((size_t)(b * g.ld + g.idx) * SEQ + s) * 64 + 8 * fq;
#pragma unroll
                for (int bj = 0; bj < 2; ++bj) {
                    pg8::u32x4 w;
                    w.x = pg8::cvt_pk_bf16(v[8 * bj + 0], v[8 * bj + 1]); w.y = pg8::cvt_pk_bf16(v[8 * bj + 2], v[8 * bj + 3]);
                    w.z = pg8::cvt_pk_bf16(v[8 * bj + 4], v[8 * bj + 5]); w.w = pg8::cvt_pk_bf16(v[8 * bj + 6], v[8 * bj + 7]);
                    *(pg8::u32x4*)(dp + 32 * bj) = w;
                }
            }
        if (do_km) {
#pragma unroll
            for (int i = 0; i < 16; ++i) { float a = km[i]; a += __shfl_xor(a, 1); a += __shfl_xor(a, 2); a += __shfl_xor(a, 4); a += __shfl_xor(a, 8); km[i] = a * (1.0f / 256); }
            if (fr == 0) {
                float* kp = (float*)(P.ws + WS_KMP) + ((size_t)wr * 64 + u.pm) * 512 + g.idx * 64 + 8 * fq;
#pragma unroll
                for (int bj = 0; bj < 2; ++bj) {
                    float4 o0, o1; o0.x = km[8 * bj + 0]; o0.y = km[8 * bj + 1]; o0.z = km[8 * bj + 2]; o0.w = km[8 * bj + 3];
                    o1.x = km[8 * bj + 4]; o1.y = km[8 * bj + 5]; o1.z = km[8 * bj + 6]; o1.w = km[8 * bj + 7];
                    *(float4*)(kp + 32 * bj) = o0; *(float4*)(kp + 32 * bj + 4) = o1;
                }
            }
        }
    }
};

struct EpiOut {
    static constexpr bool PERM = true, AFTER_DRAIN = false;
    float* out; bf16_t* XB; float* SSQ; int layer;
    __device__ __forceinline__ void operator()(const pg8::f32x4 (&acc)[2][2][4][2], const pg8::Unit& u, int wr, int wc, int fr, int fq) const {
        const int col0 = u.pn * 256 + wc * 32 + 8 * fq;
#pragma unroll
        for (int ai = 0; ai < 2; ++ai)
#pragma unroll
            for (int m = 0; m < 4; ++m) {
                const int t = u.pm * 256 + ai * 128 + wr * 64 + m * 16 + fr;
                float ss = 0.f;
#pragma unroll
                for (int bj = 0; bj < 2; ++bj) {
                    const size_t o = (size_t)t * DM + col0 + 128 * bj;
                    const pg8::u32x4 rb = *(const pg8::u32x4*)(XB + o);
                    pg8::f32x4 x0, x1;
                    x0[0] = bf2f(rb.x & 0xffff) + acc[ai][bj][m][0][0]; x0[1] = bf2f(rb.x >> 16) + acc[ai][bj][m][0][1]; x0[2] = bf2f(rb.y & 0xffff) + acc[ai][bj][m][0][2]; x0[3] = bf2f(rb.y >> 16) + acc[ai][bj][m][0][3];
                    x1[0] = bf2f(rb.z & 0xffff) + acc[ai][bj][m][1][0]; x1[1] = bf2f(rb.z >> 16) + acc[ai][bj][m][1][1]; x1[2] = bf2f(rb.w & 0xffff) + acc[ai][bj][m][1][2]; x1[3] = bf2f(rb.w >> 16) + acc[ai][bj][m][1][3];
                    if (layer == 0) {
                        pg8::u32x4 w; w.x = pg8::cvt_pk_bf16(x0[0], x0[1]); w.y = pg8::cvt_pk_bf16(x0[2], x0[3]); w.z = pg8::cvt_pk_bf16(x1[0], x1[1]); w.w = pg8::cvt_pk_bf16(x1[2], x1[3]);
                        *(pg8::u32x4*)(XB + o) = w;
                        ss += (x0[0] * x0[0] + x0[1] * x0[1]) + (x0[2] * x0[2] + x0[3] * x0[3]) + (x1[0] * x1[0] + x1[1] * x1[1]) + (x1[2] * x1[2] + x1[3] * x1[3]);
                    } else { *(pg8::f32x4*)(out + o) = x0; *(pg8::f32x4*)(out + o + 4) = x1; }
                }
                if (layer == 0) { ss += __shfl_xor(ss, 16); ss += __shfl_xor(ss, 32); if (fq == 0) SSQ[(size_t)t * 16 + u.pn * 4 + wc] = ss; }
            }
    }
};

__device__ __forceinline__ void cvt_item(const float* __restrict__ W, int ldw, const float* __restrict__ gain, bf16_t* __restrict__ Bt, int Kd, int k0, int drow0, int src0, int vw, LAS float* scr, int lane) {
    {
        const int c = lane & 31, h = lane >> 5;
        if (vw == 32) {
            float v[32];
#pragma unroll
            for (int i = 0; i < 32; ++i) v[i] = W[(size_t)(k0 + 2 * i + h) * ldw + src0 + c];
            if (gain) {
#pragma unroll
                for (int i = 0; i < 32; ++i) v[i] *= gain[k0 + 2 * i + h];
            }
#pragma unroll
            for (int i = 0; i < 32; ++i) scr[(2 * i + h) * 33 + c] = v[i];
        } else {
            const int cc = c < vw ? c : (vw > 0 ? vw - 1 : 0);
#pragma unroll 8
            for (int i = 0; i < 32; ++i) { const int kk = 2 * i + h;
                float v = vw > 0 ? W[(size_t)(k0 + kk) * ldw + src0 + cc] : 0.f; if (gain) v *= gain[k0 + kk];
                scr[kk * 33 + c] = c < vw ? v : 0.f; }
        }
    }
    LDS_WAIT(); asm volatile("" ::: "memory");
    const int c = lane & 7;
#pragma unroll
    for (int j = 0; j < 4; ++j) { const int n = (lane >> 3) + 8 * j; const LAS float* s = scr + (8 * c) * 33 + n;
        v4u o; o.x = pk2(s[0 * 33], s[1 * 33]); o.y = pk2(s[2 * 33], s[3 * 33]); o.z = pk2(s[4 * 33], s[5 * 33]); o.w = pk2(s[6 * 33], s[7 * 33]);
        *(v4u*)(Bt + (size_t)(drow0 + n) * Kd + k0 + 8 * c) = o; }
    LDS_WAIT(); asm volatile("" ::: "memory");
}
__device__ __forceinline__ void cvt_in_item(const KArgs& P, int layer, int it, LAS float* scr, int lane) {
    const int kb = it & 15, blk = it >> 4, pn = blk >> 3, pb = blk & 7, wc = pb & 3, bj = pb >> 2;
    const NvGroup g = fast_group(P, layer, pn, wc);
    int src0 = 0, vw = 0;
    if (g.type == 4) { src0 = bj ? g.col2 : g.col; vw = 32; }
    else if (g.type != 5) { src0 = g.col + 32 * bj; vw = g.width - 32 * bj; vw = vw < 0 ? 0 : (vw > 32 ? 32 : vw); }
    const float* W = layer == 0 ? P.e_w_in : P.o_w_in; const int ldw = layer == 0 ? 3584 : 3096;
    bf16_t* Bt = (bf16_t*)(P.ws + (layer == 0 ? WS_WIN0 : WS_WIN1));
    cvt_item(W, ldw, P.norm_g + layer * DM, Bt, DM, 64 * kb, 256 * pn + 128 * bj + 32 * wc, src0, vw, scr, lane);
}
__device__ __forceinline__ void p0_prologue(const KArgs& P, LAS unsigned char* lds, int vcu, int G, int wave, int lane) {
    LAS float* scr = (LAS float*)(lds + wave * 16384);
    const int gw = vcu * 8 + wave, NGW = G * 8;
    constexpr int I_IN0 = NTILE_IN0 * 8 * 16, I_IN1 = NTILE_IN1 * 8 * 16, I_OUT = 32 * 16, I_W1 = 128, I_W2 = 2 * 4;
    constexpr int I_B1P = 128, I_WG = 16;
    constexpr int NITEMS = I_WG + I_B1P + I_IN0 + I_IN1 + 2 * I_OUT + 2 * I_W1 + 2 * I_W2;
    for (int it = gw; it < NITEMS; it += NGW) {
        int r = it;
        if (r < I_WG) { cvt_item(P.o_w_in, 3096, P.norm_g + DM, (bf16_t*)(P.ws + WS_WGATE), DM, 64 * r, 0, 1280, 24, scr, lane); continue; } r -= I_WG;
        if (r < I_B1P) { fm::b1p_item(P, r, lane); continue; } r -= I_B1P;
        if (r < I_IN0) { cvt_in_item(P, 0, r, scr, lane); continue; } r -= I_IN0;
        if (r < I_IN1) { cvt_in_item(P, 1, r, scr, lane); continue; } r -= I_IN1;
        if (r < 2 * I_OUT) { const int l = r / I_OUT; r -= l * I_OUT; const int kb = r & 15, nb = r >> 4;
            cvt_item(P.w_out + (size_t)l * DM * DM, DM, nullptr, (bf16_t*)(P.ws + (l == 0 ? WS_WOUT0 : WS_WOUT1)), DM, 64 * kb, 32 * nb, 32 * nb, 32, scr, lane); continue; }
        r -= 2 * I_OUT;
        if (r < 2 * I_W1) { fm::w1f_item(P, r, lane); continue; }
        r -= 2 * I_W1;
        { const int kv = r / I_W2; r -= kv * I_W2; const int kb = r & 3, nb = r >> 2;
            cvt_item(kv == 0 ? P.c_k_w2 : P.c_v_w2, 64, nullptr, (bf16_t*)(P.ws + WS_CW2) + (size_t)kv * 64 * 256, 256, 64 * kb, 32 * nb, 32 * nb, 32, scr, lane); }
    }
    bf16_t* XB = (bf16_t*)(P.ws + WS_XB); float* SSQ = (float*)(P.ws + WS_SSQ);
    for (int m = gw; m < NT; m += NGW) {
        const float4* r = (const float4*)(P.x + (size_t)m * DM);
        float s = 0.f;
#pragma unroll
        for (int j = 0; j < 4; ++j) {
            const float4 v = r[lane + 64 * j];
            s += v.x * v.x + v.y * v.y + v.z * v.z + v.w * v.w;
            uint2 o; o.x = pg8::cvt_pk_bf16(v.x, v.y); o.y = pg8::cvt_pk_bf16(v.z, v.w);
            *(uint2*)(XB + (size_t)m * DM + (lane + 64 * j) * 4) = o;
        }
#pragma unroll
        for (int o = 1; o < 64; o <<= 1) s += __shfl_xor(s, o);
        if (lane < 4) { float4 q; q.x = lane == 0 ? s : 0.f; q.y = 0.f; q.z = 0.f; q.w = 0.f; *(float4*)(SSQ + (size_t)m * 16 + lane * 4) = q; }
    }
}

constexpr int CW_WQ2 = 8192, CW_WQ2C = 8192 + 512, CW_WQ6 = 8192 + 1024;
#define WQ_FIRST(ctrptr) unsigned* ctr_ = (ctrptr); \
        if (tid == 0) MISC[12] = __hip_atomic_fetch_add(ctr_, 1u, __ATOMIC_RELAXED, __HIP_MEMORY_SCOPE_AGENT); \
        __syncthreads(); \
        int it_ = (int)MISC[12];
#define WQ_WHILE(LIMIT, ...) while (it_ < (LIMIT)) { \
            unsigned nx_ = 0u; if (tid == 0) nx_ = __hip_atomic_fetch_add(ctr_, 1u, __ATOMIC_RELAXED, __HIP_MEMORY_SCOPE_AGENT);     \
            { const int it = it_; __VA_ARGS__ } \
            __syncthreads(); if (tid == 0) MISC[12] = nx_; __syncthreads(); it_ = (int)MISC[12]; \
        }
#define WQ_QUEUES(cwbase, QLEN, ...) do { const int xcc_ = (int)(xb_xcc_id() & 7u); unsigned* qb_ = (unsigned*)(P.ws + WS_CTL) + (cwbase); \
        for (int qi_ = 0; qi_ < 8; ++qi_) { const int q = (xcc_ + qi_) & 7; \
            if (qi_ == 1) { __syncthreads(); if (tid < 8) MISC[24 + tid] = __hip_atomic_load(qb_ + 64 * tid, __ATOMIC_RELAXED, __HIP_MEMORY_SCOPE_AGENT); __syncthreads(); } \
            if (qi_ >= 1 && MISC[24 + q] >= (unsigned)(QLEN)) continue; \
            WQ_FIRST(qb_ + 64 * q) __VA_ARGS__ } } while (0)

constexpr int RING_BYTES = 131072, LDSCTL_OFF = RING_BYTES, MISC_OFF = LDSCTL_OFF + 320, LDS_BYTES = 147456;
constexpr int CW_BAR = 4096;
constexpr int NPHASE = 8;

__global__ void __launch_bounds__(512, 2) mk_fwd(KArgs P) {
    extern __shared__ __attribute__((aligned(16))) unsigned char lds_raw[];
    LAS unsigned char* lds = (LAS unsigned char*)lds_raw;
    volatile LAS unsigned* MISC = (volatile LAS unsigned*)(lds + MISC_OFF);
    const int tid = threadIdx.x, lane = tid & 63, wave = __builtin_amdgcn_readfirstlane(tid >> 6);
    const int G = gridDim.x, bx = blockIdx.x, vcu = (G % 8 == 0) ? (bx % 8) * (G / 8) + bx / 8 : bx;
    for (int u = tid; u < (LDS_BYTES - LDSCTL_OFF) / 4; u += 512) ((LAS unsigned*)(lds + LDSCTL_OFF))[u] = 0u;
    __syncthreads();
#ifdef PROBE_A
#define STAMP(n) do { if (bx == 0 && tid == 0) MISC[16 + (n)] = (unsigned)__builtin_amdgcn_s_memrealtime(); } while (0)
#else
#define STAMP(n) do {} while (0)
#endif
    const int lo = P.ph_lo, hi = P.ph_hi;
    STAMP(0);
    XcdBarrier bar; bar.bar = (unsigned*)(P.ws + WS_CTL) + CW_BAR; bar.x = 0; bar.st = nullptr;
    if (hi - lo > 1) bar = xcd_barrier_post((unsigned*)(P.ws + WS_CTL) + CW_BAR, MISC + 8);
#define IN(k) (lo <= (k) && (k) < hi)
#define SEAM(k) do { STAMP(2 * (k) + 1); if (IN(k) && IN((k) + 1)) xcd_barrier(bar); STAMP(2 * (k) + 2); } while (0)

    if (IN(0)) {
        p0_prologue(P, lds, vcu, G, wave, lane); SEAM(0);
    }
    if (IN(1)) {
        pg8::Gemm g{(const bf16_t*)(P.ws + WS_XB), (const bf16_t*)(P.ws + WS_WIN0), NT, NTILE_IN0 * 256, DM}; pg8::StaticOrder S; S.init(NT, NTILE_IN0 * 256, G, bx);
        EpiIn E{P, 0};
        pg8::gemm_phase<EpiIn, pg8::StaticOrder, true, true>(lds, g, S, E);
        SEAM(1);
    }
    if (IN(2)) {
        for (int k = vcu; k < 512; k += G) { const int kk = k < 256 ? k : k - 256, bh = kk >> 2, own = k < 256 ? 7 - (kk & 3) : (kk & 3);
            fa::moba_unit(P, (fa::lds_ptr)lds, bh >> 3, bh & 7, own, wave, lane); }
        STAMP(20);
        {
            fm::ConvW cw; fm::conv_load_w(P, cw, tid, lane);
            for (int k = vcu; k < 512; k += G) fm::conv_unit(P, lds, k, cw, tid, wave, lane);
        }
        SEAM(2);
    }
    if (IN(3)) {
        pg8::Gemm g{(const bf16_t*)(P.ws + WS_Y), (const bf16_t*)(P.ws + WS_WOUT0), NT, DM, DM}; pg8::StaticOrder S; S.init(NT, DM, G, bx);
        EpiOut E{P.out, (bf16_t*)(P.ws + WS_XB), (float*)(P.ws + WS_SSQ), 0};
        pg8::gemm_phase<EpiOut, pg8::StaticOrder, true, true>(lds, g, S, E);
        SEAM(3);
    }
    if (IN(4)) {
        pg8::Gemm g{(const bf16_t*)(P.ws + WS_XB), (const bf16_t*)(P.ws + WS_WIN1), NT, NTILE_IN1 * 256, DM}; pg8::StaticOrder S; S.init(NT, NTILE_IN1 * 256, G, bx);
        EpiIn E{P, 1};
        pg8::gemm_phase<EpiIn, pg8::StaticOrder, true, true>(lds, g, S, E);
        SEAM(4);
    }
    if (IN(5)) {
        for (int k = vcu; k < 256; k += G) fm::gate_unit(P, lds, k, tid, wave, lane);
        STAMP(21);
        if (P.flags & 16) for (int k = vcu; k < 256; k += G) fm::cmp_unit(P, lds, k, tid, wave, lane);
        SEAM(5);
    }
    if (IN(6)) {
        for (int k = vcu; k < 512; k += G) { const int kk = k < 256 ? k : k - 256, bg = kk >> 4, c = k < 256 ? 31 - (kk & 15) : (kk & 15);
            fa::nsa_unit(P, (fa::lds_ptr)lds, bg >> 1, bg & 1, c, wave, lane, tid); }
        STAMP(22);
        for (int k = vcu; k < 512; k += G) { const int kk = k < 256 ? k : k - 256, bg = kk >> 4, c = k < 256 ? 31 - (kk & 15) : (kk & 15);
            fa::swa_unit(P, (fa::lds_ptr)lds, bg >> 1, bg & 1, c, wave, lane); }
        SEAM(6);
    }
    if (IN(7)) {
        pg8::Gemm g{(const bf16_t*)(P.ws + WS_Y), (const bf16_t*)(P.ws + WS_WOUT1), NT, DM, DM}; pg8::StaticOrder S; S.init(NT, DM, G, bx);
        EpiOut E{P.out, (bf16_t*)(P.ws + WS_XB), nullptr, 1};
        pg8::gemm_phase<EpiOut, pg8::StaticOrder, true, true>(lds, g, S, E);
    }
#ifdef PROBE_A
    if (bx == 0 && tid == 0) {
        const unsigned dt = (MISC[16 + PROBE_B] - MISC[16 + PROBE_A]) * 8u, t0 = (unsigned)__builtin_amdgcn_s_memrealtime();
        while ((unsigned)__builtin_amdgcn_s_memrealtime() - t0 < dt) __builtin_amdgcn_s_sleep(8);
    }
#endif
#undef IN
#undef SEAM
}
static void fill_args(KArgs& a, void* const* d_in, void* d_out, void* d_ws) {
    const float** p = (const float**)&a;
    for (int i = 0; i < 28; ++i) p[i] = (const float*)d_in[i];
    a.out = (float*)d_out; a.ws = (unsigned char*)d_ws; a.ph_lo = 0; a.ph_hi = NPHASE; a.flags = 31; a.pad = 0;
}
static int g_grid = 0;
extern "C" void kernel_launch(void* const* d_in, const int* in_sizes, int n_in, void* d_out, int out_size, void* d_ws, size_t ws_size, hipStream_t stream) {
    if (n_in != 28 || out_size != NT * DM || ws_size < WS_END) { fprintf(stderr, "kernel_launch: unexpected shapes n_in %d out %d ws %zu\n", n_in, out_size, ws_size); return; }
    if (g_grid == 0) {
        int dev = 0, cus = 0;
        if (hipGetDevice(&dev) != hipSuccess || hipDeviceGetAttribute(&cus, hipDeviceAttributeMultiprocessorCount, dev) != hipSuccess) { fprintf(stderr, "kernel_launch: device query failed\n"); g_grid = -1; return; }
        if (hipFuncSetAttribute((const void*)mk_fwd, hipFuncAttributeMaxDynamicSharedMemorySize, LDS_BYTES) != hipSuccess) { fprintf(stderr, "kernel_launch: hipFuncSetAttribute failed\n"); g_grid = -1; return; }
        int per_cu = 0;
        if (hipOccupancyMaxActiveBlocksPerMultiprocessor(&per_cu, (const void*)mk_fwd, 512, LDS_BYTES) != hipSuccess || per_cu < 1) { fprintf(stderr, "kernel_launch: occupancy query says %d blocks/CU\n", per_cu); }
        (void)hipGetLastError();
        g_grid = cus;
    }
    if (g_grid < 0) return;
    KArgs a{}; fill_args(a, d_in, d_out, d_ws);
    (void)hipMemsetAsync((char*)d_ws + WS_CTL, 0, 64 * 1024, stream);
    hipLaunchKernelGGL(mk_fwd, dim3(g_grid), dim3(512), LDS_BYTES, stream, a);
}
```

```cpp
#include <hip/hip_runtime.h>
#include <stdint.h>
#include <stdio.h>

typedef unsigned short bf16_t;
constexpr int NB = 8, SEQ = 2048, NT = NB * SEQ, DM = 1024;
#define EPSF 1e-6f
#define LOG2E 1.4426950408889634f
#define QSCALE (0.125f * 1.4426950408889634f)

constexpr size_t MiB = 1u << 20;
constexpr size_t WS_CTL = 0, WS_SSQ = 5 * MiB, WS_KMP = 1 * MiB + 512 * 1024, WS_B1P = 1 * MiB + 768 * 1024, WS_GT = 2 * MiB, WS_KC = 4 * MiB, WS_VC = 4 * MiB + 256 * 1024;
constexpr size_t WS_WIN0 = 6 * MiB, WS_WOUT0 = 13 * MiB, WS_WIN1 = 15 * MiB, WS_WOUT1 = 22 * MiB, WS_CW1 = 24 * MiB, WS_CW2 = 26 * MiB, WS_WGATE = 27 * MiB;
constexpr size_t WS_XB = 32 * MiB, WS_Y = 64 * MiB;
constexpr size_t WS_G0 = 96 * MiB, WS_ZA = 112 * MiB, WS_QB = 128 * MiB, WS_KB = 144 * MiB, WS_VB = 160 * MiB, WS_ZB = 176 * MiB;
constexpr size_t WS_QC = 96 * MiB, WS_ZC = 112 * MiB, WS_QD = 128 * MiB, WS_ZD = 144 * MiB;
constexpr size_t WS_KCR = 160 * MiB, WS_VCR = 164 * MiB, WS_KS = 168 * MiB, WS_VS = 172 * MiB, WS_KW = 176 * MiB, WS_VW = 180 * MiB, WS_KD = 184 * MiB, WS_VD = 188 * MiB;
constexpr size_t WS_NVTMP = 192 * MiB, WS_END = 200 * MiB;

struct KArgs {
    const float *x, *norm_g, *w_out, *e_w_in, *a_conv_w, *a_conv_b, *a_ln_g, *a_ln_b, *b_qnorm_g, *b_knorm_g, *o_w_in, *c_qnorm_g, *c_knorm_cmp_g, *c_knorm_slc_g,
        *c_knorm_win_g, *c_pos_k, *c_pos_v, *c_k_w1, *c_k_b1, *c_k_w2, *c_k_b2, *c_v_w1, *c_v_b1, *c_v_w2, *c_v_b2, *d_qnorm_g, *d_knorm_g, *d_sinks;
    float* out; unsigned char* ws;
    int ph_lo, ph_hi, flags, pad;
};

__device__ __forceinline__ float bf2f(unsigned v) { return __uint_as_float(v << 16); }
__device__ __forceinline__ unsigned f2bf_u(float f) { unsigned u = __float_as_uint(f); return (u + 0x7fffu + ((u >> 16) & 1u)) >> 16; }
__device__ __forceinline__ bf16_t f2bf(float f) { return (bf16_t)f2bf_u(f); }
__device__ __forceinline__ unsigned pk2(float lo, float hi) { return f2bf_u(lo) | (f2bf_u(hi) << 16); }
__device__ __forceinline__ float fast_silu(float v) { return v * __builtin_amdgcn_rcpf(1.f + __expf(-v)); }
__device__ __forceinline__ float fast_sigmoid(float v) { return __builtin_amdgcn_rcpf(1.f + __expf(-v)); }
struct NvGroup { int col, width, type; const float* gain; float scale; int dkind; void* dst; int ld, idx, col2; };

__device__ __forceinline__ NvGroup nv_group0(const KArgs& P, int gi) {
    NvGroup g; g.gain = nullptr; g.scale = 1.f; g.col2 = 0; g.width = 64;
    const int j = gi & 7;
    switch (gi >> 3) {
    case 0: g.col = 64 * j; g.col2 = 512 + 64 * j; g.type = 4; g.dkind = 0; g.dst = P.ws + WS_G0; g.ld = 512; g.idx = j; break;
    case 1: g.col = 1024 + 64 * j; g.type = 1; g.dkind = 0; g.dst = P.ws + WS_ZA; g.ld = 512; g.idx = j; break;
    case 2: g.col = 1536 + 64 * j; g.type = 2; g.gain = P.b_qnorm_g; g.scale = QSCALE; g.dkind = 1; g.dst = P.ws + WS_QB; g.ld = 8; g.idx = j; break;
    case 3: g.col = 2048 + 64 * j; g.type = 2; g.gain = P.b_knorm_g; g.dkind = 3; g.dst = P.ws + WS_KB; g.ld = 8; g.idx = j; break;
    case 4: g.col = 2560 + 64 * j; g.type = 0; g.dkind = 4; g.dst = P.ws + WS_VB; g.ld = 8; g.idx = j; break;
    default: g.col = 3072 + 64 * j; g.type = 1; g.dkind = 0; g.dst = P.ws + WS_ZB; g.ld = 512; g.idx = j; break;
    }
    return g;
}
__device__ __forceinline__ NvGroup nv_group1(const KArgs& P, int gi) {
    NvGroup g; g.gain = nullptr; g.scale = 1.f; g.col2 = 0; g.width = 64;
    if (gi < 8) { g.col = 64 * gi; g.type = 2; g.gain = P.c_qnorm_g; g.scale = QSCALE; g.dkind = 1; g.dst = P.ws + WS_QC; g.ld = 8; g.idx = gi; return g; }
    gi -= 8;
    if (gi < 12) {
        const int which = gi >> 1, hh = gi & 1;
        g.col = 512 + 128 * which + 64 * hh; g.dkind = (which < 2) ? 1 : ((which & 1) ? 4 : 3); g.ld = 2; g.idx = hh;
        g.dst = P.ws + (which == 0 ? WS_KCR : which == 1 ? WS_VCR : which == 2 ? WS_KS : which == 3 ? WS_VS : which == 4 ? WS_KW : WS_VW);
        if (which == 2) { g.type = 2; g.gain = P.c_knorm_slc_g; } else if (which == 4) { g.type = 2; g.gain = P.c_knorm_win_g; } else g.type = 0;
        return g;
    }
    gi -= 12;
    if (gi < 1) { g.col = 1280; g.width = 24; g.type = 3; g.dkind = 2; g.dst = P.ws + WS_GT; g.ld = 32; g.idx = 0; return g; }
    gi -= 1;
    if (gi < 8) { g.col = 1304 + 64 * gi; g.type = 1; g.dkind = 0; g.dst = P.ws + WS_ZC; g.ld = 512; g.idx = gi; return g; }
    gi -= 8;
    if (gi < 8) { g.col = 1816 + 64 * gi; g.type = 2; g.gain = P.d_qnorm_g; g.scale = QSCALE; g.dkind = 1; g.dst = P.ws + WS_QD; g.ld = 8; g.idx = gi; return g; }
    gi -= 8;
    if (gi < 2) { g.col = 2328 + 64 * gi; g.type = 2; g.gain = P.d_knorm_g; g.dkind = 3; g.dst = P.ws + WS_KD; g.ld = 2; g.idx = gi; return g; }
    gi -= 2;
    if (gi < 2) { g.col = 2456 + 64 * gi; g.type = 0; g.dkind = 4; g.dst = P.ws + WS_VD; g.ld = 2; g.idx = gi; return g; }
    gi -= 2;
    g.col = 2584 + 64 * gi; g.type = 1; g.dkind = 0; g.dst = P.ws + WS_ZD; g.ld = 512; g.idx = gi; return g;
}
namespace pg8 {
#define PG8_LAS __attribute__((address_space(3)))
typedef short bf16x8 __attribute__((ext_vector_type(8)));
typedef float f32x4 __attribute__((ext_vector_type(4)));
typedef unsigned u32x4 __attribute__((ext_vector_type(4)));
constexpr int BM = 256, BK = 64, HALF = 128, HTB = HALF * BK * 2  , STAGE_BYTES = 8 * HTB, NXCD = 8, WGM = 8;

__host__ __device__ __forceinline__ int lds_byte(int r, int c) { const int st = (r >> 4) * 2 + (c >> 5), rr = r & 15, cc = c & 31, ob = rr * 64 + cc * 2; return st * 1024 + (ob ^ (((ob >> 9) & 1) << 5)); }
__host__ __device__ __forceinline__ void stage_rc(int b, int& R, int& C) { const int st = b / 1024, sb = b % 1024, swz = sb ^ (((sb >> 9) & 1) << 5); R = (st >> 1) * 16 + swz / 64; C = (st & 1) * 32 + (swz % 64) / 2; }
__host__ __device__ __forceinline__ int perm32(int rho) { const int n = rho >> 4, i = rho & 15; return 8 * (i >> 2) + 4 * n + (i & 3); }

struct Unit { int pm, pn; };
struct Gemm { const bf16_t* A; const bf16_t* Bt; int M, N, K; };

struct StaticOrder {
    int nM, nN, nwg, G, c;
    __host__ __device__ void init(int M, int N, int G_, int c_) { nM = M / BM; nN = N / BM; nwg = nM * nN; G = G_; c = c_; }
    __host__ __device__ bool next(int i, Unit& u) const {
        const long L = (long)i * G + c; if (L >= nwg) return false;
        int wgid = (int)L; { const int q = nwg / NXCD, r = nwg % NXCD, xcd = wgid % NXCD, off = wgid / NXCD; wgid = (xcd < r ? xcd * (q + 1) : r * (q + 1) + (xcd - r) * q) + off; }
        const int nig = WGM * nN, gid = wgid / nig, fm = gid * WGM, gsz = (nM - fm) < WGM ? (nM - fm) : WGM;
        u.pm = fm + ((wgid % nig) % gsz); u.pn = (wgid % nig) / gsz; return true;
    }
    __device__ __forceinline__ void a_ready(const Unit&) const {}
    __device__ __forceinline__ void done(const Unit&) const {}
};

__device__ __forceinline__ unsigned cvt_pk_bf16(float lo, float hi) { unsigned r; asm volatile("v_cvt_pk_bf16_f32 %0, %1, %2" : "=v"(r) : "v"(lo), "v"(hi)); return r; }
template <class Epi, class Sched, bool ALIGN_EPI = false, bool SP2 = false>
__device__ __forceinline__ void gemm_phase(PG8_LAS unsigned char* lds, const Gemm g, const Sched& S, const Epi& E) {
    const int tid = threadIdx.x, wid = __builtin_amdgcn_readfirstlane(tid >> 6), lane = tid & 63, wr = wid >> 2, wc = wid & 3, fr = lane & 15, fq = lane >> 4;
    const int K = g.K, nt = K / BK;
    unsigned voffA[2], voffB[2];
#pragma unroll
    for (int i = 0; i < 2; ++i) { int R, C; stage_rc(tid * 16 + i * 8192, R, C); const int Rb = Epi::PERM ? ((R & ~31) + perm32(R & 31)) : R;
        voffA[i] = (unsigned)(R * K + C) * 2u; voffB[i] = (unsigned)(Rb * K + C) * 2u; }
    const size_t kstep = (size_t)(BK * 2);
    const size_t hstep = (size_t)HALF * K * 2;
    const size_t tstep = 2 * hstep;
    const unsigned ldsw = (unsigned)wid * 1024u;
    const int aoff = lds_byte(wr * 64 + fr, fq * 8), boff = lds_byte(wc * 32 + fr, fq * 8);
#define PG8_SA(b, h) (((b) * 2 + (h)) * HTB)
#define PG8_SB(b, h) ((4 + (b) * 2 + (h)) * HTB)
#define PG8_STAGE(bufoff, gbase, voff) do { _Pragma("unroll") for (int _i = 0; _i < 2; ++_i) \
        __builtin_amdgcn_global_load_lds((const unsigned*)((const char*)(gbase) + (voff)[_i]), (PG8_LAS unsigned*)(lds + (bufoff) + ldsw + _i * 8192), 16, 0, 0); } while (0)
#define PG8_LDA(dst, b, h) do { _Pragma("unroll") for (int m = 0; m < 4; ++m) _Pragma("unroll") for (int k = 0; k < 2; ++k) dst[m][k] = *(const PG8_LAS bf16x8*)(lds + PG8_SA(b, h) + aoff + m * 2048 + k * 1024); } while (0)
#define PG8_LDB(dst, b, h) do { _Pragma("unroll") for (int n = 0; n < 2; ++n) _Pragma("unroll") for (int k = 0; k < 2; ++k) dst[n][k] = *(const PG8_LAS bf16x8*)(lds + PG8_SB(b, h) + boff + n * 2048 + k * 1024); } while (0)
#define PG8_MMA(ai, bj, At, Bt) do { __builtin_amdgcn_s_setprio(1); _Pragma("unroll") for (int m = 0; m < 4; ++m) _Pragma("unroll") for (int n = 0; n < 2; ++n) _Pragma("unroll") for (int k = 0; k < 2; ++k) \
        acc[ai][bj][m][n] = __builtin_amdgcn_mfma_f32_16x16x32_bf16(Bt[n][k], At[m][k], acc[ai][bj][m][n], 0, 0, 0); __builtin_amdgcn_s_setprio(0); } while (0)
#define PG8_WAIT_V(n) asm volatile("s_waitcnt vmcnt(" #n ")" ::: "memory")
#define PG8_WAIT_L(n) asm volatile("s_waitcnt lgkmcnt(" #n ")" ::: "memory")
#define PG8_BAR __builtin_amdgcn_s_barrier()
#define PG8_SCHED __builtin_amdgcn_sched_barrier(0)
    Unit cur, nxt; int ui = 0;
    if (!S.next(0, cur)) return;
    f32x4 acc[2][2][4][2];
#pragma unroll
    for (int a = 0; a < 2; ++a)
#pragma unroll
        for (int b = 0; b < 2; ++b)
#pragma unroll
            for (int m = 0; m < 4; ++m)
#pragma unroll
                for (int n = 0; n < 2; ++n) acc[a][b][m][n] = (f32x4){0.f, 0.f, 0.f, 0.f};
    bf16x8 At[4][2], B0[2][2], B1[2][2];
    const char* cA = (const char*)g.A + (size_t)cur.pm * tstep; const char* cB = (const char*)g.Bt + (size_t)cur.pn * tstep;
    S.a_ready(cur);
    if constexpr (SP2) {
        PG8_STAGE(PG8_SB(0, 0), cB, voffB); PG8_STAGE(PG8_SB(0, 1), cB + hstep, voffB); PG8_STAGE(PG8_SA(0, 0), cA, voffA); PG8_STAGE(PG8_SA(0, 1), cA + hstep, voffA);
        if (wr == 1) PG8_BAR;
        PG8_WAIT_V(2); PG8_BAR;
        PG8_STAGE(PG8_SB(1, 0), cB + kstep, voffB); PG8_STAGE(PG8_SA(1, 0), cA + kstep, voffA); PG8_STAGE(PG8_SB(1, 1), cB + hstep + kstep, voffB);
        PG8_WAIT_V(6); PG8_BAR;
    } else {
        PG8_STAGE(PG8_SB(0, 0), cB, voffB); PG8_STAGE(PG8_SA(0, 0), cA, voffA); PG8_STAGE(PG8_SB(0, 1), cB + hstep, voffB); PG8_STAGE(PG8_SA(0, 1), cA + hstep, voffA);
        if (wr == 1) PG8_BAR;
        PG8_WAIT_V(4); PG8_BAR;
        PG8_STAGE(PG8_SB(1, 0), cB + kstep, voffB); PG8_STAGE(PG8_SA(1, 0), cA + kstep, voffA); PG8_STAGE(PG8_SB(1, 1), cB + hstep + kstep, voffB);
        PG8_WAIT_V(6); PG8_BAR;
    }
    for (;;) {
        const bool has_next = S.next(ui + 1, nxt);
        const char* nA = has_next ? (const char*)g.A + (size_t)nxt.pm * tstep : cA; const char* nB = has_next ? (const char*)g.Bt + (size_t)nxt.pn * tstep : cB;
        for (int t = 0; t < nt; t += 2) {
            const bool last = (t == nt - 2);
            const char* a1 = cA + (size_t)(t + 1) * kstep;
            const char* a2 = last ? nA : cA + (size_t)(t + 2) * kstep; const char* b2 = last ? nB : cB + (size_t)(t + 2) * kstep;
            const char* a3 = a2 + kstep; const char* b3 = b2 + kstep;
            if (last && has_next) S.a_ready(nxt);
            if constexpr (SP2) {
            PG8_LDB(B0, 0, 0); PG8_LDB(B1, 0, 1); PG8_SCHED; PG8_LDA(At, 0, 0); PG8_STAGE(PG8_SA(1, 1), a1 + hstep, voffA);
            PG8_WAIT_V(8); PG8_WAIT_L(0); PG8_BAR; PG8_MMA(0, 0, At, B0); PG8_MMA(0, 1, At, B1); PG8_BAR; PG8_SCHED;
            PG8_LDA(At, 0, 1); PG8_STAGE(PG8_SB(0, 0), b2, voffB); PG8_STAGE(PG8_SB(0, 1), b2 + hstep, voffB); PG8_STAGE(PG8_SA(0, 0), a2, voffA);
            PG8_WAIT_V(8); PG8_WAIT_L(0); PG8_BAR; PG8_MMA(1, 0, At, B0); PG8_MMA(1, 1, At, B1); PG8_BAR; PG8_SCHED;
            PG8_LDB(B0, 1, 0); PG8_LDB(B1, 1, 1); PG8_SCHED; PG8_LDA(At, 1, 0); PG8_STAGE(PG8_SA(0, 1), a2 + hstep, voffA);
            PG8_WAIT_V(8); PG8_WAIT_L(0); PG8_BAR; PG8_MMA(0, 0, At, B0); PG8_MMA(0, 1, At, B1); PG8_BAR; PG8_SCHED;
            PG8_LDA(At, 1, 1); PG8_STAGE(PG8_SB(1, 0), b3, voffB); PG8_STAGE(PG8_SB(1, 1), b3 + hstep, voffB); PG8_STAGE(PG8_SA(1, 0), a3, voffA);
            PG8_WAIT_V(8); PG8_WAIT_L(0); PG8_BAR; PG8_MMA(1, 0, At, B0); PG8_MMA(1, 1, At, B1); PG8_BAR; PG8_SCHED;
            } else {
            PG8_LDB(B0, 0, 0); PG8_SCHED; PG8_LDA(At, 0, 0); PG8_STAGE(PG8_SA(1, 1), a1 + hstep, voffA);
            PG8_WAIT_L(8); PG8_BAR; PG8_WAIT_L(0); PG8_MMA(0, 0, At, B0); PG8_BAR; PG8_SCHED;
            PG8_LDB(B1, 0, 1); PG8_STAGE(PG8_SB(0, 0), b2, voffB);
            PG8_BAR; PG8_WAIT_L(0); PG8_MMA(0, 1, At, B1); PG8_BAR;
            PG8_LDA(At, 0, 1); PG8_STAGE(PG8_SA(0, 0), a2, voffA);
            PG8_BAR; PG8_WAIT_L(0); PG8_MMA(1, 0, At, B0); PG8_BAR; PG8_SCHED;
            PG8_STAGE(PG8_SB(0, 1), b2 + hstep, voffB);
            PG8_WAIT_V(6); PG8_BAR; PG8_MMA(1, 1, At, B1); PG8_BAR;
            PG8_LDB(B0, 1, 0); PG8_SCHED; PG8_LDA(At, 1, 0); PG8_STAGE(PG8_SA(0, 1), a2 + hstep, voffA);
            PG8_WAIT_L(8); PG8_BAR; PG8_WAIT_L(0); PG8_MMA(0, 0, At, B0); PG8_BAR; PG8_SCHED;
            PG8_LDB(B1, 1, 1); PG8_STAGE(PG8_SB(1, 0), b3, voffB);
            PG8_BAR; PG8_WAIT_L(0); PG8_MMA(0, 1, At, B1); PG8_BAR;
            PG8_LDA(At, 1, 1); PG8_STAGE(PG8_SA(1, 0), a3, voffA);
            PG8_BAR; PG8_WAIT_L(0); PG8_MMA(1, 0, At, B0); PG8_BAR; PG8_SCHED;
            PG8_STAGE(PG8_SB(1, 1), b3 + hstep, voffB);
            PG8_WAIT_V(6); PG8_BAR; PG8_MMA(1, 1, At, B1); PG8_BAR;
            }
        }
        if constexpr (ALIGN_EPI) { if (wr == 0) PG8_BAR; }
        if constexpr (!Epi::AFTER_DRAIN) { E(acc, cur, wr, wc, fr, fq); S.done(cur); }
        if (!has_next) break;
#pragma unroll
        for (int a = 0; a < 2; ++a)
#pragma unroll
            for (int b = 0; b < 2; ++b)
#pragma unroll
                for (int m = 0; m < 4; ++m)
#pragma unroll
                    for (int n = 0; n < 2; ++n) acc[a][b][m][n] = (f32x4){0.f, 0.f, 0.f, 0.f};
        cur = nxt; cA = nA; cB = nB; ++ui;
        if constexpr (ALIGN_EPI) { if (wr == 1) PG8_BAR; }
    }
    PG8_WAIT_V(0);
    if constexpr (!ALIGN_EPI) { if (wr == 0) PG8_BAR; }
    PG8_BAR;
    if constexpr (Epi::AFTER_DRAIN) { E.fused(acc, cur, wr, wc, fr, fq, lds, wid, lane); S.done(cur); }
#undef PG8_SA
#undef PG8_SB
#undef PG8_STAGE
#undef PG8_LDA
#undef PG8_LDB
#undef PG8_MMA
#undef PG8_WAIT_V
#undef PG8_WAIT_L
#undef PG8_BAR
#undef PG8_SCHED
}
}
#define GAS __attribute__((address_space(1)))
#define LAS __attribute__((address_space(3)))
typedef unsigned v4u __attribute__((ext_vector_type(4)));
typedef float f32x4 __attribute__((ext_vector_type(4)));
typedef short bf16x8 __attribute__((ext_vector_type(8)));
typedef GAS unsigned gu32;
typedef GAS unsigned long long gu64;
#define RLX_AGENT __ATOMIC_RELAXED, __HIP_MEMORY_SCOPE_AGENT
#define LDS_WAIT() asm volatile("s_waitcnt lgkmcnt(0)" ::: "memory")
#define VM_WAIT() asm volatile("s_waitcnt vmcnt(0)" ::: "memory")
__device__ __forceinline__ unsigned long long rt() { return __builtin_amdgcn_s_memrealtime(); }

#define XB_TMO      128
#define XB_XCNT(j)  (256  + 64 * (j))
#define XB_XSUB(j)  (1280 + 64 * (j))
#define XB_XGEN(j)  (2304 + 64 * (j))
#define XB_TOP      3328
#define XB_TOPGEN   3392
#define XCD_BAR_WORDS 3456
#define XB_SPIN_CAP (1u << 18)

__device__ __forceinline__ unsigned xb_ld(unsigned* p)              { return __hip_atomic_load(p, __ATOMIC_RELAXED, __HIP_MEMORY_SCOPE_AGENT); }
__device__ __forceinline__ unsigned xb_add(unsigned* p, unsigned v) { return __hip_atomic_fetch_add(p, v, __ATOMIC_RELAXED, __HIP_MEMORY_SCOPE_AGENT); }
__device__ __forceinline__ unsigned xb_xcc_id() { return (unsigned)__builtin_amdgcn_s_getreg((3 << 11) | 20) & 0xFu; }
#define XB_SPIN(cond, bar) do { unsigned _sp = 0; while (cond) { __builtin_amdgcn_s_sleep(1); \
    if ((++_sp & 255u) == 0u) { if (xb_ld(&(bar)[XB_TMO])) break; if (_sp > XB_SPIN_CAP) { atomicAdd(&(bar)[XB_TMO], 1u); break; } } } } while (0)

struct XcdBarrier {
    unsigned* bar; unsigned x;
    volatile LAS unsigned* st;
};

__device__ __forceinline__ XcdBarrier xcd_barrier_post(unsigned* bar, volatile LAS unsigned* st) {
    XcdBarrier b; b.bar = bar; b.x = xb_xcc_id(); b.st = st;
    if (threadIdx.x == 0) (void)xb_add(&bar[XB_XCNT(b.x)], 1u);
    return b;
}
__device__ __forceinline__ void xcd_barrier_complete(unsigned* bar, unsigned x, unsigned& nloc, unsigned& nx) {
    const unsigned G = gridDim.x * gridDim.y * gridDim.z;
    unsigned sum, cnt, mine, sp = 0u;
    for (;;) {
        sum = 0u; cnt = 0u; mine = 0u;
#pragma unroll
        for (unsigned j = 0; j < 16; ++j) { const unsigned c = xb_ld(&bar[XB_XCNT(j)]); sum += c; cnt += (c > 0u) ? 1u : 0u; mine = (j == x) ? c : mine; }
        if (sum == G) break;
        __builtin_amdgcn_s_sleep(1);
        if ((++sp & 255u) == 0u) { if (xb_ld(&bar[XB_TMO])) break; if (sp > XB_SPIN_CAP) { atomicAdd(&bar[XB_TMO], 1u); break; } }
    }
    nloc = mine > 0u ? mine : 1u; nx = cnt > 0u ? cnt : 1u;
}

__device__ __forceinline__ void xcd_barrier(const XcdBarrier& b) {
    asm volatile("s_waitcnt vmcnt(0)" ::: "memory");
    __syncthreads();
    if (threadIdx.x == 0) {
        unsigned* bar = b.bar;
        __builtin_amdgcn_s_waitcnt(0);
        unsigned nloc = b.st[0], nx = b.st[1];
        if (nloc == 0u) { xcd_barrier_complete(bar, b.x, nloc, nx); b.st[0] = nloc; b.st[1] = nx; }
        const unsigned old = xb_add(&bar[XB_XSUB(b.x)], 1u);
        const unsigned gen = old / nloc;
        if (old + 1u == (gen + 1u) * nloc) {
            __builtin_amdgcn_fence(__ATOMIC_RELEASE, "agent");
            asm volatile("s_waitcnt vmcnt(0)" ::: "memory");
            const unsigned og = xb_add(&bar[XB_TOP], 1u);
            const unsigned tg = og / nx;
            if (og + 1u == (tg + 1u) * nx) xb_add(&bar[XB_TOPGEN], 1u);
            else XB_SPIN(xb_ld(&bar[XB_TOPGEN]) == tg, bar);
            __builtin_amdgcn_fence(__ATOMIC_ACQUIRE, "agent");
            xb_add(&bar[XB_XGEN(b.x)], 1u);
            asm volatile("s_waitcnt vmcnt(0)" ::: "memory");
        } else {
            XB_SPIN(xb_ld(&bar[XB_XGEN(b.x)]) == gen, bar);
            __builtin_amdgcn_fence(__ATOMIC_ACQUIRE, "agent");
            asm volatile("s_waitcnt vmcnt(0)" ::: "memory");
        }
    }
    __syncthreads();
}

namespace fa {
typedef short bf16x8 __attribute__((ext_vector_type(8)));
typedef short s16x4 __attribute__((ext_vector_type(4)));
typedef float f32x16 __attribute__((ext_vector_type(16)));
typedef unsigned u32x4 __attribute__((ext_vector_type(4)));
typedef short v4i16_t __attribute__((ext_vector_type(4)));
typedef __attribute__((address_space(3))) const char* lds_cptr;
typedef __attribute__((address_space(3))) char* lds_ptr;

constexpr int NSLOT = 3, SLOTB = 8192;
constexpr int LDS_K = 0, LDS_V = NSLOT * SLOTB;
constexpr int LDS_IMP = 2 * NSLOT * SLOTB;
constexpr int LDS_IMPT = LDS_IMP + 4 * 64 * 33 * 4;
constexpr int LDS_SEL = 131072 - 256;
constexpr int LDS_OT = LDS_IMP;
static_assert(LDS_OT + 65536 <= LDS_SEL && LDS_IMPT + 64 * 33 * 4 <= LDS_SEL, "attention LDS map");

#define FA_NEG (-__builtin_inff())
__device__ __forceinline__ void glds16(const void* gsrc, unsigned lds_dst) { unsigned keep;
    asm volatile("s_mov_b32 %0, m0\n\ts_mov_b32 m0, %2\n\ts_nop 0\n\tglobal_load_lds_dwordx4 %1, off\n\ts_mov_b32 m0, %0" : "=&s"(keep) : "v"(gsrc), "s"(lds_dst) : "memory"); }
#define FA_WAIT_BAR(N) asm volatile("s_waitcnt vmcnt(" #N ") lgkmcnt(0)\n\ts_barrier" ::: "memory")
__device__ __forceinline__ s16x4 vtr(lds_cptr p) { return __builtin_bit_cast(s16x4, __builtin_amdgcn_ds_read_tr16_b64_v4i16((__attribute__((address_space(3))) v4i16_t*)p)); }
typedef float f32x2_t __attribute__((ext_vector_type(2))); typedef __bf16 bf16x2_t __attribute__((ext_vector_type(2)));
__device__ __forceinline__ unsigned cvtpk(float lo, float hi) { f32x2_t v = {lo, hi}; bf16x2_t b = __builtin_convertvector(v, bf16x2_t); return __builtin_bit_cast(unsigned, b); }

__device__ __forceinline__ unsigned char* launder(unsigned char* p) { asm volatile("" : "+s"(p)); return p; }
struct RowCtx {
    int hiAbs, loAbs;
    unsigned selmask; int selshift;
    float sk, lb;
};

__device__ __forceinline__ void qk_scores(lds_cptr kslot, int j, const bf16x8 (&qr)[4], const RowCtx& rc, int r32, int hi, int hk, int lk, bool rowok, f32x16& p0, f32x16& p1) {
    const float lbj = rc.sk * (float)(64 * j + 4 * hi) + rc.lb;
#pragma unroll
    for (int r = 0; r < 16; ++r) { const float c = (float)((r & 3) + 8 * (r >> 2)); p0[r] = __builtin_fmaf(rc.sk, c, lbj); p1[r] = __builtin_fmaf(rc.sk, c + 32.f, lbj); }
    const lds_cptr kp = kslot + hi * 1024 + r32 * 16;
#pragma unroll
    for (int d0 = 0; d0 < 4; ++d0) {
        const bf16x8 b0 = *(const __attribute__((address_space(3))) bf16x8*)(kp + d0 * 2048);
        const bf16x8 b1 = *(const __attribute__((address_space(3))) bf16x8*)(kp + d0 * 2048 + 512);
        p0 = __builtin_amdgcn_mfma_f32_32x32x16_bf16(b0, qr[d0], p0, 0, 0, 0);
        p1 = __builtin_amdgcn_mfma_f32_32x32x16_bf16(b1, qr[d0], p1, 0, 0, 0);
    }
    const bool full = (lk <= 0) && (hk >= 63);
    if (!__all(full)) {
        const int a = lk - 4 * hi, b = hk - 4 * hi;
#pragma unroll
        for (int r = 0; r < 16; ++r) { const int c = (r & 3) + 8 * (r >> 2);
            p0[r] = (c >= a && c <= b) ? p0[r] : FA_NEG; p1[r] = (c + 32 >= a && c + 32 <= b) ? p1[r] : FA_NEG; }
    }
    if (!__all(rowok)) {
#pragma unroll
        for (int r = 0; r < 16; ++r) { p0[r] = rowok ? p0[r] : FA_NEG; p1[r] = rowok ? p1[r] : FA_NEG; }
    }
}
__device__ __forceinline__ void pv_accum(lds_cptr vslot, const f32x16& p0, const f32x16& p1, int lane, int hi, f32x16 (&o)[2]) {
    u32x4 pw[4];
    pw[0] = (u32x4){cvtpk(p0[0], p0[1]), cvtpk(p0[2], p0[3]), cvtpk(p0[4], p0[5]), cvtpk(p0[6], p0[7])};
    pw[1] = (u32x4){cvtpk(p0[8], p0[9]), cvtpk(p0[10], p0[11]), cvtpk(p0[12], p0[13]), cvtpk(p0[14], p0[15])};
    pw[2] = (u32x4){cvtpk(p1[0], p1[1]), cvtpk(p1[2], p1[3]), cvtpk(p1[4], p1[5]), cvtpk(p1[6], p1[7])};
    pw[3] = (u32x4){cvtpk(p1[8], p1[9]), cvtpk(p1[10], p1[11]), cvtpk(p1[12], p1[13]), cvtpk(p1[14], p1[15])};
    const lds_cptr vp = vslot + ((lane >> 4) & 1) * 32 + (lane & 3) * 8 + (4 * hi + ((lane & 15) >> 2)) * 64;
#pragma unroll
    for (int d0 = 0; d0 < 2; ++d0)
#pragma unroll
        for (int ks = 0; ks < 4; ++ks) {
            const s16x4 lo = vtr(vp + d0 * 4096 + ks * 1024), hh = vtr(vp + d0 * 4096 + ks * 1024 + 512);
            const bf16x8 vf = (bf16x8){lo[0], lo[1], lo[2], lo[3], hh[0], hh[1], hh[2], hh[3]};
            o[d0] = __builtin_amdgcn_mfma_f32_32x32x16_bf16(vf, __builtin_bit_cast(bf16x8, pw[ks]), o[d0], 0, 0, 0);
        }
}
__device__ __forceinline__ float rowmax32(const f32x16& p0, const f32x16& p1) {
    float a = __builtin_fmaxf(p0[0], p1[0]);
#pragma unroll
    for (int r = 1; r < 16; ++r) a = __builtin_fmaxf(a, __builtin_fmaxf(p0[r], p1[r]));
    return __builtin_fmaxf(a, __shfl_xor(a, 32));
}


struct RowCtx2 { int hiAbs, loAbs; unsigned selmask; int selshift; float slope2; int kp_mul, kp_off; };
#define FA_THR 16.0f
__device__ __forceinline__ void attn_prefetch(lds_ptr ring, const bf16_t* Kb, const bf16_t* Vb, int jlo, int nt, int wid, int lane, bool withV) {
    if (nt <= 0) return;
    const unsigned lds0 = (unsigned)(uintptr_t)ring;
    const bf16_t* ksrc = Kb + wid * 512 + lane * 8 + (size_t)jlo * 4096;
    glds16(ksrc, (unsigned)__builtin_amdgcn_readfirstlane(lds0 + LDS_K + wid * 1024));
    if (nt > 1) glds16(ksrc + 4096, (unsigned)__builtin_amdgcn_readfirstlane(lds0 + LDS_K + SLOTB + wid * 1024));
    if (withV) { const bf16_t* vsrc = Vb + wid * 512 + lane * 8 + (size_t)jlo * 4096;
        glds16(vsrc, (unsigned)__builtin_amdgcn_readfirstlane(lds0 + LDS_V + wid * 1024)); }
}
#define FA_SBAR() __builtin_amdgcn_sched_barrier(0)
__device__ __forceinline__ void attn_stream2(lds_ptr ring, const bf16_t* Kb, const bf16_t* Vb, int jlo, int jhi, const bf16x8 (&qr)[4], const RowCtx2& rc, int wid, int lane,
                                             float& m, float& l, f32x16 (&o)[2], bool chk, int pre = 0, const bf16_t* Knext = nullptr, int jlo_next = 0, int nt_next = 0, const bf16_t* zrow = nullptr, uint2* zreg = nullptr) {
    const int nt = jhi - jlo;
    if (nt <= 0) { if (Knext) attn_prefetch(ring, Knext, nullptr, jlo_next, nt_next, wid, lane, false); return; }
    const int r32 = lane & 31, hi = lane >> 5;
    const unsigned lds0 = (unsigned)(uintptr_t)ring;
    const bf16_t* ksrc = Kb + wid * 512 + lane * 8;
    const bf16_t* vsrc = Vb + wid * 512 + lane * 8;
    const unsigned kdst = lds0 + LDS_K + wid * 1024, vdst = lds0 + LDS_V + wid * 1024;
#define FA_DMAK(j_, so_) glds16(ksrc + (size_t)(j_) * 4096, (unsigned)__builtin_amdgcn_readfirstlane(kdst + (so_)))
#define FA_DMAV(j_, so_) glds16(vsrc + (size_t)(j_) * 4096, (unsigned)__builtin_amdgcn_readfirstlane(vdst + (so_)))
    if (pre == 0) { FA_DMAK(jlo, 0); if (nt > 1) FA_DMAK(jlo + 1, SLOTB); }
    if (pre < 2) FA_DMAV(jlo, 0);
    const lds_cptr kbase = (lds_cptr)ring + LDS_K + hi * 1024 + r32 * 16;
    const lds_cptr vbase = (lds_cptr)ring + LDS_V + ((lane >> 4) & 1) * 32 + (lane & 3) * 8 + (4 * hi + ((lane & 15) >> 2)) * 64;
    const float skm = rc.slope2 * (float)rc.kp_mul;
    u32x4 pw[4];
    bool prev = false;
    int s_k = 0, s_vprev = 2 * SLOTB, s_knn = 2 * SLOTB, s_vn = SLOTB;
#define FA_NEXT(x) ((x) == (NSLOT - 1) * SLOTB ? 0 : (x) + SLOTB)
#define FA_VREADS(vf, so_) do { _Pragma("unroll") for (int d0_ = 0; d0_ < 2; ++d0_) _Pragma("unroll") for (int ks_ = 0; ks_ < 4; ++ks_) { \
        const s16x4 lo_ = vtr(vbase + (so_) + d0_ * 4096 + ks_ * 1024), hh_ = vtr(vbase + (so_) + d0_ * 4096 + ks_ * 1024 + 512); \
        vf[d0_ * 4 + ks_] = (bf16x8){lo_[0], lo_[1], lo_[2], lo_[3], hh_[0], hh_[1], hh_[2], hh_[3]}; } } while (0)
#define FA_PV(vf, pw) do { _Pragma("unroll") for (int d0_ = 0; d0_ < 2; ++d0_) _Pragma("unroll") for (int ks_ = 0; ks_ < 4; ++ks_) \
        o[d0_] = __builtin_amdgcn_mfma_f32_32x32x16_bf16(vf[d0_ * 4 + ks_], __builtin_bit_cast(bf16x8, pw[ks_]), o[d0_], 0, 0, 0); } while (0)
    for (int i = 0; i < nt; ++i) {
        if (i + 1 < nt) FA_WAIT_BAR(2); else FA_WAIT_BAR(1);
        if (i + 2 < nt) FA_DMAK(jlo + i + 2, s_knn);
        if (i + 1 < nt) FA_DMAV(jlo + i + 1, s_vn);
        const int j = jlo + i;
        int hk = rc.hiAbs - 64 * j; hk = hk > 63 ? 63 : hk;
        int lk = rc.loAbs - 64 * j; lk = lk < 0 ? 0 : lk;
        const bool rowok = ((rc.selmask >> (j >> rc.selshift)) & 1u) != 0u;
        const bool cur = __any(rowok && lk <= hk) != 0;
        bf16x8 kf[8], vf[8];
        if (cur) {
#pragma unroll
            for (int d0 = 0; d0 < 4; ++d0) { kf[2 * d0] = *(const __attribute__((address_space(3))) bf16x8*)(kbase + s_k + d0 * 2048); kf[2 * d0 + 1] = *(const __attribute__((address_space(3))) bf16x8*)(kbase + s_k + d0 * 2048 + 512); }
        }
        if (prev) FA_VREADS(vf, s_vprev);
        f32x16 s0, s1;
        if (cur) {
            const float lbj = rowok ? rc.slope2 * (float)(rc.kp_mul * (64 * j + 4 * hi) + rc.kp_off) - m : FA_NEG;
#pragma unroll
            for (int r = 0; r < 16; ++r) { const float c = (float)((r & 3) + 8 * (r >> 2)); s0[r] = __builtin_fmaf(skm, c, lbj); s1[r] = __builtin_fmaf(skm, c + 32.f, lbj); }
        }
        FA_SBAR();
        __builtin_amdgcn_s_setprio(1);
        if (cur) {
#pragma unroll
            for (int d0 = 0; d0 < 4; ++d0) { s0 = __builtin_amdgcn_mfma_f32_32x32x16_bf16(kf[2 * d0], qr[d0], s0, 0, 0, 0); s1 = __builtin_amdgcn_mfma_f32_32x32x16_bf16(kf[2 * d0 + 1], qr[d0], s1, 0, 0, 0); }
        }
        if (prev) FA_PV(vf, pw);
        __builtin_amdgcn_s_setprio(0);
        FA_SBAR();
        if (cur) {
            const bool full = (lk <= 0) && (hk >= 63);
            if (!__all(full)) {
                const int a = lk - 4 * hi, b = hk - 4 * hi;
#pragma unroll
                for (int r = 0; r < 16; ++r) { const int c = (r & 3) + 8 * (r >> 2);
                    s0[r] = (c >= a && c <= b) ? s0[r] : FA_NEG; s1[r] = (c + 32 >= a && c + 32 <= b) ? s1[r] : FA_NEG; }
            }
            if (chk) {
            float mx = __builtin_fmaxf(s0[0], s1[0]);
#pragma unroll
            for (int r = 1; r < 16; ++r) mx = __builtin_fmaxf(mx, __builtin_fmaxf(s0[r], s1[r]));
            if (__any(mx > FA_THR)) {
                mx = __builtin_fmaxf(mx, __shfl_xor(mx, 32));
                const float dl = __builtin_fmaxf(mx, 0.f), f = __builtin_amdgcn_exp2f(-dl);
                m += dl; l *= f;
#pragma unroll
                for (int r = 0; r < 16; ++r) { s0[r] -= dl; s1[r] -= dl; o[0][r] *= f; o[1][r] *= f; }
            }
            }
            float sum_ = 0.f;
#pragma unroll
            for (int r = 0; r < 16; ++r) { s0[r] = __builtin_amdgcn_exp2f(s0[r]); s1[r] = __builtin_amdgcn_exp2f(s1[r]); sum_ += s0[r] + s1[r]; }
            l += sum_;
            pw[0] = (u32x4){cvtpk(s0[0], s0[1]), cvtpk(s0[2], s0[3]), cvtpk(s0[4], s0[5]), cvtpk(s0[6], s0[7])}; pw[1] = (u32x4){cvtpk(s0[8], s0[9]), cvtpk(s0[10], s0[11]), cvtpk(s0[12], s0[13]), cvtpk(s0[14], s0[15])};
            pw[2] = (u32x4){cvtpk(s1[0], s1[1]), cvtpk(s1[2], s1[3]), cvtpk(s1[4], s1[5]), cvtpk(s1[6], s1[7])}; pw[3] = (u32x4){cvtpk(s1[8], s1[9]), cvtpk(s1[10], s1[11]), cvtpk(s1[12], s1[13]), cvtpk(s1[14], s1[15])};
        }
        prev = cur;
        s_vprev = s_k; s_k = FA_NEXT(s_k); s_knn = FA_NEXT(s_knn); s_vn = FA_NEXT(s_vn);
    }
    FA_WAIT_BAR(0);
    if (Knext) attn_prefetch(ring, Knext, nullptr, jlo_next, nt_next, wid, lane, false);
    if (zrow) {
#pragma unroll
        for (int d0 = 0; d0 < 2; ++d0)
#pragma unroll
            for (int g4 = 0; g4 < 4; ++g4) zreg[d0 * 4 + g4] = *(const uint2*)(zrow + 32 * d0 + 8 * g4 + 4 * hi);
    }
    if (prev) {
        bf16x8 vf[8];
        FA_VREADS(vf, s_vprev);
        FA_PV(vf, pw);
    }
    asm volatile("s_waitcnt lgkmcnt(0)\n\ts_barrier" ::: "memory");
#undef FA_DMAK
#undef FA_DMAV
#undef FA_NEXT
#undef FA_VREADS
#undef FA_PV
}

__device__ __forceinline__ bool need_maxcheck(const bf16x8 (&qr)[4], const float* gk, int lane, float refslack) {
    float qn = 0.f;
#pragma unroll
    for (int d0 = 0; d0 < 4; ++d0)
#pragma unroll
        for (int i = 0; i < 8; ++i) { const float v = bf2f((unsigned short)qr[d0][i]); qn += v * v; }
    qn += __shfl_xor(qn, 32);
    float gm = __builtin_fabsf(gk[lane]);
#pragma unroll
    for (int o = 1; o < 64; o <<= 1) gm = __builtin_fmaxf(gm, __shfl_xor(gm, o));
    const float bound = sqrtf(qn) * gm * 8.04f + refslack;
    return __any(!(bound <= FA_THR)) != 0;
}
__device__ __forceinline__ void store_oz(const f32x16 (&o)[2], float w, const uint2* zreg, bf16_t* Y, int t, int ycol, int hi) {
#pragma unroll
    for (int d0 = 0; d0 < 2; ++d0)
#pragma unroll
        for (int g4 = 0; g4 < 4; ++g4) {
            const int d = 32 * d0 + 8 * g4 + 4 * hi;
            const uint2 z = zreg[d0 * 4 + g4];
            const float v0 = o[d0][4 * g4 + 0] * w * bf2f(z.x & 0xffff), v1 = o[d0][4 * g4 + 1] * w * bf2f(z.x >> 16);
            const float v2 = o[d0][4 * g4 + 2] * w * bf2f(z.y & 0xffff), v3 = o[d0][4 * g4 + 3] * w * bf2f(z.y >> 16);
            uint2 y; y.x = cvtpk(v0, v1); y.y = cvtpk(v2, v3);
            *(uint2*)(Y + (size_t)t * 1024 + ycol + d) = y;
        }
}
__device__ __forceinline__ void load_q(bf16x8 (&qr)[4], const bf16_t* Qrow, int hi) {
#pragma unroll
    for (int d0 = 0; d0 < 4; ++d0) qr[d0] = *(const bf16x8*)(Qrow + d0 * 16 + hi * 8);
}

#ifdef PROBE_A
#define FA_STAMP(n) do { if (blockIdx.x == 0 && threadIdx.x == 0) ((volatile __attribute__((address_space(3))) unsigned*)(ring + 131072 + 320))[40 + (n)] = (unsigned)__builtin_amdgcn_s_memrealtime(); } while (0)
#else
#define FA_STAMP(n) do {} while (0)
#endif
__device__ __forceinline__ void moba_unit(const KArgs& P, lds_ptr ring, int b, int h, int own, int wid, int lane) {
    unsigned char* ws = launder(P.ws); asm volatile("" : "+v"(lane));
    const bf16_t* QB = (const bf16_t*)(ws + WS_QB); const bf16_t* KB = (const bf16_t*)(ws + WS_KB); const bf16_t* VB = (const bf16_t*)(ws + WS_VB);
    const float* KMP = (const float*)(ws + WS_KMP); const bf16_t* ZB = (const bf16_t*)(ws + WS_ZB); bf16_t* Y = (bf16_t*)(ws + WS_Y);
    const int r32 = lane & 31, hi = lane >> 5;
    const int sq = own * 256 + 32 * wid + r32, t = b * SEQ + sq;
    const size_t hb = (size_t)(b * 8 + h) * SEQ;
    FA_STAMP(own == 7 ? 24 : 28);
    attn_prefetch(ring, KB + hb * 64, VB + hb * 64, 0, 4 * own + 4, wid, lane, true);
    bf16x8 qr[4]; load_q(qr, QB + (hb + sq) * 64, hi);
    __attribute__((address_space(3))) float* kmS = (__attribute__((address_space(3))) float*)(ring + LDS_IMP);
    { const int tid = wid * 64 + lane, n = tid >> 6, d = tid & 63;
      const float* k0 = KMP + (size_t)(b * 8 + n) * 512 + h * 64 + d;
      kmS[tid] = k0[0] + k0[64 * 512]; }
    asm volatile("s_waitcnt vmcnt(0) lgkmcnt(0)\n\ts_barrier" ::: "memory");
    float gate[8];
#pragma unroll
    for (int n = 0; n < 8; ++n) gate[n] = -1e30f;
    if (own > 0) {
        float qf[32];
#pragma unroll
        for (int d0 = 0; d0 < 4; ++d0)
#pragma unroll
            for (int i = 0; i < 8; ++i) qf[8 * d0 + i] = bf2f((unsigned short)qr[d0][i]);
#pragma unroll
        for (int n = 0; n < 7; ++n) {
            float part = 0.f;
#pragma unroll
            for (int d0 = 0; d0 < 4; ++d0)
#pragma unroll
                for (int i = 0; i < 8; ++i) part += qf[8 * d0 + i] * kmS[n * 64 + d0 * 16 + hi * 8 + i];
            const float g = part + __shfl_xor(part, 32);
            gate[n] = n < own ? g : -1e30f;
        }
    }
    FA_STAMP(own == 7 ? 32 : 36);
    unsigned sel = 0;
#pragma unroll
    for (int it = 0; it < 3; ++it) {
        float best = -3e38f; int bi = 0;
#pragma unroll
        for (int n = 0; n < 8; ++n) { const bool ok = !((sel >> n) & 1u) && gate[n] > best; best = ok ? gate[n] : best; bi = ok ? n : bi; }
        sel |= 1u << bi;
    }
    FA_STAMP(own == 7 ? 33 : 37);
    sel &= (1u << own) - 1u;
    sel |= 1u << own;
    const float slope2 = exp2f(-(float)(h + 1)) * LOG2E;
    RowCtx2 rc; rc.hiAbs = sq; rc.loAbs = -(1 << 30); rc.selmask = sel; rc.selshift = 2; rc.slope2 = slope2; rc.kp_mul = 1; rc.kp_off = -sq;
    float m = 0.f, l = 0.f; f32x16 o[2]; uint2 zreg[8];
#pragma unroll
    for (int r = 0; r < 16; ++r) { o[0][r] = 0.f; o[1][r] = 0.f; }
    FA_STAMP(own == 7 ? 25 : 29);
    attn_stream2(ring, KB + hb * 64, VB + hb * 64, 0, 4 * own + 4, qr, rc, wid, lane, m, l, o, need_maxcheck(qr, P.b_knorm_g, lane, 0.f), 2, nullptr, 0, 0, ZB + (size_t)t * 512 + h * 64, zreg);
    FA_STAMP(own == 7 ? 26 : 30);
    l += __shfl_xor(l, 32);
    const float inv = l > 0.f ? 1.0f / l : 0.f;
    store_oz(o, inv, zreg, Y, t, 512 + h * 64, hi);
    FA_STAMP(own == 7 ? 27 : 31);
}

__device__ __forceinline__ void swa_unit(const KArgs& P, lds_ptr ring, int b, int g, int c, int wid, int lane) {
    unsigned char* ws = launder(P.ws); asm volatile("" : "+v"(lane));
    const bf16_t* QD = (const bf16_t*)(ws + WS_QD); const bf16_t* KD = (const bf16_t*)(ws + WS_KD); const bf16_t* VD = (const bf16_t*)(ws + WS_VD);
    const bf16_t* ZD = (const bf16_t*)(ws + WS_ZD); bf16_t* Y = (bf16_t*)(ws + WS_Y);
    const int r32 = lane & 31, hi = lane >> 5, h = 4 * g + (wid >> 1);
    const int sq = 64 * c + 32 * (wid & 1) + r32, t = b * SEQ + sq;
    const size_t gb = (size_t)(b * 2 + g) * SEQ * 64;
    attn_prefetch(ring, KD + gb, VD + gb, c >= 2 ? c - 2 : 0, c >= 2 ? 3 : c + 1, wid, lane, true);
    bf16x8 qr[4]; load_q(qr, QD + ((size_t)(b * 8 + h) * SEQ + sq) * 64, hi);
    const float slope2 = exp2f(-(float)(h + 1)) * LOG2E;
    RowCtx2 rc; rc.hiAbs = sq; rc.loAbs = sq - 127; rc.selmask = 0xffffffffu; rc.selshift = 0; rc.slope2 = slope2; rc.kp_mul = 1; rc.kp_off = -sq;
    float m = P.d_sinks[h] * LOG2E, l = hi == 0 ? 1.f : 0.f; f32x16 o[2]; uint2 zreg[8];
#pragma unroll
    for (int r = 0; r < 16; ++r) { o[0][r] = 0.f; o[1][r] = 0.f; }
    attn_stream2(ring, KD + gb, VD + gb, c >= 2 ? c - 2 : 0, c + 1, qr, rc, wid, lane, m, l, o, need_maxcheck(qr, P.d_knorm_g, lane, __builtin_fabsf(m)), 2, nullptr, 0, 0, ZD + (size_t)t * 512 + h * 64, zreg);
    l += __shfl_xor(l, 32);
    store_oz(o, 1.0f / l, zreg, Y, t, 512 + h * 64, hi);
}

__device__ __forceinline__ void nsa_unit(const KArgs& P, lds_ptr ring, int b, int g, int c, int wid, int lane, int tid) {
    unsigned char* ws = launder(P.ws); asm volatile("" : "+v"(lane));
    const bf16_t* QC = (const bf16_t*)(ws + WS_QC); const bf16_t* KC = (const bf16_t*)(ws + WS_KC); const bf16_t* VC = (const bf16_t*)(ws + WS_VC);
    const bf16_t* KS = (const bf16_t*)(ws + WS_KS); const bf16_t* VS = (const bf16_t*)(ws + WS_VS);
    const bf16_t* KW = (const bf16_t*)(ws + WS_KW); const bf16_t* VW = (const bf16_t*)(ws + WS_VW);
    const float* GT = (const float*)(ws + WS_GT); const bf16_t* ZC = (const bf16_t*)(ws + WS_ZC); bf16_t* Y = (bf16_t*)(ws + WS_Y);
    const int r32 = lane & 31, hi = lane >> 5, hh = wid >> 1, h = 4 * g + hh;
    const int tok = 32 * (wid & 1) + r32, sq = 64 * c + tok, t = b * SEQ + sq;
    if (c == 31) FA_STAMP(44);
    bf16x8 qr[4]; load_q(qr, QC + ((size_t)(b * 8 + h) * SEQ + sq) * 64, hi);
    const float slope2 = exp2f(-(float)(h + 1)) * LOG2E;
    const size_t gbe = (size_t)(b * 2 + g) * SEQ * 64;
    const float g0 = GT[(size_t)t * 32 + h], g1 = GT[(size_t)t * 32 + 8 + h], g2 = GT[(size_t)t * 32 + 16 + h];
    f32x16 o[2];
#pragma unroll
    for (int r = 0; r < 16; ++r) { o[0][r] = 0.f; o[1][r] = 0.f; }
    __attribute__((address_space(3))) float* otS = (__attribute__((address_space(3))) float*)(ring + LDS_OT) + wid * 2048 + lane;
    __attribute__((address_space(3))) float* impH = (__attribute__((address_space(3))) float*)(ring + LDS_IMP);
    __attribute__((address_space(3))) float* impT = (__attribute__((address_space(3))) float*)(ring + LDS_IMPT);
    __attribute__((address_space(3))) unsigned* selS = (__attribute__((address_space(3))) unsigned*)(ring + LDS_SEL);
    {
        const bf16_t* kc = KC + (size_t)(b * 2 + g) * 128 * 64; const bf16_t* vc = VC + (size_t)(b * 2 + g) * 128 * 64;
        const unsigned lds0 = (unsigned)(uintptr_t)ring;
        const bf16_t* ksrc = kc + wid * 512 + lane * 8;
        const bf16_t* vsrc = vc + wid * 512 + lane * 8;
        glds16(ksrc, (unsigned)__builtin_amdgcn_readfirstlane(lds0 + LDS_K + wid * 1024)); glds16(vsrc, (unsigned)__builtin_amdgcn_readfirstlane(lds0 + LDS_V + wid * 1024));
        glds16(ksrc + 4096, (unsigned)__builtin_amdgcn_readfirstlane(lds0 + LDS_K + SLOTB + wid * 1024)); glds16(vsrc + 4096, (unsigned)__builtin_amdgcn_readfirstlane(lds0 + LDS_V + SLOTB + wid * 1024));
        FA_WAIT_BAR(0);
        RowCtx rc; int hc = (sq - 31) >> 4; rc.hiAbs = hc > 126 ? 126 : hc; rc.loAbs = -(1 << 30); rc.selmask = 0xffffffffu; rc.selshift = 0; rc.sk = 16.f * slope2; rc.lb = slope2 * (float)(31 - 64 * c);
        f32x16 a0, a1, b0, b1;
        { int hk = rc.hiAbs; hk = hk > 63 ? 63 : hk; qk_scores((lds_cptr)ring + LDS_K, 0, qr, rc, r32, hi, hk, 0, true, a0, a1); }
        { int hk = rc.hiAbs - 64; hk = hk > 63 ? 63 : hk; qk_scores((lds_cptr)ring + LDS_K + SLOTB, 1, qr, rc, r32, hi, hk, 0, true, b0, b1); }
        float mx = __builtin_fmaxf(rowmax32(a0, a1), rowmax32(b0, b1));
        mx = mx > -1e37f ? mx : 0.f;
        float sum = 0.f;
#pragma unroll
        for (int r = 0; r < 16; ++r) { a0[r] = __builtin_amdgcn_exp2f(a0[r] - mx); a1[r] = __builtin_amdgcn_exp2f(a1[r] - mx); b0[r] = __builtin_amdgcn_exp2f(b0[r] - mx); b1[r] = __builtin_amdgcn_exp2f(b1[r] - mx);
            sum += (a0[r] + a1[r]) + (b0[r] + b1[r]); }
        sum += __shfl_xor(sum, 32);
        const float inv = sum > 0.f ? 1.0f / sum : 0.f;
#pragma unroll
        for (int r = 0; r < 16; ++r) { a0[r] *= inv; a1[r] *= inv; b0[r] *= inv; b1[r] *= inv; }
        float ss[16], ee[16];
#pragma unroll
        for (int i = 0; i < 4; ++i) {
            ss[i] = (a0[4 * i] + a0[4 * i + 1]) + (a0[4 * i + 2] + a0[4 * i + 3]); ee[i] = a0[4 * i + 3];
            ss[4 + i] = (a1[4 * i] + a1[4 * i + 1]) + (a1[4 * i + 2] + a1[4 * i + 3]); ee[4 + i] = a1[4 * i + 3];
            ss[8 + i] = (b0[4 * i] + b0[4 * i + 1]) + (b0[4 * i + 2] + b0[4 * i + 3]); ee[8 + i] = b0[4 * i + 3];
            ss[12 + i] = (b1[4 * i] + b1[4 * i + 1]) + (b1[4 * i + 2] + b1[4 * i + 3]); ee[12 + i] = b1[4 * i + 3];
        }
        float ep[16];
#pragma unroll
        for (int k = 0; k < 16; ++k) ep[k] = __shfl_xor(ee[k], 32);
#pragma unroll
        for (int k = 0; k < 16; ++k) {
            const float prev = k > 0 ? ep[k > 0 ? k - 1 : 0] : 0.f;
            const float v = ss[k] + (hi ? ep[k] : prev);
            impH[(hh * 64 + tok) * 33 + 2 * k + hi] = v;
        }
        pv_accum((lds_cptr)ring + LDS_V, a0, a1, lane, hi, o);
        pv_accum((lds_cptr)ring + LDS_V + SLOTB, b0, b1, lane, hi, o);
        asm volatile("s_waitcnt lgkmcnt(0)\n\ts_barrier" ::: "memory");
        attn_prefetch(ring, KS + gbe, VS + gbe, 0, c + 1, wid, lane, true);
        {
            const int tk = tid >> 3, part = tid & 7;
#pragma unroll
            for (int i = 0; i < 4; ++i) { const int n = 4 * part + i;
                float v = (impH[(0 * 64 + tk) * 33 + n] + impH[(1 * 64 + tk) * 33 + n]) + (impH[(2 * 64 + tk) * 33 + n] + impH[(3 * 64 + tk) * 33 + n]);
                if (n == 0 || n == c || n == c - 1) v = 1e4f;
                if (n > c) v = -1e30f;
                impT[tk * 33 + n] = v; }
            asm volatile("s_waitcnt lgkmcnt(0)\n\ts_barrier" ::: "memory");
            float mine[4]; int rank[4];
#pragma unroll
            for (int i = 0; i < 4; ++i) { mine[i] = impT[tk * 33 + 4 * part + i]; rank[i] = 0; }
#pragma unroll 1
            for (int mI = 0; mI < 32; ++mI) { const float v = impT[tk * 33 + mI];
#pragma unroll
                for (int i = 0; i < 4; ++i) rank[i] += (v > mine[i] || (v == mine[i] && mI < 4 * part + i)) ? 1 : 0; }
            unsigned bits = 0;
#pragma unroll
            for (int i = 0; i < 4; ++i) if (rank[i] < 16) bits |= 1u << (4 * part + i);
            bits |= __shfl_xor(bits, 1); bits |= __shfl_xor(bits, 2); bits |= __shfl_xor(bits, 4);
            if (part == 0) selS[tk] = bits;
            asm volatile("s_waitcnt lgkmcnt(0)\n\ts_barrier" ::: "memory");
        }
    }
    const unsigned sel = selS[tok];
    if (c == 31) FA_STAMP(45);
    const size_t gb = (size_t)(b * 2 + g) * SEQ * 64;
#pragma unroll
    for (int r = 0; r < 16; ++r) { otS[r * 64] = o[0][r] * g0; otS[(16 + r) * 64] = o[1][r] * g0; }
    {
        RowCtx2 rc; rc.hiAbs = sq; rc.loAbs = -(1 << 30); rc.selmask = sel; rc.selshift = 0; rc.slope2 = slope2; rc.kp_mul = 1; rc.kp_off = -sq;
        float m = 0.f, l = 0.f;
#pragma unroll
        for (int r = 0; r < 16; ++r) { o[0][r] = 0.f; o[1][r] = 0.f; }
        attn_stream2(ring, KS + gb, VS + gb, 0, c + 1, qr, rc, wid, lane, m, l, o, need_maxcheck(qr, P.c_knorm_slc_g, lane, 0.f), 2, KW + gb, c >= 8 ? c - 8 : 0, c >= 8 ? 9 : c + 1);
        l += __shfl_xor(l, 32);
        if (c == 31) FA_STAMP(46);
        const float w1 = l > 0.f ? g1 / l : 0.f;
#pragma unroll
        for (int r = 0; r < 16; ++r) { otS[r * 64] += o[0][r] * w1; otS[(16 + r) * 64] += o[1][r] * w1; }
    }
    uint2 zreg[8];
    {
        RowCtx2 rc; rc.hiAbs = sq; rc.loAbs = sq - 511; rc.selmask = 0xffffffffu; rc.selshift = 0; rc.slope2 = slope2; rc.kp_mul = 1; rc.kp_off = -sq;
        float m = 0.f, l = 0.f;
#pragma unroll
        for (int r = 0; r < 16; ++r) { o[0][r] = 0.f; o[1][r] = 0.f; }
        attn_stream2(ring, KW + gb, VW + gb, c >= 8 ? c - 8 : 0, c + 1, qr, rc, wid, lane, m, l, o, need_maxcheck(qr, P.c_knorm_win_g, lane, 0.f), 1, nullptr, 0, 0, ZC + (size_t)t * 512 + h * 64, zreg);
        l += __shfl_xor(l, 32);
        if (c == 31) FA_STAMP(47);
        const float w2 = l > 0.f ? g2 / l : 0.f;
#pragma unroll
        for (int r = 0; r < 16; ++r) { o[0][r] = o[0][r] * w2 + otS[r * 64]; o[1][r] = o[1][r] * w2 + otS[(16 + r) * 64]; }
    }
    store_oz(o, 1.f, zreg, Y, t, h * 64, hi);
    if (c == 31) FA_STAMP(48);
}
}
namespace fm {
typedef short bf16x8 __attribute__((ext_vector_type(8)));
typedef float f32x4 __attribute__((ext_vector_type(4)));
typedef float f32x2 __attribute__((ext_vector_type(2)));
__device__ __forceinline__ float wave_sum(float v) {
#pragma unroll
    for (int o = 1; o < 64; o <<= 1) v += __shfl_xor(v, o);
    return v;
}
struct ConvW { float w0[31], w1[31]; float2 bias; float4 ga, gb, ba, bb2; };
__device__ __forceinline__ void conv_load_w(const KArgs& P, ConvW& W, int tid, int lane) {
    const int cp = tid & 255;
#pragma unroll
    for (int j = 0; j < 31; ++j) { const float2 w = *(const float2*)(P.a_conv_w + j * 512 + 2 * cp); W.w0[j] = w.x; W.w1[j] = w.y; }
    W.bias = *(const float2*)(P.a_conv_b + 2 * cp);
    W.ga = *(const float4*)(P.a_ln_g + 4 * lane); W.gb = *(const float4*)(P.a_ln_g + 256 + 4 * lane);
    W.ba = *(const float4*)(P.a_ln_b + 4 * lane); W.bb2 = *(const float4*)(P.a_ln_b + 256 + 4 * lane);
}
__device__ __forceinline__ void conv_unit(const KArgs& P, LAS unsigned char* lds, int u, const ConvW& W, int tid, int wave, int lane) {
    const bf16_t* G0 = (const bf16_t*)(P.ws + WS_G0); const bf16_t* ZA = (const bf16_t*)(P.ws + WS_ZA); bf16_t* Y = (bf16_t*)(P.ws + WS_Y);
    LAS float* cy = (LAS float*)lds;
    const int cp = tid & 255, sb = tid >> 8;
    {
        const int t0 = u * 32, s0 = t0 & (SEQ - 1);
        float acc0[16], acc1[16];
#pragma unroll
        for (int o = 0; o < 16; ++o) { acc0[o] = W.bias.x; acc1[o] = W.bias.y; }
        const int sbase = s0 + 16 * sb - 30, tmin = t0 - s0, tb = t0 + 16 * sb - 30;
        unsigned xv[46];
#pragma unroll
        for (int i = 0; i < 46; ++i) { int row = tb + i; row = row < tmin ? tmin : row; xv[i] = *(const unsigned*)(G0 + (size_t)row * 512 + 2 * cp); }
#pragma unroll
        for (int i = 0; i < 46; ++i) {
            const bool ok = sbase + i >= 0;
            const float x0 = ok ? bf2f(xv[i] & 0xffff) : 0.f, x1 = ok ? bf2f(xv[i] >> 16) : 0.f;
#pragma unroll
            for (int o = 0; o < 16; ++o) { const int j = i - o; if (j >= 0 && j <= 30) { acc0[o] += x0 * W.w0[j]; acc1[o] += x1 * W.w1[j]; } }
        }
#pragma unroll
        for (int o = 0; o < 16; ++o) { f32x2 r; r.x = acc0[o]; r.y = acc1[o]; *(LAS f32x2*)(cy + (16 * sb + o) * 512 + 2 * cp) = r; }
        __syncthreads();
#pragma unroll
        for (int k = 0; k < 4; ++k) {
            const int tok = 4 * wave + k, t = t0 + tok;
            f32x4 a = *(const LAS f32x4*)(cy + tok * 512 + 4 * lane), b = *(const LAS f32x4*)(cy + tok * 512 + 256 + 4 * lane);
            const float mean = wave_sum((a.x + a.y) + (a.z + a.w) + (b.x + b.y) + (b.z + b.w)) * (1.0f / 512);
            a.x -= mean; a.y -= mean; a.z -= mean; a.w -= mean; b.x -= mean; b.y -= mean; b.z -= mean; b.w -= mean;
            const float var = wave_sum((a.x * a.x + a.y * a.y) + (a.z * a.z + a.w * a.w) + (b.x * b.x + b.y * b.y) + (b.z * b.z + b.w * b.w)) * (1.0f / 512);
            const float rstd = 1.0f / sqrtf(var + EPSF);
            const uint2 za = *(const uint2*)(ZA + (size_t)t * 512 + 4 * lane), zb = *(const uint2*)(ZA + (size_t)t * 512 + 256 + 4 * lane);
            float y0 = fast_silu(a.x * rstd * W.ga.x + W.ba.x) * bf2f(za.x & 0xffff), y1 = fast_silu(a.y * rstd * W.ga.y + W.ba.y) * bf2f(za.x >> 16);
            float y2 = fast_silu(a.z * rstd * W.ga.z + W.ba.z) * bf2f(za.y & 0xffff), y3 = fast_silu(a.w * rstd * W.ga.w + W.ba.w) * bf2f(za.y >> 16);
            uint2 o; o.x = pk2(y0, y1); o.y = pk2(y2, y3);
            *(uint2*)(Y + (size_t)t * 1024 + 4 * lane) = o;
            y0 = fast_silu(b.x * rstd * W.gb.x + W.bb2.x) * bf2f(zb.x & 0xffff); y1 = fast_silu(b.y * rstd * W.gb.y + W.bb2.y) * bf2f(zb.x >> 16);
            y2 = fast_silu(b.z * rstd * W.gb.z + W.bb2.z) * bf2f(zb.y & 0xffff); y3 = fast_silu(b.w * rstd * W.gb.w + W.bb2.w) * bf2f(zb.y >> 16);
            o.x = pk2(y0, y1); o.y = pk2(y2, y3);
            *(uint2*)(Y + (size_t)t * 1024 + 256 + 4 * lane) = o;
        }
        __syncthreads();
    }
}

__device__ __forceinline__ void cmp_unit(const KArgs& P, LAS unsigned char* lds, int u, int tid, int wave, int lane) {
    const int kv = u >> 7, bg = (u >> 3) & 15, rb = u & 7, fr = lane & 15, fq = lane >> 4;
    const bf16_t* X = (const bf16_t*)(P.ws + (kv == 0 ? WS_KCR : WS_VCR)) + ((size_t)bg * SEQ + 256 * rb) * 64;
    const bf16_t* W1f = (const bf16_t*)(P.ws + WS_CW1) + (size_t)kv * 256 * 2048;
    const bf16_t* W2t = (const bf16_t*)(P.ws + WS_CW2) + (size_t)kv * 64 * 256;
    const float* B1P = (const float*)(P.ws + WS_B1P) + (size_t)kv * 16 * 256;
    LAS unsigned char* xs = lds;
    LAS bf16_t* hidS = (LAS bf16_t*)(lds + 272 * 128);
    LAS float* outS = (LAS float*)(lds + 272 * 128 + 16 * 264 * 2);
    const bf16_t* bp0 = W1f + (size_t)(2 * wave) * 64 * 512 + lane * 8; const bf16_t* bp1 = bp0 + 64 * 512;
    bf16x8 bb[4][8];
#define CMP_LOADB(buf, ch) do { _Pragma("unroll") for (int q_ = 0; q_ < 4; ++q_) { bb[buf][2 * q_] = *(const bf16x8*)(bp0 + (size_t)(4 * (ch) + q_) * 512); bb[buf][2 * q_ + 1] = *(const bf16x8*)(bp1 + (size_t)(4 * (ch) + q_) * 512); } } while (0)
    CMP_LOADB(0, 0); CMP_LOADB(1, 1); CMP_LOADB(2, 2);
#pragma unroll
    for (int i = 0; i < 5; ++i) { const int idx = tid + 512 * i;
        if (idx < 2176) { const int t = idx >> 3, c = idx & 7; const uint4 v = *(const uint4*)(X + (size_t)t * 64 + c * 8);
            *(LAS v4u*)(xs + t * 128 + ((c ^ ((t >> 4) & 7)) << 4)) = (v4u){v.x, v.y, v.z, v.w}; } }
    __syncthreads();
    {
        const int n0 = 32 * wave;
        f32x4 acc0 = {0.f, 0.f, 0.f, 0.f}, acc1 = {0.f, 0.f, 0.f, 0.f};
#pragma unroll
        for (int ch = 0; ch < 16; ++ch) {
            if (ch + 3 < 16) CMP_LOADB((ch + 3) & 3, ch + 3);
#pragma unroll
            for (int q = 0; q < 4; ++q) {
                const int ks = 4 * ch + q, tau = ks >> 1, c = (ks & 1) * 4 + fq, t = 16 * fr + tau;
                const bf16x8 a = *(const LAS bf16x8*)(xs + t * 128 + ((c ^ ((t >> 4) & 7)) << 4));
                acc0 = __builtin_amdgcn_mfma_f32_16x16x32_bf16(a, bb[ch & 3][2 * q], acc0, 0, 0, 0);
                acc1 = __builtin_amdgcn_mfma_f32_16x16x32_bf16(a, bb[ch & 3][2 * q + 1], acc1, 0, 0, 0);
            }
        }
#undef CMP_LOADB
        const float* b1 = kv == 0 ? P.c_k_b1 : P.c_v_b1;
#pragma unroll
        for (int f = 0; f < 2; ++f) {
            const int n = n0 + 16 * f + fr;
            float bias = b1[n];
#pragma unroll
            for (int kc = 0; kc < 16; ++kc) bias += B1P[kc * 256 + n];
#pragma unroll
            for (int r = 0; r < 4; ++r) { const float v = (f == 0 ? acc0[r] : acc1[r]) + bias; hidS[(4 * fq + r) * 264 + n] = f2bf(fast_silu(v)); }
        }
    }
    __syncthreads();
    if (wave < 4) {
        const int d0 = 16 * wave;
        f32x4 acc = {0.f, 0.f, 0.f, 0.f};
#pragma unroll
        for (int k0 = 0; k0 < 256; k0 += 32) {
            const bf16x8 a = *(const LAS bf16x8*)(hidS + fr * 264 + k0 + 8 * fq);
            const bf16x8 b = *(const bf16x8*)(W2t + (size_t)(d0 + fr) * 256 + k0 + 8 * fq);
            acc = __builtin_amdgcn_mfma_f32_16x16x32_bf16(a, b, acc, 0, 0, 0);
        }
        const float b2 = (kv == 0 ? P.c_k_b2 : P.c_v_b2)[d0 + fr];
#pragma unroll
        for (int r = 0; r < 4; ++r) outS[(4 * fq + r) * 65 + d0 + fr] = acc[r] + b2;
    }
    __syncthreads();
    {
        bf16_t* dst = (bf16_t*)(P.ws + (kv == 0 ? WS_KC : WS_VC)) + (size_t)bg * 128 * 64;
#pragma unroll
        for (int k = 0; k < 2; ++k) {
            const int row = 2 * wave + k, c = 16 * rb + row;
            float v = outS[row * 65 + lane];
            if (kv == 0) { const float ss = wave_sum(v * v); v = v * (1.0f / sqrtf(ss * (1.0f / 64) + EPSF)) * P.c_knorm_cmp_g[lane]; }
            const size_t off = kv == 0 ? (size_t)(c >> 6) * 4096 + (lane >> 3) * 512 + (c & 63) * 8 + (lane & 7)
                                       : (size_t)(c >> 6) * 4096 + (lane >> 5) * 2048 + (c & 63) * 32 + (lane & 31);
            dst[off] = c < 127 ? f2bf(v) : (bf16_t)0;
        }
    }
    __syncthreads();
}

__device__ __forceinline__ void gate_unit(const KArgs& P, LAS unsigned char* lds, int u, int tid, int wave, int lane) {
    const bf16_t* XB = (const bf16_t*)(P.ws + WS_XB); const bf16_t* WG = (const bf16_t*)(P.ws + WS_WGATE); const float* SSQ = (const float*)(P.ws + WS_SSQ); float* GT = (float*)(P.ws + WS_GT);
    const int fr = lane & 15, fq = lane >> 4, mf = wave & 3, kh = wave >> 2, t0 = 64 * u + 16 * mf;
    constexpr int ROWB = 2064;
    LAS float* part = (LAS float*)(lds + 32 * ROWB);
#pragma unroll
    for (int i = 0; i < 8; ++i) { const int idx = tid + 512 * i, n = idx >> 7, ch = idx & 127;
        const uint4 v = *(const uint4*)(WG + (size_t)n * DM + ch * 8);
        *(LAS v4u*)(lds + n * ROWB + ch * 16) = (v4u){v.x, v.y, v.z, v.w}; }
    bf16x8 a[16];
    const bf16_t* ap = XB + (size_t)(t0 + fr) * DM + kh * 512 + 8 * fq;
#pragma unroll
    for (int i = 0; i < 16; ++i) a[i] = *(const bf16x8*)(ap + 32 * i);
    __syncthreads();
    f32x4 acc0 = {0.f, 0.f, 0.f, 0.f}, acc1 = {0.f, 0.f, 0.f, 0.f};
    const LAS unsigned char* bp = lds + fr * ROWB + (kh * 512 + 8 * fq) * 2;
#pragma unroll
    for (int i = 0; i < 16; ++i) {
        const bf16x8 b0 = *(const LAS bf16x8*)(bp + 64 * i), b1 = *(const LAS bf16x8*)(bp + 16 * ROWB + 64 * i);
        acc0 = __builtin_amdgcn_mfma_f32_16x16x32_bf16(a[i], b0, acc0, 0, 0, 0);
        acc1 = __builtin_amdgcn_mfma_f32_16x16x32_bf16(a[i], b1, acc1, 0, 0, 0);
    }
    if (kh == 1) {
#pragma unroll
        for (int r = 0; r < 4; ++r) { part[(mf * 64 + lane) * 8 + r] = acc0[r]; part[(mf * 64 + lane) * 8 + 4 + r] = acc1[r]; }
    }
    __syncthreads();
    if (kh == 0) {
#pragma unroll
        for (int r = 0; r < 4; ++r) {
            const int t = t0 + 4 * fq + r;
            const float4* sq = (const float4*)(SSQ + (size_t)t * 16);
            const float4 q0 = sq[0], q1 = sq[1], q2 = sq[2], q3 = sq[3];
            const float ssq = ((q0.x + q0.y) + (q0.z + q0.w)) + ((q1.x + q1.y) + (q1.z + q1.w)) + ((q2.x + q2.y) + (q2.z + q2.w)) + ((q3.x + q3.y) + (q3.z + q3.w));
            const float rstd = 1.0f / sqrtf(ssq * (1.0f / DM) + EPSF);
            GT[(size_t)t * 32 + fr] = fast_sigmoid((acc0[r] + part[(mf * 64 + lane) * 8 + r]) * rstd);
            if (fr < 8) GT[(size_t)t * 32 + 16 + fr] = fast_sigmoid((acc1[r] + part[(mf * 64 + lane) * 8 + 4 + r]) * rstd);
        }
    }
    __syncthreads();
}

__device__ __forceinline__ void b1p_item(const KArgs& P, int it, int lane) {
    const int kv = it >> 6, kc = (it >> 2) & 15, n = (it & 3) * 64 + lane;
    const float* pos = kv == 0 ? P.c_pos_k : P.c_pos_v; const float* w1 = kv == 0 ? P.c_k_w1 : P.c_v_w1;
    float s = 0.f;
#pragma unroll 32
    for (int k = kc * 128; k < kc * 128 + 128; ++k) s += pos[k] * w1[(size_t)k * 256 + n];
    ((float*)(P.ws + WS_B1P))[((size_t)kv * 16 + kc) * 256 + n] = s;
}
__device__ __forceinline__ void w1f_item(const KArgs& P, int it, int lane) {
    const int kv = it >> 7, nf = (it >> 3) & 15, ks8 = it & 7, fr = lane & 15, fq = lane >> 4;
    const float* w1 = kv == 0 ? P.c_k_w1 : P.c_v_w1;
    bf16_t* dst = (bf16_t*)(P.ws + WS_CW1) + (size_t)kv * 256 * 2048 + (size_t)nf * 64 * 512 + lane * 8;
    float v[8][8];
#pragma unroll
    for (int q = 0; q < 8; ++q) {
        const float* src = w1 + (size_t)(32 * (ks8 * 8 + q) + 8 * fq) * 256 + 16 * nf + fr;
#pragma unroll
        for (int j = 0; j < 8; ++j) v[q][j] = src[j * 256];
    }
#pragma unroll
    for (int q = 0; q < 8; ++q) {
        uint4 o; o.x = pk2(v[q][0], v[q][1]); o.y = pk2(v[q][2], v[q][3]); o.z = pk2(v[q][4], v[q][5]); o.w = pk2(v[q][6], v[q][7]);
        *(uint4*)(dst + (size_t)(ks8 * 8 + q) * 512) = o;
    }
}
}
__device__ __forceinline__ NvGroup fast_group(const KArgs& P, int layer, int pn, int wc) {
    if (layer == 0) {
        if (pn < 4) { NvGroup g; g.gain = nullptr; g.scale = 1.f; g.width = 32; g.type = 4; g.col = 128 * pn + 32 * wc; g.col2 = 512 + g.col; g.dkind = 0; g.dst = P.ws + WS_G0; g.ld = 512; g.idx = 0; return g; }
        return nv_group0(P, 8 + 4 * (pn - 4) + wc);
    }
    int gi;
    if (pn < 2) gi = 4 * pn + wc;
    else if (pn < 4) gi = 21 + 4 * (pn - 2) + wc;
    else if (pn < 6) gi = 29 + 4 * (pn - 4) + wc;
    else if (pn < 8) gi = 41 + 4 * (pn - 6) + wc;
    else if (pn == 8) gi = 8 + wc;
    else if (pn == 9) gi = wc < 2 ? 12 + wc : 16 + (wc - 2);
    else if (pn == 10) gi = wc < 2 ? 14 + wc : 18 + (wc - 2);
    else if (pn == 11) gi = wc < 2 ? 37 + wc : 39 + (wc - 2);
    else { NvGroup g; g.gain = nullptr; g.scale = 1.f; g.width = 0; g.type = 5; g.col = 0; g.col2 = 0; g.dkind = 0; g.dst = nullptr; g.ld = 0; g.idx = 0; return g; }
    return nv_group1(P, gi);
}
constexpr int NTILE_IN0 = 14, NTILE_IN1 = 12;


struct EpiIn {
    static constexpr bool PERM = true, AFTER_DRAIN = false;
    KArgs P; int layer;
    __device__ __forceinline__ void operator()(const pg8::f32x4 (&acc)[2][2][4][2], const pg8::Unit& u, int wr, int wc, int fr, int fq) const {
        const NvGroup g = fast_group(P, layer, u.pn, wc);
        if (g.type == 5) return;
        const float* SSQ = (const float*)(P.ws + WS_SSQ);
        const bool do_km = (layer == 0 && g.type == 2 && u.pn >= 8);
        float gn[16], km[16];
#pragma unroll
        for (int i = 0; i < 16; ++i) { gn[i] = 1.f; km[i] = 0.f; }
        if (g.type == 2) {
#pragma unroll
            for (int bj = 0; bj < 2; ++bj)
#pragma unroll
                for (int i = 0; i < 8; ++i) gn[8 * bj + i] = g.gain[32 * bj + 8 * fq + i] * g.scale;
        }
#pragma unroll
        for (int ai = 0; ai < 2; ++ai)
#pragma unroll
            for (int m = 0; m < 4; ++m) {
                const int t = u.pm * 256 + ai * 128 + wr * 64 + m * 16 + fr, b = t >> 11, s = t & 2047;
                const float4* sq = (const float4*)(SSQ + (size_t)t * 16);
                const float4 q0 = sq[0], q1 = sq[1], q2 = sq[2], q3 = sq[3];
                const float ssq = ((q0.x + q0.y) + (q0.z + q0.w)) + ((q1.x + q1.y) + (q1.z + q1.w)) + ((q2.x + q2.y) + (q2.z + q2.w)) + ((q3.x + q3.y) + (q3.z + q3.w));
                const float rstd = 1.0f / sqrtf(ssq * (1.0f / DM) + EPSF);
                float v[16];
#pragma unroll
                for (int bj = 0; bj < 2; ++bj)
#pragma unroll
                    for (int n = 0; n < 2; ++n)
#pragma unroll
                        for (int r = 0; r < 4; ++r) v[8 * bj + 4 * n + r] = acc[ai][bj][m][n][r] * rstd;
                if (g.type == 4) {
                    pg8::u32x4 w;
                    float o[8];
#pragma unroll
                    for (int i = 0; i < 8; ++i) o[i] = v[i] * fast_sigmoid(v[8 + i]);
                    w.x = pg8::cvt_pk_bf16(o[0], o[1]); w.y = pg8::cvt_pk_bf16(o[2], o[3]); w.z = pg8::cvt_pk_bf16(o[4], o[5]); w.w = pg8::cvt_pk_bf16(o[6], o[7]);
                    *(pg8::u32x4*)((bf16_t*)g.dst + (size_t)t * 512 + g.col + 8 * fq) = w;
                    continue;
                }
                if (g.type == 3) {
                    if (fq < 3) {
                        float4 o0, o1;
                        o0.x = fast_sigmoid(v[0]); o0.y = fast_sigmoid(v[1]); o0.z = fast_sigmoid(v[2]); o0.w = fast_sigmoid(v[3]);
                        o1.x = fast_sigmoid(v[4]); o1.y = fast_sigmoid(v[5]); o1.z = fast_sigmoid(v[6]); o1.w = fast_sigmoid(v[7]);
                        float* gp = (float*)g.dst + (size_t)t * 32 + 8 * fq;
                        *(float4*)gp = o0; *(float4*)(gp + 4) = o1;
                    }
                    continue;
                }
                if (g.type == 1) {
#pragma unroll
                    for (int i = 0; i < 16; ++i) v[i] = fast_silu(v[i]);
                } else if (g.type == 2) {
                    float ss = 0.f;
#pragma unroll
                    for (int i = 0; i < 16; ++i) ss += v[i] * v[i];
                    ss += __shfl_xor(ss, 16); ss += __shfl_xor(ss, 32);
                    const float nrm = 1.0f / sqrtf(ss * (1.0f / 64) + EPSF);
#pragma unroll
                    for (int i = 0; i < 16; ++i) v[i] = v[i] * nrm * gn[i];
                    if (do_km) {
#pragma unroll
                        for (int i = 0; i < 16; ++i) km[i] += v[i];
                    }
                }
                bf16_t* dp = g.dkind == 0 ? (bf16_t*)g.dst + (size_t)t * g.ld + g.idx * 64 + 8 * fq
                                          : (bf16_t*)g.dst + ((size_t)(b * g.ld + g.idx) * SEQ + s) * 64 + 8 * fq;
                int bjstep = 32;
                if (g.dkind == 3) { dp = (bf16_t*)g.dst + (size_t)(b * g.ld + g.idx) * SEQ * 64 + (size_t)(s >> 6) * 4096 + fq * 512 + (s & 63) * 8; bjstep = 2048; }
                else if (g.dkind == 4) { dp = (bf16_t*)g.dst + (size_t)(b * g.ld + g.idx) * SEQ * 64 + (size_t)(s >> 6) * 4096 + (s & 63) * 32 + 8 * fq; bjstep = 2048; }
#pragma unroll
                for (int bj = 0; bj < 2; ++bj) {
                    pg8::u32x4 w;
                    w.x = pg8::cvt_pk_bf16(v[8 * bj + 0], v[8 * bj + 1]); w.y = pg8::cvt_pk_bf16(v[8 * bj + 2], v[8 * bj + 3]);
                    w.z = pg8::cvt_pk_bf16(v[8 * bj + 4], v[8 * bj + 5]); w.w = pg8::cvt_pk_bf16(v[8 * bj + 6], v[8 * bj + 7]);
                    *(pg8::u32x4*)(dp + bjstep * bj) = w;
                }
            }
        if (do_km) {
#pragma unroll
            for (int i = 0; i < 16; ++i) { float a = km[i]; a += __shfl_xor(a, 1); a += __shfl_xor(a, 2); a += __shfl_xor(a, 4); a += __shfl_xor(a, 8); km[i] = a * (1.0f / 256); }
            if (fr == 0) {
                float* kp = (float*)(P.ws + WS_KMP) + ((size_t)wr * 64 + u.pm) * 512 + g.idx * 64 + 8 * fq;
#pragma unroll
                for (int bj = 0; bj < 2; ++bj) {
                    float4 o0, o1; o0.x = km[8 * bj + 0]; o0.y = km[8 * bj + 1]; o0.z = km[8 * bj + 2]; o0.w = km[8 * bj + 3];
                    o1.x = km[8 * bj + 4]; o1.y = km[8 * bj + 5]; o1.z = km[8 * bj + 6]; o1.w = km[8 * bj + 7];
                    *(float4*)(kp + 32 * bj) = o0; *(float4*)(kp + 32 * bj + 4) = o1;
                }
            }
        }
    }
};

struct EpiOut {
    static constexpr bool PERM = true, AFTER_DRAIN = false;
    float* out; bf16_t* XB; float* SSQ; int layer;
    __device__ __forceinline__ void operator()(const pg8::f32x4 (&acc)[2][2][4][2], const pg8::Unit& u, int wr, int wc, int fr, int fq) const {
        const int col0 = u.pn * 256 + wc * 32 + 8 * fq;
#pragma unroll
        for (int ai = 0; ai < 2; ++ai)
#pragma unroll
            for (int m = 0; m < 4; ++m) {
                const int t = u.pm * 256 + ai * 128 + wr * 64 + m * 16 + fr;
                float ss = 0.f;
#pragma unroll
                for (int bj = 0; bj < 2; ++bj) {
                    const size_t o = (size_t)t * DM + col0 + 128 * bj;
                    const pg8::u32x4 rb = *(const pg8::u32x4*)(XB + o);
                    pg8::f32x4 x0, x1;
                    x0[0] = bf2f(rb.x & 0xffff) + acc[ai][bj][m][0][0]; x0[1] = bf2f(rb.x >> 16) + acc[ai][bj][m][0][1]; x0[2] = bf2f(rb.y & 0xffff) + acc[ai][bj][m][0][2]; x0[3] = bf2f(rb.y >> 16) + acc[ai][bj][m][0][3];
                    x1[0] = bf2f(rb.z & 0xffff) + acc[ai][bj][m][1][0]; x1[1] = bf2f(rb.z >> 16) + acc[ai][bj][m][1][1]; x1[2] = bf2f(rb.w & 0xffff) + acc[ai][bj][m][1][2]; x1[3] = bf2f(rb.w >> 16) + acc[ai][bj][m][1][3];
                    if (layer == 0) {
                        pg8::u32x4 w; w.x = pg8::cvt_pk_bf16(x0[0], x0[1]); w.y = pg8::cvt_pk_bf16(x0[2], x0[3]); w.z = pg8::cvt_pk_bf16(x1[0], x1[1]); w.w = pg8::cvt_pk_bf16(x1[2], x1[3]);
                        *(pg8::u32x4*)(XB + o) = w;
                        ss += (x0[0] * x0[0] + x0[1] * x0[1]) + (x0[2] * x0[2] + x0[3] * x0[3]) + (x1[0] * x1[0] + x1[1] * x1[1]) + (x1[2] * x1[2] + x1[3] * x1[3]);
                    } else { *(pg8::f32x4*)(out + o) = x0; *(pg8::f32x4*)(out + o + 4) = x1; }
                }
                if (layer == 0) { ss += __shfl_xor(ss, 16); ss += __shfl_xor(ss, 32); if (fq == 0) SSQ[(size_t)t * 16 + u.pn * 4 + wc] = ss; }
            }
    }
};

__device__ __forceinline__ void cvt_item(const float* __restrict__ W, int ldw, const float* __restrict__ gain, bf16_t* __restrict__ Bt, int Kd, int k0, int drow0, int src0, int vw, LAS float* scr, int lane) {
    {
        const int c = lane & 31, h = lane >> 5;
        if (vw == 32) {
            float v[32];
#pragma unroll
            for (int i = 0; i < 32; ++i) v[i] = W[(size_t)(k0 + 2 * i + h) * ldw + src0 + c];
            if (gain) {
#pragma unroll
                for (int i = 0; i < 32; ++i) v[i] *= gain[k0 + 2 * i + h];
            }
#pragma unroll
            for (int i = 0; i < 32; ++i) scr[(2 * i + h) * 33 + c] = v[i];
        } else {
            const int cc = c < vw ? c : (vw > 0 ? vw - 1 : 0);
#pragma unroll 8
            for (int i = 0; i < 32; ++i) { const int kk = 2 * i + h;
                float v = vw > 0 ? W[(size_t)(k0 + kk) * ldw + src0 + cc] : 0.f; if (gain) v *= gain[k0 + kk];
                scr[kk * 33 + c] = c < vw ? v : 0.f; }
        }
    }
    LDS_WAIT(); asm volatile("" ::: "memory");
    const int c = lane & 7;
#pragma unroll
    for (int j = 0; j < 4; ++j) { const int n = (lane >> 3) + 8 * j; const LAS float* s = scr + (8 * c) * 33 + n;
        v4u o; o.x = pk2(s[0 * 33], s[1 * 33]); o.y = pk2(s[2 * 33], s[3 * 33]); o.z = pk2(s[4 * 33], s[5 * 33]); o.w = pk2(s[6 * 33], s[7 * 33]);
        *(v4u*)(Bt + (size_t)(drow0 + n) * Kd + k0 + 8 * c) = o; }
    LDS_WAIT(); asm volatile("" ::: "memory");
}
__device__ __forceinline__ void cvt_in_item(const KArgs& P, int layer, int it, LAS float* scr, int lane) {
    const int kb = it & 15, blk = it >> 4, pn = blk >> 3, pb = blk & 7, wc = pb & 3, bj = pb >> 2;
    const NvGroup g = fast_group(P, layer, pn, wc);
    int src0 = 0, vw = 0;
    if (g.type == 4) { src0 = bj ? g.col2 : g.col; vw = 32; }
    else if (g.type != 5) { src0 = g.col + 32 * bj; vw = g.width - 32 * bj; vw = vw < 0 ? 0 : (vw > 32 ? 32 : vw); }
    const float* W = layer == 0 ? P.e_w_in : P.o_w_in; const int ldw = layer == 0 ? 3584 : 3096;
    bf16_t* Bt = (bf16_t*)(P.ws + (layer == 0 ? WS_WIN0 : WS_WIN1));
    cvt_item(W, ldw, P.norm_g + layer * DM, Bt, DM, 64 * kb, 256 * pn + 128 * bj + 32 * wc, src0, vw, scr, lane);
}
__device__ __forceinline__ void p0_deferred_item(const KArgs& P, int r, LAS float* scr, int lane) {
    constexpr int I_B1P = 128, I_WG = 16, I_IN1 = NTILE_IN1 * 8 * 16, I_OUT = 32 * 16, I_W1 = 128, I_W2 = 2 * 4;
    if (r < I_B1P) { fm::b1p_item(P, r, lane); return; } r -= I_B1P;
    if (r < 2 * I_W1) { fm::w1f_item(P, r, lane); return; } r -= 2 * I_W1;
    if (r < I_WG) { cvt_item(P.o_w_in, 3096, P.norm_g + DM, (bf16_t*)(P.ws + WS_WGATE), DM, 64 * r, 0, 1280, 24, scr, lane); return; } r -= I_WG;
    if (r < 2 * I_W2) { const int kv = r / I_W2; r -= kv * I_W2; const int kb = r & 3, nb = r >> 2;
        cvt_item(kv == 0 ? P.c_k_w2 : P.c_v_w2, 64, nullptr, (bf16_t*)(P.ws + WS_CW2) + (size_t)kv * 64 * 256, 256, 64 * kb, 32 * nb, 32 * nb, 32, scr, lane); return; }
    r -= 2 * I_W2;
    if (r < 2 * I_OUT) { const int l = r / I_OUT; r -= l * I_OUT; const int kb = r & 15, nb = r >> 4;
        cvt_item(P.w_out + (size_t)l * DM * DM, DM, nullptr, (bf16_t*)(P.ws + (l == 0 ? WS_WOUT0 : WS_WOUT1)), DM, 64 * kb, 32 * nb, 32 * nb, 32, scr, lane); return; }
    r -= 2 * I_OUT;
    cvt_in_item(P, 1, r, scr, lane);
}
constexpr int N_EARLY = 128 + 256 + 16 + 16;
constexpr int N_DEFERRED = 2 * 512 + NTILE_IN1 * 128 + 256 + 128 + 16 + 16;
constexpr int CW_WQD = 8192 + 2048;
__device__ __forceinline__ void p0_deferred(const KArgs& P, LAS unsigned char* lds, volatile LAS unsigned* MISC, int nwg, int G, int c, int tid, int wave, int lane) {
    const int maxu = (nwg + G - 1) / G, c0 = nwg - (maxu - 1) * G;
    if (c0 < G && c < c0) return;
    LAS float* scr = (LAS float*)(lds + wave * 16384);
    unsigned* ctr = (unsigned*)(P.ws + WS_CTL) + CW_WQD;
    for (;;) {
        __syncthreads();
        if (tid == 0) MISC[13] = __hip_atomic_fetch_add(ctr, 8u, __ATOMIC_RELAXED, __HIP_MEMORY_SCOPE_AGENT);
        __syncthreads();
        const int base = N_EARLY + (int)MISC[13];
        if (base >= N_DEFERRED) break;
        { const int r = base + wave; if (r < N_DEFERRED) p0_deferred_item(P, r, scr, lane); }
    }
}
__device__ __forceinline__ void p0_prologue(const KArgs& P, LAS unsigned char* lds, int vcu, int G, int wave, int lane) {
    LAS float* scr = (LAS float*)(lds + wave * 16384);
    const int gw = vcu * 8 + wave, NGW = G * 8;
    constexpr int I_IN0 = NTILE_IN0 * 8 * 16;
    for (int it = vcu + G * wave; it < N_EARLY + I_IN0; it += NGW) {
        if (it < N_EARLY) p0_deferred_item(P, it, scr, lane); else cvt_in_item(P, 0, it - N_EARLY, scr, lane);
    }
    bf16_t* XB = (bf16_t*)(P.ws + WS_XB); float* SSQ = (float*)(P.ws + WS_SSQ);
    const int rows_per_wave = (NT + NGW - 1) / NGW;
    for (int m0 = gw * rows_per_wave; m0 < (gw + 1) * rows_per_wave && m0 < NT; m0 += 4) {
        float4 v[4][4];
#pragma unroll
        for (int q = 0; q < 4; ++q) { const int m = m0 + q < NT ? m0 + q : NT - 1; const float4* r = (const float4*)(P.x + (size_t)m * DM) + 2 * lane;
            v[q][0] = r[0]; v[q][1] = r[1]; v[q][2] = r[128]; v[q][3] = r[129]; }
#pragma unroll
        for (int q = 0; q < 4; ++q) {
            const int m = m0 + q;
            float s = 0.f;
#pragma unroll
            for (int j = 0; j < 4; ++j) s += (v[q][j].x * v[q][j].x + v[q][j].y * v[q][j].y) + (v[q][j].z * v[q][j].z + v[q][j].w * v[q][j].w);
#pragma unroll
            for (int o = 1; o < 64; o <<= 1) s += __shfl_xor(s, o);
            if (m < NT && m < (gw + 1) * rows_per_wave) {
                uint4 o0, o1;
                o0.x = pg8::cvt_pk_bf16(v[q][0].x, v[q][0].y); o0.y = pg8::cvt_pk_bf16(v[q][0].z, v[q][0].w); o0.z = pg8::cvt_pk_bf16(v[q][1].x, v[q][1].y); o0.w = pg8::cvt_pk_bf16(v[q][1].z, v[q][1].w);
                o1.x = pg8::cvt_pk_bf16(v[q][2].x, v[q][2].y); o1.y = pg8::cvt_pk_bf16(v[q][2].z, v[q][2].w); o1.z = pg8::cvt_pk_bf16(v[q][3].x, v[q][3].y); o1.w = pg8::cvt_pk_bf16(v[q][3].z, v[q][3].w);
                *(uint4*)(XB + (size_t)m * DM + 8 * lane) = o0; *(uint4*)(XB + (size_t)m * DM + 512 + 8 * lane) = o1;
                if (lane < 4) { float4 z; z.x = lane == 0 ? s : 0.f; z.y = 0.f; z.z = 0.f; z.w = 0.f; *(float4*)(SSQ + (size_t)m * 16 + lane * 4) = z; }
            }
        }
    }
}

constexpr int CW_WQ2 = 8192, CW_WQ2C = 8192 + 512, CW_WQ6 = 8192 + 1024;
#define WQ_FIRST(ctrptr) unsigned* ctr_ = (ctrptr); \
        if (tid == 0) MISC[12] = __hip_atomic_fetch_add(ctr_, 1u, __ATOMIC_RELAXED, __HIP_MEMORY_SCOPE_AGENT); \
        __syncthreads(); \
        int it_ = (int)MISC[12];
#define WQ_WHILE(LIMIT, ...) while (it_ < (LIMIT)) { \
            unsigned nx_ = 0u; if (tid == 0) nx_ = __hip_atomic_fetch_add(ctr_, 1u, __ATOMIC_RELAXED, __HIP_MEMORY_SCOPE_AGENT);     \
            { const int it = it_; __VA_ARGS__ } \
            __syncthreads(); if (tid == 0) MISC[12] = nx_; __syncthreads(); it_ = (int)MISC[12]; \
        }
#define WQ_QUEUES(cwbase, QLEN, ...) do { const int xcc_ = (int)(xb_xcc_id() & 7u); unsigned* qb_ = (unsigned*)(P.ws + WS_CTL) + (cwbase); \
        for (int qi_ = 0; qi_ < 8; ++qi_) { const int q = (xcc_ + qi_) & 7; \
            if (qi_ == 1) { __syncthreads(); if (tid < 8) MISC[24 + tid] = __hip_atomic_load(qb_ + 64 * tid, __ATOMIC_RELAXED, __HIP_MEMORY_SCOPE_AGENT); __syncthreads(); } \
            if (qi_ >= 1 && MISC[24 + q] >= (unsigned)(QLEN)) continue; \
            WQ_FIRST(qb_ + 64 * q) __VA_ARGS__ } } while (0)

constexpr int RING_BYTES = 131072, LDSCTL_OFF = RING_BYTES, MISC_OFF = LDSCTL_OFF + 320, LDS_BYTES = 147456;
constexpr int CW_BAR = 4096;
constexpr int NPHASE = 8;

__global__ void __launch_bounds__(512, 2) mk_fwd(KArgs P) {
    extern __shared__ __attribute__((aligned(16))) unsigned char lds_raw[];
    LAS unsigned char* lds = (LAS unsigned char*)lds_raw;
    volatile LAS unsigned* MISC = (volatile LAS unsigned*)(lds + MISC_OFF);
    const int tid = threadIdx.x, lane = tid & 63, wave = __builtin_amdgcn_readfirstlane(tid >> 6);
    const int G = gridDim.x, bx = blockIdx.x, vcu = (G % 8 == 0) ? (bx % 8) * (G / 8) + bx / 8 : bx;
    for (int u = tid; u < (LDS_BYTES - LDSCTL_OFF) / 4; u += 512) ((LAS unsigned*)(lds + LDSCTL_OFF))[u] = 0u;
    __syncthreads();
#ifdef PROBE_A
#ifndef PROBE_BX
#define PROBE_BX 0
#endif
#define STAMP(n) do { if (bx == PROBE_BX && tid == 0) { MISC[40 + (n)] = (unsigned)__builtin_amdgcn_s_memrealtime(); MISC[80 + (n)] = (unsigned)__builtin_amdgcn_s_memtime(); } } while (0)
#else
#define STAMP(n) do {} while (0)
#endif
    const int lo = P.ph_lo, hi = P.ph_hi;
    STAMP(0);
    XcdBarrier bar; bar.bar = (unsigned*)(P.ws + WS_CTL) + CW_BAR; bar.x = 0; bar.st = nullptr;
    if (hi - lo > 1) bar = xcd_barrier_post((unsigned*)(P.ws + WS_CTL) + CW_BAR, MISC + 8);
#define IN(k) (lo <= (k) && (k) < hi)
#define SEAM(k) do { STAMP(2 * (k) + 1); if (IN(k) && IN((k) + 1)) xcd_barrier(bar); STAMP(2 * (k) + 2); } while (0)

    if (IN(0)) {
        p0_prologue(P, lds, vcu, G, wave, lane); SEAM(0);
    }
    if (IN(1)) {
        pg8::Gemm g{(const bf16_t*)(P.ws + WS_XB), (const bf16_t*)(P.ws + WS_WIN0), NT, NTILE_IN0 * 256, DM}; pg8::StaticOrder S; S.init(NT, NTILE_IN0 * 256, G, bx);
        EpiIn E{P, 0};
        pg8::gemm_phase<EpiIn, pg8::StaticOrder, true, true>(lds, g, S, E);
        p0_deferred(P, lds, MISC, (NT / 256) * NTILE_IN0, G, bx, tid, wave, lane);
        SEAM(1);
    }
    if (IN(2)) {
        for (int k = vcu; k < 512; k += G) { const int kk = k < 256 ? k : k - 256, bh = kk >> 2, own = k < 256 ? 7 - (kk & 3) : (kk & 3);
            fa::moba_unit(P, (fa::lds_ptr)lds, bh >> 3, bh & 7, own, wave, lane); }
        STAMP(20);
        {
            fm::ConvW cw; fm::conv_load_w(P, cw, tid, lane);
            WQ_QUEUES(CW_WQ2C, 64, WQ_WHILE(64, fm::conv_unit(P, lds, 64 * q + it, cw, tid, wave, lane);));
        }
        SEAM(2);
    }
    if (IN(3)) {
        pg8::Gemm g{(const bf16_t*)(P.ws + WS_Y), (const bf16_t*)(P.ws + WS_WOUT0), NT, DM, DM}; pg8::StaticOrder S; S.init(NT, DM, G, bx);
        EpiOut E{P.out, (bf16_t*)(P.ws + WS_XB), (float*)(P.ws + WS_SSQ), 0};
        pg8::gemm_phase<EpiOut, pg8::StaticOrder, true, true>(lds, g, S, E);
        SEAM(3);
    }
    if (IN(4)) {
        pg8::Gemm g{(const bf16_t*)(P.ws + WS_XB), (const bf16_t*)(P.ws + WS_WIN1), NT, NTILE_IN1 * 256, DM}; pg8::StaticOrder S; S.init(NT, NTILE_IN1 * 256, G, bx);
        EpiIn E{P, 1};
        pg8::gemm_phase<EpiIn, pg8::StaticOrder, true, true>(lds, g, S, E);
        SEAM(4);
    }
    if (IN(5)) {
        for (int k = vcu; k < 256; k += G) fm::gate_unit(P, lds, k, tid, wave, lane);
        STAMP(21);
        if (P.flags & 16) for (int k = vcu; k < 256; k += G) fm::cmp_unit(P, lds, k, tid, wave, lane);
        SEAM(5);
    }
    if (IN(6)) {
        for (int k = vcu; k < 512; k += G) { const int kk = k < 256 ? k : k - 256, bg = kk >> 4, c = k < 256 ? 31 - (kk & 15) : (kk & 15);
            fa::nsa_unit(P, (fa::lds_ptr)lds, bg >> 1, bg & 1, c, wave, lane, tid); }
        STAMP(22);
        WQ_QUEUES(CW_WQ6, 64, WQ_WHILE(64, fa::swa_unit(P, (fa::lds_ptr)lds, q, it & 1, 31 - (it >> 1), wave, lane);));
        SEAM(6);
    }
    if (IN(7)) {
        pg8::Gemm g{(const bf16_t*)(P.ws + WS_Y), (const bf16_t*)(P.ws + WS_WOUT1), NT, DM, DM}; pg8::StaticOrder S; S.init(NT, DM, G, bx);
        EpiOut E{P.out, (bf16_t*)(P.ws + WS_XB), nullptr, 1};
        pg8::gemm_phase<EpiOut, pg8::StaticOrder, true, true>(lds, g, S, E);
    }
#ifdef PROBE_A
    if (bx == PROBE_BX && tid == 0) {
#ifdef PROBE_CLK
        const unsigned dt = (unsigned)(1000.f * (float)(MISC[80 + PROBE_B] - MISC[80 + PROBE_A]) / (float)(MISC[40 + PROBE_B] - MISC[40 + PROBE_A])), t0 = (unsigned)__builtin_amdgcn_s_memrealtime();
#else
        const unsigned dt = (MISC[40 + PROBE_B] - MISC[40 + PROBE_A]) * 8u, t0 = (unsigned)__builtin_amdgcn_s_memrealtime();
#endif
        while ((unsigned)__builtin_amdgcn_s_memrealtime() - t0 < dt) __builtin_amdgcn_s_sleep(8);
    }
#endif
#undef IN
#undef SEAM
}
static void fill_args(KArgs& a, void* const* d_in, void* d_out, void* d_ws) {
    const float** p = (const float**)&a;
    for (int i = 0; i < 28; ++i) p[i] = (const float*)d_in[i];
    a.out = (float*)d_out; a.ws = (unsigned char*)d_ws; a.ph_lo = 0; a.ph_hi = NPHASE; a.flags = 31; a.pad = 0;
}
static int g_grid = 0;
extern "C" void kernel_launch(void* const* d_in, const int* in_sizes, int n_in, void* d_out, int out_size, void* d_ws, size_t ws_size, hipStream_t stream) {
    if (n_in != 28 || out_size != NT * DM || ws_size < WS_END) { fprintf(stderr, "kernel_launch: unexpected shapes n_in %d out %d ws %zu\n", n_in, out_size, ws_size); return; }
    if (g_grid == 0) {
        int dev = 0, cus = 0;
        if (hipGetDevice(&dev) != hipSuccess || hipDeviceGetAttribute(&cus, hipDeviceAttributeMultiprocessorCount, dev) != hipSuccess) { fprintf(stderr, "kernel_launch: device query failed\n"); g_grid = -1; return; }
        if (hipFuncSetAttribute((const void*)mk_fwd, hipFuncAttributeMaxDynamicSharedMemorySize, LDS_BYTES) != hipSuccess) { fprintf(stderr, "kernel_launch: hipFuncSetAttribute failed\n"); g_grid = -1; return; }
        int per_cu = 0;
        if (hipOccupancyMaxActiveBlocksPerMultiprocessor(&per_cu, (const void*)mk_fwd, 512, LDS_BYTES) != hipSuccess || per_cu < 1) { fprintf(stderr, "kernel_launch: occupancy query says %d blocks/CU\n", per_cu); }
        (void)hipGetLastError();
        g_grid = cus;
    }
    if (g_grid < 0) return;
    KArgs a{}; fill_args(a, d_in, d_out, d_ws);
    (void)hipMemsetAsync((char*)d_ws + WS_CTL, 0, 64 * 1024, stream);
    hipLaunchKernelGGL(mk_fwd, dim3(g_grid), dim3(512), LDS_BYTES, stream, a);
}
```

```cpp
#include <hip/hip_runtime.h>
#include <stdint.h>
#include <stdio.h>

typedef unsigned short bf16_t;
constexpr int NB = 8, SEQ = 2048, NT = NB * SEQ, DM = 1024;
#define EPSF 1e-6f
#define LOG2E 1.4426950408889634f
#define QSCALE (0.125f * 1.4426950408889634f)

constexpr size_t MiB = 1u << 20;
constexpr size_t WS_CTL = 0, WS_SSQ = 5 * MiB, WS_KMP = 1 * MiB + 512 * 1024, WS_B1P = 1 * MiB + 768 * 1024, WS_GT = 2 * MiB, WS_KC = 4 * MiB, WS_VC = 4 * MiB + 256 * 1024;
constexpr size_t WS_WIN0 = 6 * MiB, WS_WOUT0 = 13 * MiB, WS_WIN1 = 15 * MiB, WS_WOUT1 = 22 * MiB, WS_CW1 = 24 * MiB, WS_CW2 = 26 * MiB, WS_WGATE = 27 * MiB;
constexpr size_t WS_XB = 32 * MiB, WS_Y = 64 * MiB;
constexpr size_t WS_G0 = 96 * MiB, WS_ZA = 112 * MiB, WS_QB = 128 * MiB, WS_KB = 144 * MiB, WS_VB = 160 * MiB, WS_ZB = 176 * MiB;
constexpr size_t WS_QC = 96 * MiB, WS_ZC = 112 * MiB, WS_QD = 128 * MiB, WS_ZD = 144 * MiB;
constexpr size_t WS_KCR = 160 * MiB, WS_VCR = 164 * MiB, WS_KS = 168 * MiB, WS_VS = 172 * MiB, WS_KW = 176 * MiB, WS_VW = 180 * MiB, WS_KD = 184 * MiB, WS_VD = 188 * MiB;
constexpr size_t WS_NVTMP = 192 * MiB, WS_END = 200 * MiB;

struct KArgs {
    const float *x, *norm_g, *w_out, *e_w_in, *a_conv_w, *a_conv_b, *a_ln_g, *a_ln_b, *b_qnorm_g, *b_knorm_g, *o_w_in, *c_qnorm_g, *c_knorm_cmp_g, *c_knorm_slc_g,
        *c_knorm_win_g, *c_pos_k, *c_pos_v, *c_k_w1, *c_k_b1, *c_k_w2, *c_k_b2, *c_v_w1, *c_v_b1, *c_v_w2, *c_v_b2, *d_qnorm_g, *d_knorm_g, *d_sinks;
    float* out; unsigned char* ws;
    int ph_lo, ph_hi, flags, pad;
};

__device__ __forceinline__ float bf2f(unsigned v) { return __uint_as_float(v << 16); }
__device__ __forceinline__ unsigned f2bf_u(float f) { unsigned u = __float_as_uint(f); return (u + 0x7fffu + ((u >> 16) & 1u)) >> 16; }
__device__ __forceinline__ bf16_t f2bf(float f) { return (bf16_t)f2bf_u(f); }
__device__ __forceinline__ unsigned pk2(float lo, float hi) { return f2bf_u(lo) | (f2bf_u(hi) << 16); }
__device__ __forceinline__ float fast_silu(float v) { return v * __builtin_amdgcn_rcpf(1.f + __expf(-v)); }
__device__ __forceinline__ float fast_sigmoid(float v) { return __builtin_amdgcn_rcpf(1.f + __expf(-v)); }
struct NvGroup { int col, width, type; const float* gain; float scale; int dkind; void* dst; int ld, idx, col2; };

__device__ __forceinline__ NvGroup nv_group0(const KArgs& P, int gi) {
    NvGroup g; g.gain = nullptr; g.scale = 1.f; g.col2 = 0; g.width = 64;
    const int j = gi & 7;
    switch (gi >> 3) {
    case 0: g.col = 64 * j; g.col2 = 512 + 64 * j; g.type = 4; g.dkind = 0; g.dst = P.ws + WS_G0; g.ld = 512; g.idx = j; break;
    case 1: g.col = 1024 + 64 * j; g.type = 1; g.dkind = 0; g.dst = P.ws + WS_ZA; g.ld = 512; g.idx = j; break;
    case 2: g.col = 1536 + 64 * j; g.type = 2; g.gain = P.b_qnorm_g; g.scale = QSCALE; g.dkind = 1; g.dst = P.ws + WS_QB; g.ld = 8; g.idx = j; break;
    case 3: g.col = 2048 + 64 * j; g.type = 2; g.gain = P.b_knorm_g; g.dkind = 3; g.dst = P.ws + WS_KB; g.ld = 8; g.idx = j; break;
    case 4: g.col = 2560 + 64 * j; g.type = 0; g.dkind = 4; g.dst = P.ws + WS_VB; g.ld = 8; g.idx = j; break;
    default: g.col = 3072 + 64 * j; g.type = 1; g.dkind = 0; g.dst = P.ws + WS_ZB; g.ld = 512; g.idx = j; break;
    }
    return g;
}
__device__ __forceinline__ NvGroup nv_group1(const KArgs& P, int gi) {
    NvGroup g; g.gain = nullptr; g.scale = 1.f; g.col2 = 0; g.width = 64;
    if (gi < 8) { g.col = 64 * gi; g.type = 2; g.gain = P.c_qnorm_g; g.scale = QSCALE; g.dkind = 1; g.dst = P.ws + WS_QC; g.ld = 8; g.idx = gi; return g; }
    gi -= 8;
    if (gi < 12) {
        const int which = gi >> 1, hh = gi & 1;
        g.col = 512 + 128 * which + 64 * hh; g.dkind = (which < 2) ? 1 : ((which & 1) ? 4 : 3); g.ld = 2; g.idx = hh;
        g.dst = P.ws + (which == 0 ? WS_KCR : which == 1 ? WS_VCR : which == 2 ? WS_KS : which == 3 ? WS_VS : which == 4 ? WS_KW : WS_VW);
        if (which == 2) { g.type = 2; g.gain = P.c_knorm_slc_g; } else if (which == 4) { g.type = 2; g.gain = P.c_knorm_win_g; } else g.type = 0;
        return g;
    }
    gi -= 12;
    if (gi < 1) { g.col = 1280; g.width = 24; g.type = 3; g.dkind = 2; g.dst = P.ws + WS_GT; g.ld = 32; g.idx = 0; return g; }
    gi -= 1;
    if (gi < 8) { g.col = 1304 + 64 * gi; g.type = 1; g.dkind = 0; g.dst = P.ws + WS_ZC; g.ld = 512; g.idx = gi; return g; }
    gi -= 8;
    if (gi < 8) { g.col = 1816 + 64 * gi; g.type = 2; g.gain = P.d_qnorm_g; g.scale = QSCALE; g.dkind = 1; g.dst = P.ws + WS_QD; g.ld = 8; g.idx = gi; return g; }
    gi -= 8;
    if (gi < 2) { g.col = 2328 + 64 * gi; g.type = 2; g.gain = P.d_knorm_g; g.dkind = 3; g.dst = P.ws + WS_KD; g.ld = 2; g.idx = gi; return g; }
    gi -= 2;
    if (gi < 2) { g.col = 2456 + 64 * gi; g.type = 0; g.dkind = 4; g.dst = P.ws + WS_VD; g.ld = 2; g.idx = gi; return g; }
    gi -= 2;
    g.col = 2584 + 64 * gi; g.type = 1; g.dkind = 0; g.dst = P.ws + WS_ZD; g.ld = 512; g.idx = gi; return g;
}
namespace pg8 {
#define PG8_LAS __attribute__((address_space(3)))
typedef short bf16x8 __attribute__((ext_vector_type(8)));
typedef float f32x4 __attribute__((ext_vector_type(4)));
typedef unsigned u32x4 __attribute__((ext_vector_type(4)));
constexpr int BM = 256, BK = 64, HALF = 128, HTB = HALF * BK * 2  , STAGE_BYTES = 8 * HTB, NXCD = 8, WGM = 8;

__host__ __device__ __forceinline__ int lds_byte(int r, int c) { const int st = (r >> 4) * 2 + (c >> 5), rr = r & 15, cc = c & 31, ob = rr * 64 + cc * 2; return st * 1024 + (ob ^ (((ob >> 9) & 1) << 5)); }
__host__ __device__ __forceinline__ void stage_rc(int b, int& R, int& C) { const int st = b / 1024, sb = b % 1024, swz = sb ^ (((sb >> 9) & 1) << 5); R = (st >> 1) * 16 + swz / 64; C = (st & 1) * 32 + (swz % 64) / 2; }
__host__ __device__ __forceinline__ int perm32(int rho) { const int n = rho >> 4, i = rho & 15; return 8 * (i >> 2) + 4 * n + (i & 3); }

struct Unit { int pm, pn; };
struct Gemm { const bf16_t* A; const bf16_t* Bt; int M, N, K; };

struct StaticOrder {
    int nM, nN, nwg, G, c;
    __host__ __device__ void init(int M, int N, int G_, int c_) { nM = M / BM; nN = N / BM; nwg = nM * nN; G = G_; c = c_; }
    __host__ __device__ bool next(int i, Unit& u) const {
        const long L = (long)i * G + c; if (L >= nwg) return false;
        int wgid = (int)L; { const int q = nwg / NXCD, r = nwg % NXCD, xcd = wgid % NXCD, off = wgid / NXCD; wgid = (xcd < r ? xcd * (q + 1) : r * (q + 1) + (xcd - r) * q) + off; }
        const int nig = WGM * nN, gid = wgid / nig, fm = gid * WGM, gsz = (nM - fm) < WGM ? (nM - fm) : WGM;
        u.pm = fm + ((wgid % nig) % gsz); u.pn = (wgid % nig) / gsz; return true;
    }
    __device__ __forceinline__ void a_ready(const Unit&) const {}
    __device__ __forceinline__ void done(const Unit&) const {}
};

__device__ __forceinline__ unsigned cvt_pk_bf16(float lo, float hi) { unsigned r; asm volatile("v_cvt_pk_bf16_f32 %0, %1, %2" : "=v"(r) : "v"(lo), "v"(hi)); return r; }
template <class Epi, class Sched, bool ALIGN_EPI = false, bool SP2 = false>
__device__ __forceinline__ void gemm_phase(PG8_LAS unsigned char* lds, const Gemm g, const Sched& S, const Epi& E) {
    const int tid = threadIdx.x, wid = __builtin_amdgcn_readfirstlane(tid >> 6), lane = tid & 63, wr = wid >> 2, wc = wid & 3, fr = lane & 15, fq = lane >> 4;
    const int K = g.K, nt = K / BK;
    unsigned voffA[2], voffB[2];
#pragma unroll
    for (int i = 0; i < 2; ++i) { int R, C; stage_rc(tid * 16 + i * 8192, R, C); const int Rb = Epi::PERM ? ((R & ~31) + perm32(R & 31)) : R;
        voffA[i] = (unsigned)(R * K + C) * 2u; voffB[i] = (unsigned)(Rb * K + C) * 2u; }
    const size_t kstep = (size_t)(BK * 2);
    const size_t hstep = (size_t)HALF * K * 2;
    const size_t tstep = 2 * hstep;
    const unsigned ldsw = (unsigned)wid * 1024u;
    const int aoff = lds_byte(wr * 64 + fr, fq * 8), boff = lds_byte(wc * 32 + fr, fq * 8);
#define PG8_SA(b, h) (((b) * 2 + (h)) * HTB)
#define PG8_SB(b, h) ((4 + (b) * 2 + (h)) * HTB)
#define PG8_STAGE(bufoff, gbase, voff) do { _Pragma("unroll") for (int _i = 0; _i < 2; ++_i) \
        __builtin_amdgcn_global_load_lds((const unsigned*)((const char*)(gbase) + (voff)[_i]), (PG8_LAS unsigned*)(lds + (bufoff) + ldsw + _i * 8192), 16, 0, 0); } while (0)
#define PG8_LDA(dst, b, h) do { _Pragma("unroll") for (int m = 0; m < 4; ++m) _Pragma("unroll") for (int k = 0; k < 2; ++k) dst[m][k] = *(const PG8_LAS bf16x8*)(lds + PG8_SA(b, h) + aoff + m * 2048 + k * 1024); } while (0)
#define PG8_LDB(dst, b, h) do { _Pragma("unroll") for (int n = 0; n < 2; ++n) _Pragma("unroll") for (int k = 0; k < 2; ++k) dst[n][k] = *(const PG8_LAS bf16x8*)(lds + PG8_SB(b, h) + boff + n * 2048 + k * 1024); } while (0)
#define PG8_MMA(ai, bj, At, Bt) do { __builtin_amdgcn_s_setprio(1); _Pragma("unroll") for (int m = 0; m < 4; ++m) _Pragma("unroll") for (int n = 0; n < 2; ++n) _Pragma("unroll") for (int k = 0; k < 2; ++k) \
        acc[ai][bj][m][n] = __builtin_amdgcn_mfma_f32_16x16x32_bf16(Bt[n][k], At[m][k], acc[ai][bj][m][n], 0, 0, 0); __builtin_amdgcn_s_setprio(0); } while (0)
#define PG8_WAIT_V(n) asm volatile("s_waitcnt vmcnt(" #n ")" ::: "memory")
#define PG8_WAIT_L(n) asm volatile("s_waitcnt lgkmcnt(" #n ")" ::: "memory")
#define PG8_BAR __builtin_amdgcn_s_barrier()
#define PG8_SCHED __builtin_amdgcn_sched_barrier(0)
    Unit cur, nxt; int ui = 0;
    if (!S.next(0, cur)) return;
    f32x4 acc[2][2][4][2];
#pragma unroll
    for (int a = 0; a < 2; ++a)
#pragma unroll
        for (int b = 0; b < 2; ++b)
#pragma unroll
            for (int m = 0; m < 4; ++m)
#pragma unroll
                for (int n = 0; n < 2; ++n) acc[a][b][m][n] = (f32x4){0.f, 0.f, 0.f, 0.f};
    bf16x8 At[4][2], B0[2][2], B1[2][2];
    const char* cA = (const char*)g.A + (size_t)cur.pm * tstep; const char* cB = (const char*)g.Bt + (size_t)cur.pn * tstep;
    S.a_ready(cur);
    if constexpr (SP2) {
        PG8_STAGE(PG8_SB(0, 0), cB, voffB); PG8_STAGE(PG8_SB(0, 1), cB + hstep, voffB); PG8_STAGE(PG8_SA(0, 0), cA, voffA); PG8_STAGE(PG8_SA(0, 1), cA + hstep, voffA);
        if (wr == 1) PG8_BAR;
        PG8_WAIT_V(2); PG8_BAR;
        PG8_STAGE(PG8_SB(1, 0), cB + kstep, voffB); PG8_STAGE(PG8_SA(1, 0), cA + kstep, voffA); PG8_STAGE(PG8_SB(1, 1), cB + hstep + kstep, voffB);
        PG8_WAIT_V(6); PG8_BAR;
    } else {
        PG8_STAGE(PG8_SB(0, 0), cB, voffB); PG8_STAGE(PG8_SA(0, 0), cA, voffA); PG8_STAGE(PG8_SB(0, 1), cB + hstep, voffB); PG8_STAGE(PG8_SA(0, 1), cA + hstep, voffA);
        if (wr == 1) PG8_BAR;
        PG8_WAIT_V(4); PG8_BAR;
        PG8_STAGE(PG8_SB(1, 0), cB + kstep, voffB); PG8_STAGE(PG8_SA(1, 0), cA + kstep, voffA); PG8_STAGE(PG8_SB(1, 1), cB + hstep + kstep, voffB);
        PG8_WAIT_V(6); PG8_BAR;
    }
    for (;;) {
        const bool has_next = S.next(ui + 1, nxt);
        const char* nA = has_next ? (const char*)g.A + (size_t)nxt.pm * tstep : cA; const char* nB = has_next ? (const char*)g.Bt + (size_t)nxt.pn * tstep : cB;
        for (int t = 0; t < nt; t += 2) {
            const bool last = (t == nt - 2);
            const char* a1 = cA + (size_t)(t + 1) * kstep;
            const char* a2 = last ? nA : cA + (size_t)(t + 2) * kstep; const char* b2 = last ? nB : cB + (size_t)(t + 2) * kstep;
            const char* a3 = a2 + kstep; const char* b3 = b2 + kstep;
            if (last && has_next) S.a_ready(nxt);
            if constexpr (SP2) {
            PG8_LDB(B0, 0, 0); PG8_LDB(B1, 0, 1); PG8_SCHED; PG8_LDA(At, 0, 0); PG8_STAGE(PG8_SA(1, 1), a1 + hstep, voffA);
            PG8_WAIT_V(8); PG8_WAIT_L(0); PG8_BAR; PG8_MMA(0, 0, At, B0); PG8_MMA(0, 1, At, B1); PG8_BAR; PG8_SCHED;
            PG8_LDA(At, 0, 1); PG8_STAGE(PG8_SB(0, 0), b2, voffB); PG8_STAGE(PG8_SB(0, 1), b2 + hstep, voffB); PG8_STAGE(PG8_SA(0, 0), a2, voffA);
            PG8_WAIT_V(8); PG8_WAIT_L(0); PG8_BAR; PG8_MMA(1, 0, At, B0); PG8_MMA(1, 1, At, B1); PG8_BAR; PG8_SCHED;
            PG8_LDB(B0, 1, 0); PG8_LDB(B1, 1, 1); PG8_SCHED; PG8_LDA(At, 1, 0); PG8_STAGE(PG8_SA(0, 1), a2 + hstep, voffA);
            PG8_WAIT_V(8); PG8_WAIT_L(0); PG8_BAR; PG8_MMA(0, 0, At, B0); PG8_MMA(0, 1, At, B1); PG8_BAR; PG8_SCHED;
            PG8_LDA(At, 1, 1); PG8_STAGE(PG8_SB(1, 0), b3, voffB); PG8_STAGE(PG8_SB(1, 1), b3 + hstep, voffB); PG8_STAGE(PG8_SA(1, 0), a3, voffA);
            PG8_WAIT_V(8); PG8_WAIT_L(0); PG8_BAR; PG8_MMA(1, 0, At, B0); PG8_MMA(1, 1, At, B1); PG8_BAR; PG8_SCHED;
            } else {
            PG8_LDB(B0, 0, 0); PG8_SCHED; PG8_LDA(At, 0, 0); PG8_STAGE(PG8_SA(1, 1), a1 + hstep, voffA);
            PG8_WAIT_L(8); PG8_BAR; PG8_WAIT_L(0); PG8_MMA(0, 0, At, B0); PG8_BAR; PG8_SCHED;
            PG8_LDB(B1, 0, 1); PG8_STAGE(PG8_SB(0, 0), b2, voffB);
            PG8_BAR; PG8_WAIT_L(0); PG8_MMA(0, 1, At, B1); PG8_BAR;
            PG8_LDA(At, 0, 1); PG8_STAGE(PG8_SA(0, 0), a2, voffA);
            PG8_BAR; PG8_WAIT_L(0); PG8_MMA(1, 0, At, B0); PG8_BAR; PG8_SCHED;
            PG8_STAGE(PG8_SB(0, 1), b2 + hstep, voffB);
            PG8_WAIT_V(6); PG8_BAR; PG8_MMA(1, 1, At, B1); PG8_BAR;
            PG8_LDB(B0, 1, 0); PG8_SCHED; PG8_LDA(At, 1, 0); PG8_STAGE(PG8_SA(0, 1), a2 + hstep, voffA);
            PG8_WAIT_L(8); PG8_BAR; PG8_WAIT_L(0); PG8_MMA(0, 0, At, B0); PG8_BAR; PG8_SCHED;
            PG8_LDB(B1, 1, 1); PG8_STAGE(PG8_SB(1, 0), b3, voffB);
            PG8_BAR; PG8_WAIT_L(0); PG8_MMA(0, 1, At, B1); PG8_BAR;
            PG8_LDA(At, 1, 1); PG8_STAGE(PG8_SA(1, 0), a3, voffA);
            PG8_BAR; PG8_WAIT_L(0); PG8_MMA(1, 0, At, B0); PG8_BAR; PG8_SCHED;
            PG8_STAGE(PG8_SB(1, 1), b3 + hstep, voffB);
            PG8_WAIT_V(6); PG8_BAR; PG8_MMA(1, 1, At, B1); PG8_BAR;
            }
        }
        if constexpr (ALIGN_EPI) { if (wr == 0) PG8_BAR; }
        if constexpr (!Epi::AFTER_DRAIN) { E(acc, cur, wr, wc, fr, fq); S.done(cur); }
        if (!has_next) break;
#pragma unroll
        for (int a = 0; a < 2; ++a)
#pragma unroll
            for (int b = 0; b < 2; ++b)
#pragma unroll
                for (int m = 0; m < 4; ++m)
#pragma unroll
                    for (int n = 0; n < 2; ++n) acc[a][b][m][n] = (f32x4){0.f, 0.f, 0.f, 0.f};
        cur = nxt; cA = nA; cB = nB; ++ui;
        if constexpr (ALIGN_EPI) { if (wr == 1) PG8_BAR; }
    }
    PG8_WAIT_V(0);
    if constexpr (!ALIGN_EPI) { if (wr == 0) PG8_BAR; }
    PG8_BAR;
    if constexpr (Epi::AFTER_DRAIN) { E.fused(acc, cur, wr, wc, fr, fq, lds, wid, lane); S.done(cur); }
#undef PG8_SA
#undef PG8_SB
#undef PG8_STAGE
#undef PG8_LDA
#undef PG8_LDB
#undef PG8_MMA
#undef PG8_WAIT_V
#undef PG8_WAIT_L
#undef PG8_BAR
#undef PG8_SCHED
}
}
#define GAS __attribute__((address_space(1)))
#define LAS __attribute__((address_space(3)))
typedef unsigned v4u __attribute__((ext_vector_type(4)));
typedef float f32x4 __attribute__((ext_vector_type(4)));
typedef short bf16x8 __attribute__((ext_vector_type(8)));
typedef GAS unsigned gu32;
typedef GAS unsigned long long gu64;
#define RLX_AGENT __ATOMIC_RELAXED, __HIP_MEMORY_SCOPE_AGENT
#define LDS_WAIT() asm volatile("s_waitcnt lgkmcnt(0)" ::: "memory")
#define VM_WAIT() asm volatile("s_waitcnt vmcnt(0)" ::: "memory")
__device__ __forceinline__ unsigned long long rt() { return __builtin_amdgcn_s_memrealtime(); }

#define XB_TMO      128
#define XB_XCNT(j)  (256  + 64 * (j))
#define XB_XSUB(j)  (1280 + 64 * (j))
#define XB_XGEN(j)  (2304 + 64 * (j))
#define XB_TOP      3328
#define XB_TOPGEN   3392
#define XCD_BAR_WORDS 3456
#define XB_SPIN_CAP (1u << 18)

__device__ __forceinline__ unsigned xb_ld(unsigned* p)              { return __hip_atomic_load(p, __ATOMIC_RELAXED, __HIP_MEMORY_SCOPE_AGENT); }
__device__ __forceinline__ unsigned xb_add(unsigned* p, unsigned v) { return __hip_atomic_fetch_add(p, v, __ATOMIC_RELAXED, __HIP_MEMORY_SCOPE_AGENT); }
__device__ __forceinline__ unsigned xb_xcc_id() { return (unsigned)__builtin_amdgcn_s_getreg((3 << 11) | 20) & 0xFu; }
#define XB_SPIN(cond, bar) do { unsigned _sp = 0; while (cond) { __builtin_amdgcn_s_sleep(1); \
    if ((++_sp & 255u) == 0u) { if (xb_ld(&(bar)[XB_TMO])) break; if (_sp > XB_SPIN_CAP) { atomicAdd(&(bar)[XB_TMO], 1u); break; } } } } while (0)

struct XcdBarrier {
    unsigned* bar; unsigned x;
    volatile LAS unsigned* st;
};

__device__ __forceinline__ XcdBarrier xcd_barrier_post(unsigned* bar, volatile LAS unsigned* st) {
    XcdBarrier b; b.bar = bar; b.x = xb_xcc_id(); b.st = st;
    if (threadIdx.x == 0) (void)xb_add(&bar[XB_XCNT(b.x)], 1u);
    return b;
}
__device__ __forceinline__ void xcd_barrier_complete(unsigned* bar, unsigned x, unsigned& nloc, unsigned& nx) {
    const unsigned G = gridDim.x * gridDim.y * gridDim.z;
    unsigned sum, cnt, mine, sp = 0u;
    for (;;) {
        sum = 0u; cnt = 0u; mine = 0u;
#pragma unroll
        for (unsigned j = 0; j < 16; ++j) { const unsigned c = xb_ld(&bar[XB_XCNT(j)]); sum += c; cnt += (c > 0u) ? 1u : 0u; mine = (j == x) ? c : mine; }
        if (sum == G) break;
        __builtin_amdgcn_s_sleep(1);
        if ((++sp & 255u) == 0u) { if (xb_ld(&bar[XB_TMO])) break; if (sp > XB_SPIN_CAP) { atomicAdd(&bar[XB_TMO], 1u); break; } }
    }
    nloc = mine > 0u ? mine : 1u; nx = cnt > 0u ? cnt : 1u;
}

__device__ __forceinline__ void xcd_barrier(const XcdBarrier& b) {
    asm volatile("s_waitcnt vmcnt(0)" ::: "memory");
    __syncthreads();
    if (threadIdx.x == 0) {
        unsigned* bar = b.bar;
        __builtin_amdgcn_s_waitcnt(0);
        unsigned nloc = b.st[0], nx = b.st[1];
        if (nloc == 0u) { xcd_barrier_complete(bar, b.x, nloc, nx); b.st[0] = nloc; b.st[1] = nx; }
        const unsigned old = xb_add(&bar[XB_XSUB(b.x)], 1u);
        const unsigned gen = old / nloc;
        if (old + 1u == (gen + 1u) * nloc) {
            __builtin_amdgcn_fence(__ATOMIC_RELEASE, "agent");
            asm volatile("s_waitcnt vmcnt(0)" ::: "memory");
            const unsigned og = xb_add(&bar[XB_TOP], 1u);
            const unsigned tg = og / nx;
            if (og + 1u == (tg + 1u) * nx) xb_add(&bar[XB_TOPGEN], 1u);
            else XB_SPIN(xb_ld(&bar[XB_TOPGEN]) == tg, bar);
            __builtin_amdgcn_fence(__ATOMIC_ACQUIRE, "agent");
            xb_add(&bar[XB_XGEN(b.x)], 1u);
            asm volatile("s_waitcnt vmcnt(0)" ::: "memory");
        } else {
            XB_SPIN(xb_ld(&bar[XB_XGEN(b.x)]) == gen, bar);
            __builtin_amdgcn_fence(__ATOMIC_ACQUIRE, "agent");
            asm volatile("s_waitcnt vmcnt(0)" ::: "memory");
        }
    }
    __syncthreads();
}

namespace fa {
typedef short bf16x8 __attribute__((ext_vector_type(8)));
typedef short s16x4 __attribute__((ext_vector_type(4)));
typedef float f32x16 __attribute__((ext_vector_type(16)));
typedef unsigned u32x4 __attribute__((ext_vector_type(4)));
typedef short v4i16_t __attribute__((ext_vector_type(4)));
typedef __attribute__((address_space(3))) const char* lds_cptr;
typedef __attribute__((address_space(3))) char* lds_ptr;

constexpr int NSLOT = 3, SLOTB = 8192;
constexpr int LDS_K = 0, LDS_V = NSLOT * SLOTB;
constexpr int LDS_IMP = 2 * NSLOT * SLOTB;
constexpr int LDS_IMPT = LDS_IMP + 4 * 64 * 33 * 4;
constexpr int LDS_SEL = 131072 - 256;
constexpr int LDS_OT = LDS_IMP;
static_assert(LDS_OT + 65536 <= LDS_SEL && LDS_IMPT + 64 * 33 * 4 <= LDS_SEL, "attention LDS map");

#define FA_NEG (-__builtin_inff())
__device__ __forceinline__ void glds16(const void* gsrc, unsigned lds_dst) { unsigned keep;
    asm volatile("s_mov_b32 %0, m0\n\ts_mov_b32 m0, %2\n\ts_nop 0\n\tglobal_load_lds_dwordx4 %1, off\n\ts_mov_b32 m0, %0" : "=&s"(keep) : "v"(gsrc), "s"(lds_dst) : "memory"); }
#define FA_WAIT_BAR(N) asm volatile("s_waitcnt vmcnt(" #N ") lgkmcnt(0)\n\ts_barrier" ::: "memory")
__device__ __forceinline__ s16x4 vtr(lds_cptr p) { return __builtin_bit_cast(s16x4, __builtin_amdgcn_ds_read_tr16_b64_v4i16((__attribute__((address_space(3))) v4i16_t*)p)); }
typedef float f32x2_t __attribute__((ext_vector_type(2))); typedef __bf16 bf16x2_t __attribute__((ext_vector_type(2)));
__device__ __forceinline__ unsigned cvtpk(float lo, float hi) { f32x2_t v = {lo, hi}; bf16x2_t b = __builtin_convertvector(v, bf16x2_t); return __builtin_bit_cast(unsigned, b); }

__device__ __forceinline__ unsigned char* launder(unsigned char* p) { asm volatile("" : "+s"(p)); return p; }
struct RowCtx {
    int hiAbs, loAbs;
    unsigned selmask; int selshift;
    float sk, lb;
};

__device__ __forceinline__ void qk_scores(lds_cptr kslot, int j, const bf16x8 (&qr)[4], const RowCtx& rc, int r32, int hi, int hk, int lk, bool rowok, f32x16& p0, f32x16& p1) {
    const float lbj = rc.sk * (float)(64 * j + 4 * hi) + rc.lb;
#pragma unroll
    for (int r = 0; r < 16; ++r) { const float c = (float)((r & 3) + 8 * (r >> 2)); p0[r] = __builtin_fmaf(rc.sk, c, lbj); p1[r] = __builtin_fmaf(rc.sk, c + 32.f, lbj); }
    const lds_cptr kp = kslot + hi * 1024 + r32 * 16;
#pragma unroll
    for (int d0 = 0; d0 < 4; ++d0) {
        const bf16x8 b0 = *(const __attribute__((address_space(3))) bf16x8*)(kp + d0 * 2048);
        const bf16x8 b1 = *(const __attribute__((address_space(3))) bf16x8*)(kp + d0 * 2048 + 512);
        p0 = __builtin_amdgcn_mfma_f32_32x32x16_bf16(b0, qr[d0], p0, 0, 0, 0);
        p1 = __builtin_amdgcn_mfma_f32_32x32x16_bf16(b1, qr[d0], p1, 0, 0, 0);
    }
    const bool full = (lk <= 0) && (hk >= 63);
    if (!__all(full)) {
        const int a = lk - 4 * hi, b = hk - 4 * hi;
#pragma unroll
        for (int r = 0; r < 16; ++r) { const int c = (r & 3) + 8 * (r >> 2);
            p0[r] = (c >= a && c <= b) ? p0[r] : FA_NEG; p1[r] = (c + 32 >= a && c + 32 <= b) ? p1[r] : FA_NEG; }
    }
    if (!__all(rowok)) {
#pragma unroll
        for (int r = 0; r < 16; ++r) { p0[r] = rowok ? p0[r] : FA_NEG; p1[r] = rowok ? p1[r] : FA_NEG; }
    }
}
__device__ __forceinline__ void pv_accum(lds_cptr vslot, const f32x16& p0, const f32x16& p1, int lane, int hi, f32x16 (&o)[2]) {
    u32x4 pw[4];
    pw[0] = (u32x4){cvtpk(p0[0], p0[1]), cvtpk(p0[2], p0[3]), cvtpk(p0[4], p0[5]), cvtpk(p0[6], p0[7])};
    pw[1] = (u32x4){cvtpk(p0[8], p0[9]), cvtpk(p0[10], p0[11]), cvtpk(p0[12], p0[13]), cvtpk(p0[14], p0[15])};
    pw[2] = (u32x4){cvtpk(p1[0], p1[1]), cvtpk(p1[2], p1[3]), cvtpk(p1[4], p1[5]), cvtpk(p1[6], p1[7])};
    pw[3] = (u32x4){cvtpk(p1[8], p1[9]), cvtpk(p1[10], p1[11]), cvtpk(p1[12], p1[13]), cvtpk(p1[14], p1[15])};
    const lds_cptr vp = vslot + ((lane >> 4) & 1) * 32 + (lane & 3) * 8 + (4 * hi + ((lane & 15) >> 2)) * 64;
#pragma unroll
    for (int d0 = 0; d0 < 2; ++d0)
#pragma unroll
        for (int ks = 0; ks < 4; ++ks) {
            const s16x4 lo = vtr(vp + d0 * 4096 + ks * 1024), hh = vtr(vp + d0 * 4096 + ks * 1024 + 512);
            const bf16x8 vf = (bf16x8){lo[0], lo[1], lo[2], lo[3], hh[0], hh[1], hh[2], hh[3]};
            o[d0] = __builtin_amdgcn_mfma_f32_32x32x16_bf16(vf, __builtin_bit_cast(bf16x8, pw[ks]), o[d0], 0, 0, 0);
        }
}
__device__ __forceinline__ float rowmax32(const f32x16& p0, const f32x16& p1) {
    float a = __builtin_fmaxf(p0[0], p1[0]);
#pragma unroll
    for (int r = 1; r < 16; ++r) a = __builtin_fmaxf(a, __builtin_fmaxf(p0[r], p1[r]));
    return __builtin_fmaxf(a, __shfl_xor(a, 32));
}


struct RowCtx2 { int hiAbs, loAbs; unsigned selmask; int selshift; float slope2; int kp_mul, kp_off; };
#define FA_THR 16.0f
__device__ __forceinline__ void attn_prefetch(lds_ptr ring, const bf16_t* Kb, const bf16_t* Vb, int jlo, int nt, int wid, int lane, bool withV) {
    if (nt <= 0) return;
    const unsigned lds0 = (unsigned)(uintptr_t)ring;
    const bf16_t* ksrc = Kb + wid * 512 + lane * 8 + (size_t)jlo * 4096;
    glds16(ksrc, (unsigned)__builtin_amdgcn_readfirstlane(lds0 + LDS_K + wid * 1024));
    if (nt > 1) glds16(ksrc + 4096, (unsigned)__builtin_amdgcn_readfirstlane(lds0 + LDS_K + SLOTB + wid * 1024));
    if (withV) { const bf16_t* vsrc = Vb + wid * 512 + lane * 8 + (size_t)jlo * 4096;
        glds16(vsrc, (unsigned)__builtin_amdgcn_readfirstlane(lds0 + LDS_V + wid * 1024)); }
}
#define FA_SBAR() __builtin_amdgcn_sched_barrier(0)
__device__ __forceinline__ void attn_stream2(lds_ptr ring, const bf16_t* Kb, const bf16_t* Vb, int jlo, int jhi, const bf16x8 (&qr)[4], const RowCtx2& rc, int wid, int lane,
                                             float& m, float& l, f32x16 (&o)[2], bool chk, int pre = 0, const bf16_t* Knext = nullptr, int jlo_next = 0, int nt_next = 0, const bf16_t* zrow = nullptr, uint2* zreg = nullptr) {
    const int nt = jhi - jlo;
    if (nt <= 0) { if (Knext) attn_prefetch(ring, Knext, nullptr, jlo_next, nt_next, wid, lane, false); return; }
    const int r32 = lane & 31, hi = lane >> 5;
    const unsigned lds0 = (unsigned)(uintptr_t)ring;
    const bf16_t* ksrc = Kb + wid * 512 + lane * 8;
    const bf16_t* vsrc = Vb + wid * 512 + lane * 8;
    const unsigned kdst = lds0 + LDS_K + wid * 1024, vdst = lds0 + LDS_V + wid * 1024;
#define FA_DMAK(j_, so_) glds16(ksrc + (size_t)(j_) * 4096, (unsigned)__builtin_amdgcn_readfirstlane(kdst + (so_)))
#define FA_DMAV(j_, so_) glds16(vsrc + (size_t)(j_) * 4096, (unsigned)__builtin_amdgcn_readfirstlane(vdst + (so_)))
    if (pre == 0) { FA_DMAK(jlo, 0); if (nt > 1) FA_DMAK(jlo + 1, SLOTB); }
    if (pre < 2) FA_DMAV(jlo, 0);
    const lds_cptr kbase = (lds_cptr)ring + LDS_K + hi * 1024 + r32 * 16;
    const lds_cptr vbase = (lds_cptr)ring + LDS_V + ((lane >> 4) & 1) * 32 + (lane & 3) * 8 + (4 * hi + ((lane & 15) >> 2)) * 64;
    const float skm = rc.slope2 * (float)rc.kp_mul;
    u32x4 pw[4];
    bool prev = false;
    int s_k = 0, s_vprev = 2 * SLOTB, s_knn = 2 * SLOTB, s_vn = SLOTB;
#define FA_NEXT(x) ((x) == (NSLOT - 1) * SLOTB ? 0 : (x) + SLOTB)
#define FA_VREADS(vf, so_) do { _Pragma("unroll") for (int d0_ = 0; d0_ < 2; ++d0_) _Pragma("unroll") for (int ks_ = 0; ks_ < 4; ++ks_) { \
        const s16x4 lo_ = vtr(vbase + (so_) + d0_ * 4096 + ks_ * 1024), hh_ = vtr(vbase + (so_) + d0_ * 4096 + ks_ * 1024 + 512); \
        vf[d0_ * 4 + ks_] = (bf16x8){lo_[0], lo_[1], lo_[2], lo_[3], hh_[0], hh_[1], hh_[2], hh_[3]}; } } while (0)
#define FA_PV(vf, pw) do { _Pragma("unroll") for (int d0_ = 0; d0_ < 2; ++d0_) _Pragma("unroll") for (int ks_ = 0; ks_ < 4; ++ks_) \
        o[d0_] = __builtin_amdgcn_mfma_f32_32x32x16_bf16(vf[d0_ * 4 + ks_], __builtin_bit_cast(bf16x8, pw[ks_]), o[d0_], 0, 0, 0); } while (0)
    for (int i = 0; i < nt; ++i) {
        if (i + 1 < nt) FA_WAIT_BAR(2); else FA_WAIT_BAR(1);
        if (i + 2 < nt) FA_DMAK(jlo + i + 2, s_knn);
        if (i + 1 < nt) FA_DMAV(jlo + i + 1, s_vn);
        const int j = jlo + i;
        int hk = rc.hiAbs - 64 * j; hk = hk > 63 ? 63 : hk;
        int lk = rc.loAbs - 64 * j; lk = lk < 0 ? 0 : lk;
        const bool rowok = ((rc.selmask >> (j >> rc.selshift)) & 1u) != 0u;
        const bool cur = __any(rowok && lk <= hk) != 0;
        bf16x8 kf[8], vf[8];
        if (cur) {
#pragma unroll
            for (int d0 = 0; d0 < 4; ++d0) { kf[2 * d0] = *(const __attribute__((address_space(3))) bf16x8*)(kbase + s_k + d0 * 2048); kf[2 * d0 + 1] = *(const __attribute__((address_space(3))) bf16x8*)(kbase + s_k + d0 * 2048 + 512); }
        }
        if (prev) FA_VREADS(vf, s_vprev);
        f32x16 s0, s1;
        if (cur) {
            const float lbj = rowok ? rc.slope2 * (float)(rc.kp_mul * (64 * j + 4 * hi) + rc.kp_off) - m : FA_NEG;
#pragma unroll
            for (int r = 0; r < 16; ++r) { const float c = (float)((r & 3) + 8 * (r >> 2)); s0[r] = __builtin_fmaf(skm, c, lbj); s1[r] = __builtin_fmaf(skm, c + 32.f, lbj); }
        }
        FA_SBAR();
        __builtin_amdgcn_s_setprio(1);
        if (cur) {
#pragma unroll
            for (int d0 = 0; d0 < 4; ++d0) { s0 = __builtin_amdgcn_mfma_f32_32x32x16_bf16(kf[2 * d0], qr[d0], s0, 0, 0, 0); s1 = __builtin_amdgcn_mfma_f32_32x32x16_bf16(kf[2 * d0 + 1], qr[d0], s1, 0, 0, 0); }
        }
        if (prev) FA_PV(vf, pw);
        __builtin_amdgcn_s_setprio(0);
        FA_SBAR();
        if (cur) {
            const bool full = (lk <= 0) && (hk >= 63);
            if (!__all(full)) {
                const int a = lk - 4 * hi, b = hk - 4 * hi;
#pragma unroll
                for (int r = 0; r < 16; ++r) { const int c = (r & 3) + 8 * (r >> 2);
                    s0[r] = (c >= a && c <= b) ? s0[r] : FA_NEG; s1[r] = (c + 32 >= a && c + 32 <= b) ? s1[r] : FA_NEG; }
            }
            if (chk) {
            float mx = __builtin_fmaxf(s0[0], s1[0]);
#pragma unroll
            for (int r = 1; r < 16; ++r) mx = __builtin_fmaxf(mx, __builtin_fmaxf(s0[r], s1[r]));
            if (__any(mx > FA_THR)) {
                mx = __builtin_fmaxf(mx, __shfl_xor(mx, 32));
                const float dl = __builtin_fmaxf(mx, 0.f), f = __builtin_amdgcn_exp2f(-dl);
                m += dl; l *= f;
#pragma unroll
                for (int r = 0; r < 16; ++r) { s0[r] -= dl; s1[r] -= dl; o[0][r] *= f; o[1][r] *= f; }
            }
            }
            float sum_ = 0.f;
#pragma unroll
            for (int r = 0; r < 16; ++r) { s0[r] = __builtin_amdgcn_exp2f(s0[r]); s1[r] = __builtin_amdgcn_exp2f(s1[r]); sum_ += s0[r] + s1[r]; }
            l += sum_;
            pw[0] = (u32x4){cvtpk(s0[0], s0[1]), cvtpk(s0[2], s0[3]), cvtpk(s0[4], s0[5]), cvtpk(s0[6], s0[7])}; pw[1] = (u32x4){cvtpk(s0[8], s0[9]), cvtpk(s0[10], s0[11]), cvtpk(s0[12], s0[13]), cvtpk(s0[14], s0[15])};
            pw[2] = (u32x4){cvtpk(s1[0], s1[1]), cvtpk(s1[2], s1[3]), cvtpk(s1[4], s1[5]), cvtpk(s1[6], s1[7])}; pw[3] = (u32x4){cvtpk(s1[8], s1[9]), cvtpk(s1[10], s1[11]), cvtpk(s1[12], s1[13]), cvtpk(s1[14], s1[15])};
        }
        prev = cur;
        s_vprev = s_k; s_k = FA_NEXT(s_k); s_knn = FA_NEXT(s_knn); s_vn = FA_NEXT(s_vn);
    }
    FA_WAIT_BAR(0);
    if (Knext) attn_prefetch(ring, Knext, nullptr, jlo_next, nt_next, wid, lane, false);
    if (zrow) {
#pragma unroll
        for (int d0 = 0; d0 < 2; ++d0)
#pragma unroll
            for (int g4 = 0; g4 < 4; ++g4) zreg[d0 * 4 + g4] = *(const uint2*)(zrow + 32 * d0 + 8 * g4 + 4 * hi);
    }
    if (prev) {
        bf16x8 vf[8];
        FA_VREADS(vf, s_vprev);
        FA_PV(vf, pw);
    }
    asm volatile("s_waitcnt lgkmcnt(0)\n\ts_barrier" ::: "memory");
#undef FA_DMAK
#undef FA_DMAV
#undef FA_NEXT
#undef FA_VREADS
#undef FA_PV
}

__device__ __forceinline__ bool need_maxcheck(const bf16x8 (&qr)[4], const float* gk, int lane, float refslack) {
    float qn = 0.f;
#pragma unroll
    for (int d0 = 0; d0 < 4; ++d0)
#pragma unroll
        for (int i = 0; i < 8; ++i) { const float v = bf2f((unsigned short)qr[d0][i]); qn += v * v; }
    qn += __shfl_xor(qn, 32);
    float gm = __builtin_fabsf(gk[lane]);
#pragma unroll
    for (int o = 1; o < 64; o <<= 1) gm = __builtin_fmaxf(gm, __shfl_xor(gm, o));
    const float bound = sqrtf(qn) * gm * 8.04f + refslack;
    return __any(!(bound <= FA_THR)) != 0;
}
__device__ __forceinline__ void store_oz(const f32x16 (&o)[2], float w, const uint2* zreg, bf16_t* Y, int t, int ycol, int hi) {
#pragma unroll
    for (int d0 = 0; d0 < 2; ++d0)
#pragma unroll
        for (int g4 = 0; g4 < 4; ++g4) {
            const int d = 32 * d0 + 8 * g4 + 4 * hi;
            const uint2 z = zreg[d0 * 4 + g4];
            const float v0 = o[d0][4 * g4 + 0] * w * bf2f(z.x & 0xffff), v1 = o[d0][4 * g4 + 1] * w * bf2f(z.x >> 16);
            const float v2 = o[d0][4 * g4 + 2] * w * bf2f(z.y & 0xffff), v3 = o[d0][4 * g4 + 3] * w * bf2f(z.y >> 16);
            uint2 y; y.x = cvtpk(v0, v1); y.y = cvtpk(v2, v3);
            *(uint2*)(Y + (size_t)t * 1024 + ycol + d) = y;
        }
}
__device__ __forceinline__ void load_q(bf16x8 (&qr)[4], const bf16_t* Qrow, int hi) {
#pragma unroll
    for (int d0 = 0; d0 < 4; ++d0) qr[d0] = *(const bf16x8*)(Qrow + d0 * 16 + hi * 8);
}

#ifdef PROBE_A
#define FA_STAMP(n) do { if (blockIdx.x == 0 && threadIdx.x == 0) ((volatile __attribute__((address_space(3))) unsigned*)(ring + 131072 + 320))[40 + (n)] = (unsigned)__builtin_amdgcn_s_memrealtime(); } while (0)
#else
#define FA_STAMP(n) do {} while (0)
#endif
__device__ __forceinline__ void moba_unit(const KArgs& P, lds_ptr ring, int b, int h, int own, int wid, int lane) {
    unsigned char* ws = launder(P.ws); asm volatile("" : "+v"(lane));
    const bf16_t* QB = (const bf16_t*)(ws + WS_QB); const bf16_t* KB = (const bf16_t*)(ws + WS_KB); const bf16_t* VB = (const bf16_t*)(ws + WS_VB);
    const float* KMP = (const float*)(ws + WS_KMP); const bf16_t* ZB = (const bf16_t*)(ws + WS_ZB); bf16_t* Y = (bf16_t*)(ws + WS_Y);
    const int r32 = lane & 31, hi = lane >> 5;
    const int sq = own * 256 + 32 * wid + r32, t = b * SEQ + sq;
    const size_t hb = (size_t)(b * 8 + h) * SEQ;
    FA_STAMP(own == 7 ? 24 : 28);
    attn_prefetch(ring, KB + hb * 64, VB + hb * 64, 0, 4 * own + 4, wid, lane, true);
    bf16x8 qr[4]; load_q(qr, QB + (hb + sq) * 64, hi);
    __attribute__((address_space(3))) float* kmS = (__attribute__((address_space(3))) float*)(ring + LDS_IMP);
    { const int tid = wid * 64 + lane, n = tid >> 6, d = tid & 63;
      const float* k0 = KMP + (size_t)(b * 8 + n) * 512 + h * 64 + d;
      kmS[tid] = k0[0] + k0[64 * 512]; }
    asm volatile("s_waitcnt vmcnt(0) lgkmcnt(0)\n\ts_barrier" ::: "memory");
    float gate[8];
#pragma unroll
    for (int n = 0; n < 8; ++n) gate[n] = -1e30f;
    if (own > 0) {
        float qf[32];
#pragma unroll
        for (int d0 = 0; d0 < 4; ++d0)
#pragma unroll
            for (int i = 0; i < 8; ++i) qf[8 * d0 + i] = bf2f((unsigned short)qr[d0][i]);
#pragma unroll
        for (int n = 0; n < 7; ++n) {
            float part = 0.f;
#pragma unroll
            for (int d0 = 0; d0 < 4; ++d0)
#pragma unroll
                for (int i = 0; i < 8; ++i) part += qf[8 * d0 + i] * kmS[n * 64 + d0 * 16 + hi * 8 + i];
            const float g = part + __shfl_xor(part, 32);
            gate[n] = n < own ? g : -1e30f;
        }
    }
    FA_STAMP(own == 7 ? 32 : 36);
    unsigned sel = 0;
#pragma unroll
    for (int it = 0; it < 3; ++it) {
        float best = -3e38f; int bi = 0;
#pragma unroll
        for (int n = 0; n < 8; ++n) { const bool ok = !((sel >> n) & 1u) && gate[n] > best; best = ok ? gate[n] : best; bi = ok ? n : bi; }
        sel |= 1u << bi;
    }
    FA_STAMP(own == 7 ? 33 : 37);
    sel &= (1u << own) - 1u;
    sel |= 1u << own;
    const float slope2 = exp2f(-(float)(h + 1)) * LOG2E;
    RowCtx2 rc; rc.hiAbs = sq; rc.loAbs = -(1 << 30); rc.selmask = sel; rc.selshift = 2; rc.slope2 = slope2; rc.kp_mul = 1; rc.kp_off = -sq;
    float m = 0.f, l = 0.f; f32x16 o[2]; uint2 zreg[8];
#pragma unroll
    for (int r = 0; r < 16; ++r) { o[0][r] = 0.f; o[1][r] = 0.f; }
    FA_STAMP(own == 7 ? 25 : 29);
    attn_stream2(ring, KB + hb * 64, VB + hb * 64, 0, 4 * own + 4, qr, rc, wid, lane, m, l, o, need_maxcheck(qr, P.b_knorm_g, lane, 0.f), 2, nullptr, 0, 0, ZB + (size_t)t * 512 + h * 64, zreg);
    FA_STAMP(own == 7 ? 26 : 30);
    l += __shfl_xor(l, 32);
    const float inv = l > 0.f ? 1.0f / l : 0.f;
    store_oz(o, inv, zreg, Y, t, 512 + h * 64, hi);
    FA_STAMP(own == 7 ? 27 : 31);
}

__device__ __forceinline__ void swa_unit(const KArgs& P, lds_ptr ring, int b, int g, int c, int wid, int lane) {
    unsigned char* ws = launder(P.ws); asm volatile("" : "+v"(lane));
    const bf16_t* QD = (const bf16_t*)(ws + WS_QD); const bf16_t* KD = (const bf16_t*)(ws + WS_KD); const bf16_t* VD = (const bf16_t*)(ws + WS_VD);
    const bf16_t* ZD = (const bf16_t*)(ws + WS_ZD); bf16_t* Y = (bf16_t*)(ws + WS_Y);
    const int r32 = lane & 31, hi = lane >> 5, h = 4 * g + (wid >> 1);
    const int sq = 64 * c + 32 * (wid & 1) + r32, t = b * SEQ + sq;
    const size_t gb = (size_t)(b * 2 + g) * SEQ * 64;
    attn_prefetch(ring, KD + gb, VD + gb, c >= 2 ? c - 2 : 0, c >= 2 ? 3 : c + 1, wid, lane, true);
    bf16x8 qr[4]; load_q(qr, QD + ((size_t)(b * 8 + h) * SEQ + sq) * 64, hi);
    const float slope2 = exp2f(-(float)(h + 1)) * LOG2E;
    RowCtx2 rc; rc.hiAbs = sq; rc.loAbs = sq - 127; rc.selmask = 0xffffffffu; rc.selshift = 0; rc.slope2 = slope2; rc.kp_mul = 1; rc.kp_off = -sq;
    float m = P.d_sinks[h] * LOG2E, l = hi == 0 ? 1.f : 0.f; f32x16 o[2]; uint2 zreg[8];
#pragma unroll
    for (int r = 0; r < 16; ++r) { o[0][r] = 0.f; o[1][r] = 0.f; }
    attn_stream2(ring, KD + gb, VD + gb, c >= 2 ? c - 2 : 0, c + 1, qr, rc, wid, lane, m, l, o, need_maxcheck(qr, P.d_knorm_g, lane, __builtin_fabsf(m)), 2, nullptr, 0, 0, ZD + (size_t)t * 512 + h * 64, zreg);
    l += __shfl_xor(l, 32);
    store_oz(o, 1.0f / l, zreg, Y, t, 512 + h * 64, hi);
}

__device__ __forceinline__ void nsa_unit(const KArgs& P, lds_ptr ring, int b, int g, int c, int wid, int lane, int tid) {
    unsigned char* ws = launder(P.ws); asm volatile("" : "+v"(lane));
    const bf16_t* QC = (const bf16_t*)(ws + WS_QC); const bf16_t* KC = (const bf16_t*)(ws + WS_KC); const bf16_t* VC = (const bf16_t*)(ws + WS_VC);
    const bf16_t* KS = (const bf16_t*)(ws + WS_KS); const bf16_t* VS = (const bf16_t*)(ws + WS_VS);
    const bf16_t* KW = (const bf16_t*)(ws + WS_KW); const bf16_t* VW = (const bf16_t*)(ws + WS_VW);
    const float* GT = (const float*)(ws + WS_GT); const bf16_t* ZC = (const bf16_t*)(ws + WS_ZC); bf16_t* Y = (bf16_t*)(ws + WS_Y);
    const int r32 = lane & 31, hi = lane >> 5, hh = wid >> 1, h = 4 * g + hh;
    const int tok = 32 * (wid & 1) + r32, sq = 64 * c + tok, t = b * SEQ + sq;
    if (c == 31) FA_STAMP(44);
    bf16x8 qr[4]; load_q(qr, QC + ((size_t)(b * 8 + h) * SEQ + sq) * 64, hi);
    const float slope2 = exp2f(-(float)(h + 1)) * LOG2E;
    const size_t gbe = (size_t)(b * 2 + g) * SEQ * 64;
    const float g0 = GT[(size_t)t * 32 + h], g1 = GT[(size_t)t * 32 + 8 + h], g2 = GT[(size_t)t * 32 + 16 + h];
    f32x16 o[2];
#pragma unroll
    for (int r = 0; r < 16; ++r) { o[0][r] = 0.f; o[1][r] = 0.f; }
    __attribute__((address_space(3))) float* otS = (__attribute__((address_space(3))) float*)(ring + LDS_OT) + wid * 2048 + lane;
    __attribute__((address_space(3))) float* impH = (__attribute__((address_space(3))) float*)(ring + LDS_IMP);
    __attribute__((address_space(3))) float* impT = (__attribute__((address_space(3))) float*)(ring + LDS_IMPT);
    __attribute__((address_space(3))) unsigned* selS = (__attribute__((address_space(3))) unsigned*)(ring + LDS_SEL);
    {
        const bf16_t* kc = KC + (size_t)(b * 2 + g) * 128 * 64; const bf16_t* vc = VC + (size_t)(b * 2 + g) * 128 * 64;
        const unsigned lds0 = (unsigned)(uintptr_t)ring;
        const bf16_t* ksrc = kc + wid * 512 + lane * 8;
        const bf16_t* vsrc = vc + wid * 512 + lane * 8;
        glds16(ksrc, (unsigned)__builtin_amdgcn_readfirstlane(lds0 + LDS_K + wid * 1024)); glds16(vsrc, (unsigned)__builtin_amdgcn_readfirstlane(lds0 + LDS_V + wid * 1024));
        glds16(ksrc + 4096, (unsigned)__builtin_amdgcn_readfirstlane(lds0 + LDS_K + SLOTB + wid * 1024)); glds16(vsrc + 4096, (unsigned)__builtin_amdgcn_readfirstlane(lds0 + LDS_V + SLOTB + wid * 1024));
        FA_WAIT_BAR(0);
        RowCtx rc; int hc = (sq - 31) >> 4; rc.hiAbs = hc > 126 ? 126 : hc; rc.loAbs = -(1 << 30); rc.selmask = 0xffffffffu; rc.selshift = 0; rc.sk = 16.f * slope2; rc.lb = slope2 * (float)(31 - 64 * c);
        f32x16 a0, a1, b0, b1;
        { int hk = rc.hiAbs; hk = hk > 63 ? 63 : hk; qk_scores((lds_cptr)ring + LDS_K, 0, qr, rc, r32, hi, hk, 0, true, a0, a1); }
        { int hk = rc.hiAbs - 64; hk = hk > 63 ? 63 : hk; qk_scores((lds_cptr)ring + LDS_K + SLOTB, 1, qr, rc, r32, hi, hk, 0, true, b0, b1); }
        float mx = __builtin_fmaxf(rowmax32(a0, a1), rowmax32(b0, b1));
        mx = mx > -1e37f ? mx : 0.f;
        float sum = 0.f;
#pragma unroll
        for (int r = 0; r < 16; ++r) { a0[r] = __builtin_amdgcn_exp2f(a0[r] - mx); a1[r] = __builtin_amdgcn_exp2f(a1[r] - mx); b0[r] = __builtin_amdgcn_exp2f(b0[r] - mx); b1[r] = __builtin_amdgcn_exp2f(b1[r] - mx);
            sum += (a0[r] + a1[r]) + (b0[r] + b1[r]); }
        sum += __shfl_xor(sum, 32);
        const float inv = sum > 0.f ? 1.0f / sum : 0.f;
#pragma unroll
        for (int r = 0; r < 16; ++r) { a0[r] *= inv; a1[r] *= inv; b0[r] *= inv; b1[r] *= inv; }
        float ss[16], ee[16];
#pragma unroll
        for (int i = 0; i < 4; ++i) {
            ss[i] = (a0[4 * i] + a0[4 * i + 1]) + (a0[4 * i + 2] + a0[4 * i + 3]); ee[i] = a0[4 * i + 3];
            ss[4 + i] = (a1[4 * i] + a1[4 * i + 1]) + (a1[4 * i + 2] + a1[4 * i + 3]); ee[4 + i] = a1[4 * i + 3];
            ss[8 + i] = (b0[4 * i] + b0[4 * i + 1]) + (b0[4 * i + 2] + b0[4 * i + 3]); ee[8 + i] = b0[4 * i + 3];
            ss[12 + i] = (b1[4 * i] + b1[4 * i + 1]) + (b1[4 * i + 2] + b1[4 * i + 3]); ee[12 + i] = b1[4 * i + 3];
        }
        float ep[16];
#pragma unroll
        for (int k = 0; k < 16; ++k) ep[k] = __shfl_xor(ee[k], 32);
#pragma unroll
        for (int k = 0; k < 16; ++k) {
            const float prev = k > 0 ? ep[k > 0 ? k - 1 : 0] : 0.f;
            const float v = ss[k] + (hi ? ep[k] : prev);
            impH[(hh * 64 + tok) * 33 + 2 * k + hi] = v;
        }
        pv_accum((lds_cptr)ring + LDS_V, a0, a1, lane, hi, o);
        pv_accum((lds_cptr)ring + LDS_V + SLOTB, b0, b1, lane, hi, o);
        asm volatile("s_waitcnt lgkmcnt(0)\n\ts_barrier" ::: "memory");
        attn_prefetch(ring, KS + gbe, VS + gbe, 0, c + 1, wid, lane, true);
        {
            const int tk = tid >> 3, part = tid & 7;
#pragma unroll
            for (int i = 0; i < 4; ++i) { const int n = 4 * part + i;
                float v = (impH[(0 * 64 + tk) * 33 + n] + impH[(1 * 64 + tk) * 33 + n]) + (impH[(2 * 64 + tk) * 33 + n] + impH[(3 * 64 + tk) * 33 + n]);
                if (n == 0 || n == c || n == c - 1) v = 1e4f;
                if (n > c) v = -1e30f;
                impT[tk * 33 + n] = v; }
            asm volatile("s_waitcnt lgkmcnt(0)\n\ts_barrier" ::: "memory");
            float mine[4]; int rank[4];
#pragma unroll
            for (int i = 0; i < 4; ++i) { mine[i] = impT[tk * 33 + 4 * part + i]; rank[i] = 0; }
#pragma unroll 1
            for (int mI = 0; mI < 32; ++mI) { const float v = impT[tk * 33 + mI];
#pragma unroll
                for (int i = 0; i < 4; ++i) rank[i] += (v > mine[i] || (v == mine[i] && mI < 4 * part + i)) ? 1 : 0; }
            unsigned bits = 0;
#pragma unroll
            for (int i = 0; i < 4; ++i) if (rank[i] < 16) bits |= 1u << (4 * part + i);
            bits |= __shfl_xor(bits, 1); bits |= __shfl_xor(bits, 2); bits |= __shfl_xor(bits, 4);
            if (part == 0) selS[tk] = bits;
            asm volatile("s_waitcnt lgkmcnt(0)\n\ts_barrier" ::: "memory");
        }
    }
    const unsigned sel = selS[tok];
    if (c == 31) FA_STAMP(45);
    const size_t gb = (size_t)(b * 2 + g) * SEQ * 64;
#pragma unroll
    for (int r = 0; r < 16; ++r) { otS[r * 64] = o[0][r] * g0; otS[(16 + r) * 64] = o[1][r] * g0; }
    {
        RowCtx2 rc; rc.hiAbs = sq; rc.loAbs = -(1 << 30); rc.selmask = sel; rc.selshift = 0; rc.slope2 = slope2; rc.kp_mul = 1; rc.kp_off = -sq;
        float m = 0.f, l = 0.f;
#pragma unroll
        for (int r = 0; r < 16; ++r) { o[0][r] = 0.f; o[1][r] = 0.f; }
        attn_stream2(ring, KS + gb, VS + gb, 0, c + 1, qr, rc, wid, lane, m, l, o, need_maxcheck(qr, P.c_knorm_slc_g, lane, 0.f), 2, KW + gb, c >= 8 ? c - 8 : 0, c >= 8 ? 9 : c + 1);
        l += __shfl_xor(l, 32);
        if (c == 31) FA_STAMP(46);
        const float w1 = l > 0.f ? g1 / l : 0.f;
#pragma unroll
        for (int r = 0; r < 16; ++r) { otS[r * 64] += o[0][r] * w1; otS[(16 + r) * 64] += o[1][r] * w1; }
    }
    uint2 zreg[8];
    {
        RowCtx2 rc; rc.hiAbs = sq; rc.loAbs = sq - 511; rc.selmask = 0xffffffffu; rc.selshift = 0; rc.slope2 = slope2; rc.kp_mul = 1; rc.kp_off = -sq;
        float m = 0.f, l = 0.f;
#pragma unroll
        for (int r = 0; r < 16; ++r) { o[0][r] = 0.f; o[1][r] = 0.f; }
        attn_stream2(ring, KW + gb, VW + gb, c >= 8 ? c - 8 : 0, c + 1, qr, rc, wid, lane, m, l, o, need_maxcheck(qr, P.c_knorm_win_g, lane, 0.f), 1, nullptr, 0, 0, ZC + (size_t)t * 512 + h * 64, zreg);
        l += __shfl_xor(l, 32);
        if (c == 31) FA_STAMP(47);
        const float w2 = l > 0.f ? g2 / l : 0.f;
#pragma unroll
        for (int r = 0; r < 16; ++r) { o[0][r] = o[0][r] * w2 + otS[r * 64]; o[1][r] = o[1][r] * w2 + otS[(16 + r) * 64]; }
    }
    store_oz(o, 1.f, zreg, Y, t, h * 64, hi);
    if (c == 31) FA_STAMP(48);
}
}
namespace fm {
typedef short bf16x8 __attribute__((ext_vector_type(8)));
typedef float f32x4 __attribute__((ext_vector_type(4)));
typedef float f32x2 __attribute__((ext_vector_type(2)));
__device__ __forceinline__ float wave_sum(float v) {
#pragma unroll
    for (int o = 1; o < 64; o <<= 1) v += __shfl_xor(v, o);
    return v;
}
struct ConvW { float w0[31], w1[31]; float2 bias; float4 ga, gb, ba, bb2; };
__device__ __forceinline__ void conv_load_w(const KArgs& P, ConvW& W, int tid, int lane) {
    const int cp = tid & 255;
#pragma unroll
    for (int j = 0; j < 31; ++j) { const float2 w = *(const float2*)(P.a_conv_w + j * 512 + 2 * cp); W.w0[j] = w.x; W.w1[j] = w.y; }
    W.bias = *(const float2*)(P.a_conv_b + 2 * cp);
    W.ga = *(const float4*)(P.a_ln_g + 4 * lane); W.gb = *(const float4*)(P.a_ln_g + 256 + 4 * lane);
    W.ba = *(const float4*)(P.a_ln_b + 4 * lane); W.bb2 = *(const float4*)(P.a_ln_b + 256 + 4 * lane);
}
__device__ __forceinline__ void conv_unit(const KArgs& P, LAS unsigned char* lds, int u, const ConvW& W, int tid, int wave, int lane) {
    const bf16_t* G0 = (const bf16_t*)(P.ws + WS_G0); const bf16_t* ZA = (const bf16_t*)(P.ws + WS_ZA); bf16_t* Y = (bf16_t*)(P.ws + WS_Y);
    LAS float* cy = (LAS float*)lds;
    const int cp = tid & 255, sb = tid >> 8;
    {
        const int t0 = u * 32, s0 = t0 & (SEQ - 1);
        float acc0[16], acc1[16];
#pragma unroll
        for (int o = 0; o < 16; ++o) { acc0[o] = W.bias.x; acc1[o] = W.bias.y; }
        const int sbase = s0 + 16 * sb - 30, tmin = t0 - s0, tb = t0 + 16 * sb - 30;
        unsigned xv[46];
#pragma unroll
        for (int i = 0; i < 46; ++i) { int row = tb + i; row = row < tmin ? tmin : row; xv[i] = *(const unsigned*)(G0 + (size_t)row * 512 + 2 * cp); }
#pragma unroll
        for (int i = 0; i < 46; ++i) {
            const bool ok = sbase + i >= 0;
            const float x0 = ok ? bf2f(xv[i] & 0xffff) : 0.f, x1 = ok ? bf2f(xv[i] >> 16) : 0.f;
#pragma unroll
            for (int o = 0; o < 16; ++o) { const int j = i - o; if (j >= 0 && j <= 30) { acc0[o] += x0 * W.w0[j]; acc1[o] += x1 * W.w1[j]; } }
        }
#pragma unroll
        for (int o = 0; o < 16; ++o) { f32x2 r; r.x = acc0[o]; r.y = acc1[o]; *(LAS f32x2*)(cy + (16 * sb + o) * 512 + 2 * cp) = r; }
        __syncthreads();
#pragma unroll
        for (int k = 0; k < 4; ++k) {
            const int tok = 4 * wave + k, t = t0 + tok;
            f32x4 a = *(const LAS f32x4*)(cy + tok * 512 + 4 * lane), b = *(const LAS f32x4*)(cy + tok * 512 + 256 + 4 * lane);
            const float mean = wave_sum((a.x + a.y) + (a.z + a.w) + (b.x + b.y) + (b.z + b.w)) * (1.0f / 512);
            a.x -= mean; a.y -= mean; a.z -= mean; a.w -= mean; b.x -= mean; b.y -= mean; b.z -= mean; b.w -= mean;
            const float var = wave_sum((a.x * a.x + a.y * a.y) + (a.z * a.z + a.w * a.w) + (b.x * b.x + b.y * b.y) + (b.z * b.z + b.w * b.w)) * (1.0f / 512);
            const float rstd = 1.0f / sqrtf(var + EPSF);
            const uint2 za = *(const uint2*)(ZA + (size_t)t * 512 + 4 * lane), zb = *(const uint2*)(ZA + (size_t)t * 512 + 256 + 4 * lane);
            float y0 = fast_silu(a.x * rstd * W.ga.x + W.ba.x) * bf2f(za.x & 0xffff), y1 = fast_silu(a.y * rstd * W.ga.y + W.ba.y) * bf2f(za.x >> 16);
            float y2 = fast_silu(a.z * rstd * W.ga.z + W.ba.z) * bf2f(za.y & 0xffff), y3 = fast_silu(a.w * rstd * W.ga.w + W.ba.w) * bf2f(za.y >> 16);
            uint2 o; o.x = pk2(y0, y1); o.y = pk2(y2, y3);
            *(uint2*)(Y + (size_t)t * 1024 + 4 * lane) = o;
            y0 = fast_silu(b.x * rstd * W.gb.x + W.bb2.x) * bf2f(zb.x & 0xffff); y1 = fast_silu(b.y * rstd * W.gb.y + W.bb2.y) * bf2f(zb.x >> 16);
            y2 = fast_silu(b.z * rstd * W.gb.z + W.bb2.z) * bf2f(zb.y & 0xffff); y3 = fast_silu(b.w * rstd * W.gb.w + W.bb2.w) * bf2f(zb.y >> 16);
            o.x = pk2(y0, y1); o.y = pk2(y2, y3);
            *(uint2*)(Y + (size_t)t * 1024 + 256 + 4 * lane) = o;
        }
        __syncthreads();
    }
}

__device__ __forceinline__ void cmp_unit(const KArgs& P, LAS unsigned char* lds, int u, int tid, int wave, int lane) {
    const int kv = u >> 7, bg = (u >> 3) & 15, rb = u & 7, fr = lane & 15, fq = lane >> 4;
    const bf16_t* X = (const bf16_t*)(P.ws + (kv == 0 ? WS_KCR : WS_VCR)) + ((size_t)bg * SEQ + 256 * rb) * 64;
    const bf16_t* W1f = (const bf16_t*)(P.ws + WS_CW1) + (size_t)kv * 256 * 2048;
    const bf16_t* W2t = (const bf16_t*)(P.ws + WS_CW2) + (size_t)kv * 64 * 256;
    const float* B1P = (const float*)(P.ws + WS_B1P) + (size_t)kv * 16 * 256;
    LAS unsigned char* xs = lds;
    LAS bf16_t* hidS = (LAS bf16_t*)(lds + 272 * 128);
    LAS float* outS = (LAS float*)(lds + 272 * 128 + 16 * 264 * 2);
    const bf16_t* bp0 = W1f + (size_t)(2 * wave) * 64 * 512 + lane * 8; const bf16_t* bp1 = bp0 + 64 * 512;
    bf16x8 bb[4][8];
#define CMP_LOADB(buf, ch) do { _Pragma("unroll") for (int q_ = 0; q_ < 4; ++q_) { bb[buf][2 * q_] = *(const bf16x8*)(bp0 + (size_t)(4 * (ch) + q_) * 512); bb[buf][2 * q_ + 1] = *(const bf16x8*)(bp1 + (size_t)(4 * (ch) + q_) * 512); } } while (0)
    CMP_LOADB(0, 0); CMP_LOADB(1, 1); CMP_LOADB(2, 2);
#pragma unroll
    for (int i = 0; i < 5; ++i) { const int idx = tid + 512 * i;
        if (idx < 2176) { const int t = idx >> 3, c = idx & 7; const uint4 v = *(const uint4*)(X + (size_t)t * 64 + c * 8);
            *(LAS v4u*)(xs + t * 128 + ((c ^ ((t >> 4) & 7)) << 4)) = (v4u){v.x, v.y, v.z, v.w}; } }
    __syncthreads();
    {
        const int n0 = 32 * wave;
        f32x4 acc0 = {0.f, 0.f, 0.f, 0.f}, acc1 = {0.f, 0.f, 0.f, 0.f};
#pragma unroll
        for (int ch = 0; ch < 16; ++ch) {
            if (ch + 3 < 16) CMP_LOADB((ch + 3) & 3, ch + 3);
#pragma unroll
            for (int q = 0; q < 4; ++q) {
                const int ks = 4 * ch + q, tau = ks >> 1, c = (ks & 1) * 4 + fq, t = 16 * fr + tau;
                const bf16x8 a = *(const LAS bf16x8*)(xs + t * 128 + ((c ^ ((t >> 4) & 7)) << 4));
                acc0 = __builtin_amdgcn_mfma_f32_16x16x32_bf16(a, bb[ch & 3][2 * q], acc0, 0, 0, 0);
                acc1 = __builtin_amdgcn_mfma_f32_16x16x32_bf16(a, bb[ch & 3][2 * q + 1], acc1, 0, 0, 0);
            }
        }
#undef CMP_LOADB
        const float* b1 = kv == 0 ? P.c_k_b1 : P.c_v_b1;
#pragma unroll
        for (int f = 0; f < 2; ++f) {
            const int n = n0 + 16 * f + fr;
            float bias = b1[n];
#pragma unroll
            for (int kc = 0; kc < 16; ++kc) bias += B1P[kc * 256 + n];
#pragma unroll
            for (int r = 0; r < 4; ++r) { const float v = (f == 0 ? acc0[r] : acc1[r]) + bias; hidS[(4 * fq + r) * 264 + n] = f2bf(fast_silu(v)); }
        }
    }
    __syncthreads();
    if (wave < 4) {
        const int d0 = 16 * wave;
        f32x4 acc = {0.f, 0.f, 0.f, 0.f};
#pragma unroll
        for (int k0 = 0; k0 < 256; k0 += 32) {
            const bf16x8 a = *(const LAS bf16x8*)(hidS + fr * 264 + k0 + 8 * fq);
            const bf16x8 b = *(const bf16x8*)(W2t + (size_t)(d0 + fr) * 256 + k0 + 8 * fq);
            acc = __builtin_amdgcn_mfma_f32_16x16x32_bf16(a, b, acc, 0, 0, 0);
        }
        const float b2 = (kv == 0 ? P.c_k_b2 : P.c_v_b2)[d0 + fr];
#pragma unroll
        for (int r = 0; r < 4; ++r) outS[(4 * fq + r) * 65 + d0 + fr] = acc[r] + b2;
    }
    __syncthreads();
    {
        bf16_t* dst = (bf16_t*)(P.ws + (kv == 0 ? WS_KC : WS_VC)) + (size_t)bg * 128 * 64;
#pragma unroll
        for (int k = 0; k < 2; ++k) {
            const int row = 2 * wave + k, c = 16 * rb + row;
            float v = outS[row * 65 + lane];
            if (kv == 0) { const float ss = wave_sum(v * v); v = v * (1.0f / sqrtf(ss * (1.0f / 64) + EPSF)) * P.c_knorm_cmp_g[lane]; }
            const size_t off = kv == 0 ? (size_t)(c >> 6) * 4096 + (lane >> 3) * 512 + (c & 63) * 8 + (lane & 7)
                                       : (size_t)(c >> 6) * 4096 + (lane >> 5) * 2048 + (c & 63) * 32 + (lane & 31);
            dst[off] = c < 127 ? f2bf(v) : (bf16_t)0;
        }
    }
    __syncthreads();
}

__device__ __forceinline__ void gate_unit(const KArgs& P, LAS unsigned char* lds, int u, int tid, int wave, int lane) {
    const bf16_t* XB = (const bf16_t*)(P.ws + WS_XB); const bf16_t* WG = (const bf16_t*)(P.ws + WS_WGATE); const float* SSQ = (const float*)(P.ws + WS_SSQ); float* GT = (float*)(P.ws + WS_GT);
    const int fr = lane & 15, fq = lane >> 4, mf = wave & 3, kh = wave >> 2, t0 = 64 * u + 16 * mf;
    constexpr int ROWB = 2064;
    LAS float* part = (LAS float*)(lds + 32 * ROWB);
#pragma unroll
    for (int i = 0; i < 8; ++i) { const int idx = tid + 512 * i, n = idx >> 7, ch = idx & 127;
        const uint4 v = *(const uint4*)(WG + (size_t)n * DM + ch * 8);
        *(LAS v4u*)(lds + n * ROWB + ch * 16) = (v4u){v.x, v.y, v.z, v.w}; }
    bf16x8 a[16];
    const bf16_t* ap = XB + (size_t)(t0 + fr) * DM + kh * 512 + 8 * fq;
#pragma unroll
    for (int i = 0; i < 16; ++i) a[i] = *(const bf16x8*)(ap + 32 * i);
    __syncthreads();
    f32x4 acc0 = {0.f, 0.f, 0.f, 0.f}, acc1 = {0.f, 0.f, 0.f, 0.f};
    const LAS unsigned char* bp = lds + fr * ROWB + (kh * 512 + 8 * fq) * 2;
#pragma unroll
    for (int i = 0; i < 16; ++i) {
        const bf16x8 b0 = *(const LAS bf16x8*)(bp + 64 * i), b1 = *(const LAS bf16x8*)(bp + 16 * ROWB + 64 * i);
        acc0 = __builtin_amdgcn_mfma_f32_16x16x32_bf16(a[i], b0, acc0, 0, 0, 0);
        acc1 = __builtin_amdgcn_mfma_f32_16x16x32_bf16(a[i], b1, acc1, 0, 0, 0);
    }
    if (kh == 1) {
#pragma unroll
        for (int r = 0; r < 4; ++r) { part[(mf * 64 + lane) * 8 + r] = acc0[r]; part[(mf * 64 + lane) * 8 + 4 + r] = acc1[r]; }
    }
    __syncthreads();
    if (kh == 0) {
#pragma unroll
        for (int r = 0; r < 4; ++r) {
            const int t = t0 + 4 * fq + r;
            const float4* sq = (const float4*)(SSQ + (size_t)t * 16);
            const float4 q0 = sq[0], q1 = sq[1], q2 = sq[2], q3 = sq[3];
            const float ssq = ((q0.x + q0.y) + (q0.z + q0.w)) + ((q1.x + q1.y) + (q1.z + q1.w)) + ((q2.x + q2.y) + (q2.z + q2.w)) + ((q3.x + q3.y) + (q3.z + q3.w));
            const float rstd = 1.0f / sqrtf(ssq * (1.0f / DM) + EPSF);
            GT[(size_t)t * 32 + fr] = fast_sigmoid((acc0[r] + part[(mf * 64 + lane) * 8 + r]) * rstd);
            if (fr < 8) GT[(size_t)t * 32 + 16 + fr] = fast_sigmoid((acc1[r] + part[(mf * 64 + lane) * 8 + 4 + r]) * rstd);
        }
    }
    __syncthreads();
}

__device__ __forceinline__ void b1p_item(const KArgs& P, int it, int lane) {
    const int kv = it >> 6, kc = (it >> 2) & 15, n = (it & 3) * 64 + lane;
    const float* pos = kv == 0 ? P.c_pos_k : P.c_pos_v; const float* w1 = kv == 0 ? P.c_k_w1 : P.c_v_w1;
    float s = 0.f;
#pragma unroll 32
    for (int k = kc * 128; k < kc * 128 + 128; ++k) s += pos[k] * w1[(size_t)k * 256 + n];
    ((float*)(P.ws + WS_B1P))[((size_t)kv * 16 + kc) * 256 + n] = s;
}
__device__ __forceinline__ void w1f_item(const KArgs& P, int it, int lane) {
    const int kv = it >> 7, nf = (it >> 3) & 15, ks8 = it & 7, fr = lane & 15, fq = lane >> 4;
    const float* w1 = kv == 0 ? P.c_k_w1 : P.c_v_w1;
    bf16_t* dst = (bf16_t*)(P.ws + WS_CW1) + (size_t)kv * 256 * 2048 + (size_t)nf * 64 * 512 + lane * 8;
    float v[8][8];
#pragma unroll
    for (int q = 0; q < 8; ++q) {
        const float* src = w1 + (size_t)(32 * (ks8 * 8 + q) + 8 * fq) * 256 + 16 * nf + fr;
#pragma unroll
        for (int j = 0; j < 8; ++j) v[q][j] = src[j * 256];
    }
#pragma unroll
    for (int q = 0; q < 8; ++q) {
        uint4 o; o.x = pk2(v[q][0], v[q][1]); o.y = pk2(v[q][2], v[q][3]); o.z = pk2(v[q][4], v[q][5]); o.w = pk2(v[q][6], v[q][7]);
        *(uint4*)(dst + (size_t)(ks8 * 8 + q) * 512) = o;
    }
}
}
__device__ __forceinline__ NvGroup fast_group(const KArgs& P, int layer, int pn, int wc) {
    if (layer == 0) {
        if (pn < 4) { NvGroup g; g.gain = nullptr; g.scale = 1.f; g.width = 32; g.type = 4; g.col = 128 * pn + 32 * wc; g.col2 = 512 + g.col; g.dkind = 0; g.dst = P.ws + WS_G0; g.ld = 512; g.idx = 0; return g; }
        return nv_group0(P, 8 + 4 * (pn - 4) + wc);
    }
    int gi;
    if (pn < 2) gi = 4 * pn + wc;
    else if (pn < 4) gi = 21 + 4 * (pn - 2) + wc;
    else if (pn < 6) gi = 29 + 4 * (pn - 4) + wc;
    else if (pn < 8) gi = 41 + 4 * (pn - 6) + wc;
    else if (pn == 8) gi = 8 + wc;
    else if (pn == 9) gi = wc < 2 ? 12 + wc : 16 + (wc - 2);
    else if (pn == 10) gi = wc < 2 ? 14 + wc : 18 + (wc - 2);
    else if (pn == 11) gi = wc < 2 ? 37 + wc : 39 + (wc - 2);
    else { NvGroup g; g.gain = nullptr; g.scale = 1.f; g.width = 0; g.type = 5; g.col = 0; g.col2 = 0; g.dkind = 0; g.dst = nullptr; g.ld = 0; g.idx = 0; return g; }
    return nv_group1(P, gi);
}
constexpr int NTILE_IN0 = 14, NTILE_IN1 = 12;


struct EpiIn {
    static constexpr bool PERM = true, AFTER_DRAIN = false;
    KArgs P; int layer;
    __device__ __forceinline__ void operator()(const pg8::f32x4 (&acc)[2][2][4][2], const pg8::Unit& u, int wr, int wc, int fr, int fq) const {
        const NvGroup g = fast_group(P, layer, u.pn, wc);
        if (g.type == 5) return;
        const float* SSQ = (const float*)(P.ws + WS_SSQ);
        const bool do_km = (layer == 0 && g.type == 2 && u.pn >= 8);
        float gn[16], km[16];
#pragma unroll
        for (int i = 0; i < 16; ++i) { gn[i] = 1.f; km[i] = 0.f; }
        if (g.type == 2) {
#pragma unroll
            for (int bj = 0; bj < 2; ++bj)
#pragma unroll
                for (int i = 0; i < 8; ++i) gn[8 * bj + i] = g.gain[32 * bj + 8 * fq + i] * g.scale;
        }
#pragma unroll
        for (int ai = 0; ai < 2; ++ai)
#pragma unroll
            for (int m = 0; m < 4; ++m) {
                const int t = u.pm * 256 + ai * 128 + wr * 64 + m * 16 + fr, b = t >> 11, s = t & 2047;
                const float4* sq = (const float4*)(SSQ + (size_t)t * 16);
                const float4 q0 = sq[0], q1 = sq[1], q2 = sq[2], q3 = sq[3];
                const float ssq = ((q0.x + q0.y) + (q0.z + q0.w)) + ((q1.x + q1.y) + (q1.z + q1.w)) + ((q2.x + q2.y) + (q2.z + q2.w)) + ((q3.x + q3.y) + (q3.z + q3.w));
                const float rstd = 1.0f / sqrtf(ssq * (1.0f / DM) + EPSF);
                float v[16];
#pragma unroll
                for (int bj = 0; bj < 2; ++bj)
#pragma unroll
                    for (int n = 0; n < 2; ++n)
#pragma unroll
                        for (int r = 0; r < 4; ++r) v[8 * bj + 4 * n + r] = acc[ai][bj][m][n][r] * rstd;
                if (g.type == 4) {
                    pg8::u32x4 w;
                    float o[8];
#pragma unroll
                    for (int i = 0; i < 8; ++i) o[i] = v[i] * fast_sigmoid(v[8 + i]);
                    w.x = pg8::cvt_pk_bf16(o[0], o[1]); w.y = pg8::cvt_pk_bf16(o[2], o[3]); w.z = pg8::cvt_pk_bf16(o[4], o[5]); w.w = pg8::cvt_pk_bf16(o[6], o[7]);
                    *(pg8::u32x4*)((bf16_t*)g.dst + (size_t)t * 512 + g.col + 8 * fq) = w;
                    continue;
                }
                if (g.type == 3) {
                    if (fq < 3) {
                        float4 o0, o1;
                        o0.x = fast_sigmoid(v[0]); o0.y = fast_sigmoid(v[1]); o0.z = fast_sigmoid(v[2]); o0.w = fast_sigmoid(v[3]);
                        o1.x = fast_sigmoid(v[4]); o1.y = fast_sigmoid(v[5]); o1.z = fast_sigmoid(v[6]); o1.w = fast_sigmoid(v[7]);
                        float* gp = (float*)g.dst + (size_t)t * 32 + 8 * fq;
                        *(float4*)gp = o0; *(float4*)(gp + 4) = o1;
                    }
                    continue;
                }
                if (g.type == 1) {
#pragma unroll
                    for (int i = 0; i < 16; ++i) v[i] = fast_silu(v[i]);
                } else if (g.type == 2) {
                    float ss = 0.f;
#pragma unroll
                    for (int i = 0; i < 16; ++i) ss += v[i] * v[i];
                    ss += __shfl_xor(ss, 16); ss += __shfl_xor(ss, 32);
                    const float nrm = 1.0f / sqrtf(ss * (1.0f / 64) + EPSF);
#pragma unroll
                    for (int i = 0; i < 16; ++i) v[i] = v[i] * nrm * gn[i];
                    if (do_km) {
#pragma unroll
                        for (int i = 0; i < 16; ++i) km[i] += v[i];
                    }
                }
                bf16_t* dp = g.dkind == 0 ? (bf16_t*)g.dst + (size_t)t * g.ld + g.idx * 64 + 8 * fq
                                          : (bf16_t*)g.dst + ((size_t)(b * g.ld + g.idx) * SEQ + s) * 64 + 8 * fq;
                int bjstep = 32;
                if (g.dkind == 3) { dp = (bf16_t*)g.dst + (size_t)(b * g.ld + g.idx) * SEQ * 64 + (size_t)(s >> 6) * 4096 + fq * 512 + (s & 63) * 8; bjstep = 2048; }
                else if (g.dkind == 4) { dp = (bf16_t*)g.dst + (size_t)(b * g.ld + g.idx) * SEQ * 64 + (size_t)(s >> 6) * 4096 + (s & 63) * 32 + 8 * fq; bjstep = 2048; }
#pragma unroll
                for (int bj = 0; bj < 2; ++bj) {
                    pg8::u32x4 w;
                    w.x = pg8::cvt_pk_bf16(v[8 * bj + 0], v[8 * bj + 1]); w.y = pg8::cvt_pk_bf16(v[8 * bj + 2], v[8 * bj + 3]);
                    w.z = pg8::cvt_pk_bf16(v[8 * bj + 4], v[8 * bj + 5]); w.w = pg8::cvt_pk_bf16(v[8 * bj + 6], v[8 * bj + 7]);
                    *(pg8::u32x4*)(dp + bjstep * bj) = w;
                }
            }
        if (do_km) {
#pragma unroll
            for (int i = 0; i < 16; ++i) { float a = km[i]; a += __shfl_xor(a, 1); a += __shfl_xor(a, 2); a += __shfl_xor(a, 4); a += __shfl_xor(a, 8); km[i] = a * (1.0f / 256); }
            if (fr == 0) {
                float* kp = (float*)(P.ws + WS_KMP) + ((size_t)wr * 64 + u.pm) * 512 + g.idx * 64 + 8 * fq;
#pragma unroll
                for (int bj = 0; bj < 2; ++bj) {
                    float4 o0, o1; o0.x = km[8 * bj + 0]; o0.y = km[8 * bj + 1]; o0.z = km[8 * bj + 2]; o0.w = km[8 * bj + 3];
                    o1.x = km[8 * bj + 4]; o1.y = km[8 * bj + 5]; o1.z = km[8 * bj + 6]; o1.w = km[8 * bj + 7];
                    *(float4*)(kp + 32 * bj) = o0; *(float4*)(kp + 32 * bj + 4) = o1;
                }
            }
        }
    }
};

struct EpiOut {
    static constexpr bool PERM = true, AFTER_DRAIN = false;
    float* out; bf16_t* XB; float* SSQ; int layer;
    __device__ __forceinline__ void operator()(const pg8::f32x4 (&acc)[2][2][4][2], const pg8::Unit& u, int wr, int wc, int fr, int fq) const {
        const int col0 = u.pn * 256 + wc * 32 + 8 * fq;
#pragma unroll
        for (int ai = 0; ai < 2; ++ai)
#pragma unroll
            for (int m = 0; m < 4; ++m) {
                const int t = u.pm * 256 + ai * 128 + wr * 64 + m * 16 + fr;
                float ss = 0.f;
#pragma unroll
                for (int bj = 0; bj < 2; ++bj) {
                    const size_t o = (size_t)t * DM + col0 + 128 * bj;
                    const pg8::u32x4 rb = *(const pg8::u32x4*)(XB + o);
                    pg8::f32x4 x0, x1;
                    x0[0] = bf2f(rb.x & 0xffff) + acc[ai][bj][m][0][0]; x0[1] = bf2f(rb.x >> 16) + acc[ai][bj][m][0][1]; x0[2] = bf2f(rb.y & 0xffff) + acc[ai][bj][m][0][2]; x0[3] = bf2f(rb.y >> 16) + acc[ai][bj][m][0][3];
                    x1[0] = bf2f(rb.z & 0xffff) + acc[ai][bj][m][1][0]; x1[1] = bf2f(rb.z >> 16) + acc[ai][bj][m][1][1]; x1[2] = bf2f(rb.w & 0xffff) + acc[ai][bj][m][1][2]; x1[3] = bf2f(rb.w >> 16) + acc[ai][bj][m][1][3];
                    if (layer == 0) {
                        pg8::u32x4 w; w.x = pg8::cvt_pk_bf16(x0[0], x0[1]); w.y = pg8::cvt_pk_bf16(x0[2], x0[3]); w.z = pg8::cvt_pk_bf16(x1[0], x1[1]); w.w = pg8::cvt_pk_bf16(x1[2], x1[3]);
                        *(pg8::u32x4*)(XB + o) = w;
                        ss += (x0[0] * x0[0] + x0[1] * x0[1]) + (x0[2] * x0[2] + x0[3] * x0[3]) + (x1[0] * x1[0] + x1[1] * x1[1]) + (x1[2] * x1[2] + x1[3] * x1[3]);
                    } else { *(pg8::f32x4*)(out + o) = x0; *(pg8::f32x4*)(out + o + 4) = x1; }
                }
                if (layer == 0) { ss += __shfl_xor(ss, 16); ss += __shfl_xor(ss, 32); if (fq == 0) SSQ[(size_t)t * 16 + u.pn * 4 + wc] = ss; }
            }
    }
};

__device__ __forceinline__ void cvt_item(const float* __restrict__ W, int ldw, const float* __restrict__ gain, bf16_t* __restrict__ Bt, int Kd, int k0, int drow0, int src0, int vw, LAS float* scr, int lane) {
    {
        const int c = lane & 31, h = lane >> 5;
        if (vw == 32) {
            float v[32];
#pragma unroll
            for (int i = 0; i < 32; ++i) v[i] = W[(size_t)(k0 + 2 * i + h) * ldw + src0 + c];
            if (gain) {
#pragma unroll
                for (int i = 0; i < 32; ++i) v[i] *= gain[k0 + 2 * i + h];
            }
#pragma unroll
            for (int i = 0; i < 32; ++i) scr[(2 * i + h) * 33 + c] = v[i];
        } else {
            const int cc = c < vw ? c : (vw > 0 ? vw - 1 : 0);
#pragma unroll 8
            for (int i = 0; i < 32; ++i) { const int kk = 2 * i + h;
                float v = vw > 0 ? W[(size_t)(k0 + kk) * ldw + src0 + cc] : 0.f; if (gain) v *= gain[k0 + kk];
                scr[kk * 33 + c] = c < vw ? v : 0.f; }
        }
    }
    LDS_WAIT(); asm volatile("" ::: "memory");
    const int c = lane & 7;
#pragma unroll
    for (int j = 0; j < 4; ++j) { const int n = (lane >> 3) + 8 * j; const LAS float* s = scr + (8 * c) * 33 + n;
        v4u o; o.x = pk2(s[0 * 33], s[1 * 33]); o.y = pk2(s[2 * 33], s[3 * 33]); o.z = pk2(s[4 * 33], s[5 * 33]); o.w = pk2(s[6 * 33], s[7 * 33]);
        *(v4u*)(Bt + (size_t)(drow0 + n) * Kd + k0 + 8 * c) = o; }
    LDS_WAIT(); asm volatile("" ::: "memory");
}
__device__ __forceinline__ void cvt_in_item(const KArgs& P, int layer, int it, LAS float* scr, int lane) {
    const int kb = it & 15, blk = it >> 4, pn = blk >> 3, pb = blk & 7, wc = pb & 3, bj = pb >> 2;
    const NvGroup g = fast_group(P, layer, pn, wc);
    int src0 = 0, vw = 0;
    if (g.type == 4) { src0 = bj ? g.col2 : g.col; vw = 32; }
    else if (g.type != 5) { src0 = g.col + 32 * bj; vw = g.width - 32 * bj; vw = vw < 0 ? 0 : (vw > 32 ? 32 : vw); }
    const float* W = layer == 0 ? P.e_w_in : P.o_w_in; const int ldw = layer == 0 ? 3584 : 3096;
    bf16_t* Bt = (bf16_t*)(P.ws + (layer == 0 ? WS_WIN0 : WS_WIN1));
    cvt_item(W, ldw, P.norm_g + layer * DM, Bt, DM, 64 * kb, 256 * pn + 128 * bj + 32 * wc, src0, vw, scr, lane);
}
__device__ __forceinline__ void p0_deferred_item(const KArgs& P, int r, LAS float* scr, int lane) {
    constexpr int I_B1P = 128, I_WG = 16, I_IN1 = NTILE_IN1 * 8 * 16, I_OUT = 32 * 16, I_W1 = 128, I_W2 = 2 * 4;
    if (r < I_B1P) { fm::b1p_item(P, r, lane); return; } r -= I_B1P;
    if (r < I_WG) { cvt_item(P.o_w_in, 3096, P.norm_g + DM, (bf16_t*)(P.ws + WS_WGATE), DM, 64 * r, 0, 1280, 24, scr, lane); return; } r -= I_WG;
    if (r < 2 * I_W2) { const int kv = r / I_W2; r -= kv * I_W2; const int kb = r & 3, nb = r >> 2;
        cvt_item(kv == 0 ? P.c_k_w2 : P.c_v_w2, 64, nullptr, (bf16_t*)(P.ws + WS_CW2) + (size_t)kv * 64 * 256, 256, 64 * kb, 32 * nb, 32 * nb, 32, scr, lane); return; }
    r -= 2 * I_W2;
    if (r < 2 * I_W1) { fm::w1f_item(P, r, lane); return; } r -= 2 * I_W1;
    if (r < 2 * I_OUT) { const int l = r / I_OUT; r -= l * I_OUT; const int kb = r & 15, nb = r >> 4;
        cvt_item(P.w_out + (size_t)l * DM * DM, DM, nullptr, (bf16_t*)(P.ws + (l == 0 ? WS_WOUT0 : WS_WOUT1)), DM, 64 * kb, 32 * nb, 32 * nb, 32, scr, lane); return; }
    r -= 2 * I_OUT;
    cvt_in_item(P, 1, r, scr, lane);
}
constexpr int N_EARLY = 128 + 16 + 16;
constexpr int N_DEFERRED = 2 * 512 + NTILE_IN1 * 128 + 256 + 128 + 16 + 16;
constexpr int CW_WQD = 8192 + 2048;
__device__ __forceinline__ void p0_deferred(const KArgs& P, LAS unsigned char* lds, volatile LAS unsigned* MISC, int nwg, int G, int c, int tid, int wave, int lane) {
    const int maxu = (nwg + G - 1) / G, c0 = nwg - (maxu - 1) * G;
    if (c0 < G && c < c0) return;
    LAS float* scr = (LAS float*)(lds + wave * 16384);
    unsigned* ctr = (unsigned*)(P.ws + WS_CTL) + CW_WQD;
    for (;;) {
        __syncthreads();
        if (tid == 0) MISC[13] = __hip_atomic_fetch_add(ctr, 8u, __ATOMIC_RELAXED, __HIP_MEMORY_SCOPE_AGENT);
        __syncthreads();
        const int base = N_EARLY + (int)MISC[13];
        if (base >= N_DEFERRED) break;
        { const int r = base + wave; if (r < N_DEFERRED) p0_deferred_item(P, r, scr, lane); }
    }
}
__device__ __forceinline__ void p0_prologue(const KArgs& P, LAS unsigned char* lds, int vcu, int G, int wave, int lane) {
    LAS float* scr = (LAS float*)(lds + wave * 16384);
    const int gw = vcu * 8 + wave, NGW = G * 8;
    constexpr int I_IN0 = NTILE_IN0 * 8 * 16;
    for (int it = vcu + G * wave; it < N_EARLY + I_IN0; it += NGW) {
        if (it < N_EARLY) p0_deferred_item(P, it, scr, lane); else cvt_in_item(P, 0, it - N_EARLY, scr, lane);
    }
    bf16_t* XB = (bf16_t*)(P.ws + WS_XB); float* SSQ = (float*)(P.ws + WS_SSQ);
    const int rows_per_wave = (NT + NGW - 1) / NGW;
    for (int m0 = gw * rows_per_wave; m0 < (gw + 1) * rows_per_wave && m0 < NT; m0 += 4) {
        float4 v[4][4];
#pragma unroll
        for (int q = 0; q < 4; ++q) { const int m = m0 + q < NT ? m0 + q : NT - 1; const float4* r = (const float4*)(P.x + (size_t)m * DM) + 2 * lane;
            v[q][0] = r[0]; v[q][1] = r[1]; v[q][2] = r[128]; v[q][3] = r[129]; }
#pragma unroll
        for (int q = 0; q < 4; ++q) {
            const int m = m0 + q;
            float s = 0.f;
#pragma unroll
            for (int j = 0; j < 4; ++j) s += (v[q][j].x * v[q][j].x + v[q][j].y * v[q][j].y) + (v[q][j].z * v[q][j].z + v[q][j].w * v[q][j].w);
#pragma unroll
            for (int o = 1; o < 64; o <<= 1) s += __shfl_xor(s, o);
            if (m < NT && m < (gw + 1) * rows_per_wave) {
                uint4 o0, o1;
                o0.x = pg8::cvt_pk_bf16(v[q][0].x, v[q][0].y); o0.y = pg8::cvt_pk_bf16(v[q][0].z, v[q][0].w); o0.z = pg8::cvt_pk_bf16(v[q][1].x, v[q][1].y); o0.w = pg8::cvt_pk_bf16(v[q][1].z, v[q][1].w);
                o1.x = pg8::cvt_pk_bf16(v[q][2].x, v[q][2].y); o1.y = pg8::cvt_pk_bf16(v[q][2].z, v[q][2].w); o1.z = pg8::cvt_pk_bf16(v[q][3].x, v[q][3].y); o1.w = pg8::cvt_pk_bf16(v[q][3].z, v[q][3].w);
                *(uint4*)(XB + (size_t)m * DM + 8 * lane) = o0; *(uint4*)(XB + (size_t)m * DM + 512 + 8 * lane) = o1;
                if (lane < 4) { float4 z; z.x = lane == 0 ? s : 0.f; z.y = 0.f; z.z = 0.f; z.w = 0.f; *(float4*)(SSQ + (size_t)m * 16 + lane * 4) = z; }
            }
        }
    }
}

constexpr int CW_WQ2 = 8192, CW_WQ2C = 8192 + 512, CW_WQ6 = 8192 + 1024;
#define WQ_FIRST(ctrptr) unsigned* ctr_ = (ctrptr); \
        if (tid == 0) MISC[12] = __hip_atomic_fetch_add(ctr_, 1u, __ATOMIC_RELAXED, __HIP_MEMORY_SCOPE_AGENT); \
        __syncthreads(); \
        int it_ = (int)MISC[12];
#define WQ_WHILE(LIMIT, ...) while (it_ < (LIMIT)) { \
            unsigned nx_ = 0u; if (tid == 0) nx_ = __hip_atomic_fetch_add(ctr_, 1u, __ATOMIC_RELAXED, __HIP_MEMORY_SCOPE_AGENT);     \
            { const int it = it_; __VA_ARGS__ } \
            __syncthreads(); if (tid == 0) MISC[12] = nx_; __syncthreads(); it_ = (int)MISC[12]; \
        }
#define WQ_QUEUES(cwbase, QLEN, ...) do { const int xcc_ = (int)(xb_xcc_id() & 7u); unsigned* qb_ = (unsigned*)(P.ws + WS_CTL) + (cwbase); \
        for (int qi_ = 0; qi_ < 8; ++qi_) { const int q = (xcc_ + qi_) & 7; \
            if (qi_ == 1) { __syncthreads(); if (tid < 8) MISC[24 + tid] = __hip_atomic_load(qb_ + 64 * tid, __ATOMIC_RELAXED, __HIP_MEMORY_SCOPE_AGENT); __syncthreads(); } \
            if (qi_ >= 1 && MISC[24 + q] >= (unsigned)(QLEN)) continue; \
            WQ_FIRST(qb_ + 64 * q) __VA_ARGS__ } } while (0)

constexpr int RING_BYTES = 131072, LDSCTL_OFF = RING_BYTES, MISC_OFF = LDSCTL_OFF + 320, LDS_BYTES = 147456;
constexpr int CW_BAR = 4096;
constexpr int NPHASE = 8;

__global__ void __launch_bounds__(512, 2) mk_fwd(KArgs P) {
    extern __shared__ __attribute__((aligned(16))) unsigned char lds_raw[];
    LAS unsigned char* lds = (LAS unsigned char*)lds_raw;
    volatile LAS unsigned* MISC = (volatile LAS unsigned*)(lds + MISC_OFF);
    const int tid = threadIdx.x, lane = tid & 63, wave = __builtin_amdgcn_readfirstlane(tid >> 6);
    const int G = gridDim.x, bx = blockIdx.x, vcu = (G % 8 == 0) ? (bx % 8) * (G / 8) + bx / 8 : bx;
    for (int u = tid; u < (LDS_BYTES - LDSCTL_OFF) / 4; u += 512) ((LAS unsigned*)(lds + LDSCTL_OFF))[u] = 0u;
    __syncthreads();
#ifdef PROBE_A
#ifndef PROBE_BX
#define PROBE_BX 0
#endif
#define STAMP(n) do { if (bx == PROBE_BX && tid == 0) { MISC[40 + (n)] = (unsigned)__builtin_amdgcn_s_memrealtime(); MISC[80 + (n)] = (unsigned)__builtin_amdgcn_s_memtime(); } } while (0)
#else
#define STAMP(n) do {} while (0)
#endif
    const int lo = P.ph_lo, hi = P.ph_hi;
    STAMP(0);
    XcdBarrier bar; bar.bar = (unsigned*)(P.ws + WS_CTL) + CW_BAR; bar.x = 0; bar.st = nullptr;
    if (hi - lo > 1) bar = xcd_barrier_post((unsigned*)(P.ws + WS_CTL) + CW_BAR, MISC + 8);
#define IN(k) (lo <= (k) && (k) < hi)
#define SEAM(k) do { STAMP(2 * (k) + 1); if (IN(k) && IN((k) + 1)) xcd_barrier(bar); STAMP(2 * (k) + 2); } while (0)

    if (IN(0)) {
        p0_prologue(P, lds, vcu, G, wave, lane); SEAM(0);
    }
    if (IN(1)) {
        pg8::Gemm g{(const bf16_t*)(P.ws + WS_XB), (const bf16_t*)(P.ws + WS_WIN0), NT, NTILE_IN0 * 256, DM}; pg8::StaticOrder S; S.init(NT, NTILE_IN0 * 256, G, bx);
        EpiIn E{P, 0};
        pg8::gemm_phase<EpiIn, pg8::StaticOrder, true, true>(lds, g, S, E);
        p0_deferred(P, lds, MISC, (NT / 256) * NTILE_IN0, G, bx, tid, wave, lane);
        SEAM(1);
    }
    if (IN(2)) {
        for (int k = vcu; k < 512; k += G) { const int kk = k < 256 ? k : k - 256, bh = kk >> 2, own = k < 256 ? 7 - (kk & 3) : (kk & 3);
            fa::moba_unit(P, (fa::lds_ptr)lds, bh >> 3, bh & 7, own, wave, lane); }
        STAMP(20);
        {
            fm::ConvW cw; fm::conv_load_w(P, cw, tid, lane);
            WQ_QUEUES(CW_WQ2C, 64, WQ_WHILE(64, fm::conv_unit(P, lds, 64 * q + it, cw, tid, wave, lane);));
        }
        SEAM(2);
    }
    if (IN(3)) {
        pg8::Gemm g{(const bf16_t*)(P.ws + WS_Y), (const bf16_t*)(P.ws + WS_WOUT0), NT, DM, DM}; pg8::StaticOrder S; S.init(NT, DM, G, bx);
        EpiOut E{P.out, (bf16_t*)(P.ws + WS_XB), (float*)(P.ws + WS_SSQ), 0};
        pg8::gemm_phase<EpiOut, pg8::StaticOrder, true, true>(lds, g, S, E);
        SEAM(3);
    }
    if (IN(4)) {
        pg8::Gemm g{(const bf16_t*)(P.ws + WS_XB), (const bf16_t*)(P.ws + WS_WIN1), NT, NTILE_IN1 * 256, DM}; pg8::StaticOrder S; S.init(NT, NTILE_IN1 * 256, G, bx);
        EpiIn E{P, 1};
        pg8::gemm_phase<EpiIn, pg8::StaticOrder, true, true>(lds, g, S, E);
        SEAM(4);
    }
    if (IN(5)) {
        for (int k = vcu; k < 256; k += G) fm::gate_unit(P, lds, k, tid, wave, lane);
        STAMP(21);
        if (P.flags & 16) for (int k = vcu; k < 256; k += G) fm::cmp_unit(P, lds, k, tid, wave, lane);
        SEAM(5);
    }
    if (IN(6)) {
        for (int k = vcu; k < 512; k += G) { const int kk = k < 256 ? k : k - 256, bg = kk >> 4, c = k < 256 ? 31 - (kk & 15) : (kk & 15);
            fa::nsa_unit(P, (fa::lds_ptr)lds, bg >> 1, bg & 1, c, wave, lane, tid); }
        STAMP(22);
        WQ_QUEUES(CW_WQ6, 64, WQ_WHILE(64, fa::swa_unit(P, (fa::lds_ptr)lds, q, it & 1, 31 - (it >> 1), wave, lane);));
        SEAM(6);
    }
    if (IN(7)) {
        pg8::Gemm g{(const bf16_t*)(P.ws + WS_Y), (const bf16_t*)(P.ws + WS_WOUT1), NT, DM, DM}; pg8::StaticOrder S; S.init(NT, DM, G, bx);
        EpiOut E{P.out, (bf16_t*)(P.ws + WS_XB), nullptr, 1};
        pg8::gemm_phase<EpiOut, pg8::StaticOrder, true, true>(lds, g, S, E);
    }
#ifdef PROBE_A
    if (bx == PROBE_BX && tid == 0) {
#ifdef PROBE_CLK
        const unsigned dt = (unsigned)(1000.f * (float)(MISC[80 + PROBE_B] - MISC[80 + PROBE_A]) / (float)(MISC[40 + PROBE_B] - MISC[40 + PROBE_A])), t0 = (unsigned)__builtin_amdgcn_s_memrealtime();
#else
        const unsigned dt = (MISC[40 + PROBE_B] - MISC[40 + PROBE_A]) * 8u, t0 = (unsigned)__builtin_amdgcn_s_memrealtime();
#endif
        while ((unsigned)__builtin_amdgcn_s_memrealtime() - t0 < dt) __builtin_amdgcn_s_sleep(8);
    }
#endif
#undef IN
#undef SEAM
}
static void fill_args(KArgs& a, void* const* d_in, void* d_out, void* d_ws) {
    const float** p = (const float**)&a;
    for (int i = 0; i < 28; ++i) p[i] = (const float*)d_in[i];
    a.out = (float*)d_out; a.ws = (unsigned char*)d_ws; a.ph_lo = 0; a.ph_hi = NPHASE; a.flags = 31; a.pad = 0;
}
static int g_grid = 0;
extern "C" void kernel_launch(void* const* d_in, const int* in_sizes, int n_in, void* d_out, int out_size, void* d_ws, size_t ws_size, hipStream_t stream) {
    if (n_in != 28 || out_size != NT * DM || ws_size < WS_END) { fprintf(stderr, "kernel_launch: unexpected shapes n_in %d out %d ws %zu\n", n_in, out_size, ws_size); return; }
    if (g_grid == 0) {
        int dev = 0, cus = 0;
        if (hipGetDevice(&dev) != hipSuccess || hipDeviceGetAttribute(&cus, hipDeviceAttributeMultiprocessorCount, dev) != hipSuccess) { fprintf(stderr, "kernel_launch: device query failed\n"); g_grid = -1; return; }
        if (hipFuncSetAttribute((const void*)mk_fwd, hipFuncAttributeMaxDynamicSharedMemorySize, LDS_BYTES) != hipSuccess) { fprintf(stderr, "kernel_launch: hipFuncSetAttribute failed\n"); g_grid = -1; return; }
        int per_cu = 0;
        if (hipOccupancyMaxActiveBlocksPerMultiprocessor(&per_cu, (const void*)mk_fwd, 512, LDS_BYTES) != hipSuccess || per_cu < 1) { fprintf(stderr, "kernel_launch: occupancy query says %d blocks/CU\n", per_cu); }
        (void)hipGetLastError();
        g_grid = cus;
    }
    if (g_grid < 0) return;
    KArgs a{}; fill_args(a, d_in, d_out, d_ws);
    (void)hipMemsetAsync((char*)d_ws + WS_CTL, 0, 64 * 1024, stream);
    hipLaunchKernelGGL(mk_fwd, dim3(g_grid), dim3(512), LDS_BYTES, stream, a);
}
```

```cpp
#include <hip/hip_runtime.h>
#include <stdint.h>
#include <stdio.h>

typedef unsigned short bf16_t;
constexpr int NB = 8, SEQ = 2048, NT = NB * SEQ, DM = 1024;
#define EPSF 1e-6f
#define LOG2E 1.4426950408889634f
#define QSCALE (0.125f * 1.4426950408889634f)

constexpr size_t MiB = 1u << 20;
constexpr size_t WS_CTL = 0, WS_SSQ = 5 * MiB, WS_KMP = 1 * MiB + 512 * 1024, WS_B1P = 1 * MiB + 768 * 1024, WS_GT = 2 * MiB, WS_KC = 4 * MiB, WS_VC = 4 * MiB + 256 * 1024;
constexpr size_t WS_WIN0 = 6 * MiB, WS_WOUT0 = 13 * MiB, WS_WIN1 = 15 * MiB, WS_WOUT1 = 22 * MiB, WS_CW1 = 24 * MiB, WS_CW2 = 26 * MiB, WS_WGATE = 27 * MiB;
constexpr size_t WS_XB = 32 * MiB, WS_Y = 64 * MiB;
constexpr size_t WS_G0 = 96 * MiB, WS_ZA = 112 * MiB, WS_QB = 128 * MiB, WS_KB = 144 * MiB, WS_VB = 160 * MiB, WS_ZB = 176 * MiB;
constexpr size_t WS_QC = 96 * MiB, WS_ZC = 112 * MiB, WS_QD = 128 * MiB, WS_ZD = 144 * MiB;
constexpr size_t WS_KCR = 160 * MiB, WS_VCR = 164 * MiB, WS_KS = 168 * MiB, WS_VS = 172 * MiB, WS_KW = 176 * MiB, WS_VW = 180 * MiB, WS_KD = 184 * MiB, WS_VD = 188 * MiB;
constexpr size_t WS_NVTMP = 192 * MiB, WS_END = 200 * MiB;

struct KArgs {
    const float *x, *norm_g, *w_out, *e_w_in, *a_conv_w, *a_conv_b, *a_ln_g, *a_ln_b, *b_qnorm_g, *b_knorm_g, *o_w_in, *c_qnorm_g, *c_knorm_cmp_g, *c_knorm_slc_g,
        *c_knorm_win_g, *c_pos_k, *c_pos_v, *c_k_w1, *c_k_b1, *c_k_w2, *c_k_b2, *c_v_w1, *c_v_b1, *c_v_w2, *c_v_b2, *d_qnorm_g, *d_knorm_g, *d_sinks;
    float* out; unsigned char* ws;
    int ph_lo, ph_hi, flags, pad;
};

__device__ __forceinline__ float bf2f(unsigned v) { return __uint_as_float(v << 16); }
__device__ __forceinline__ unsigned f2bf_u(float f) { unsigned u = __float_as_uint(f); return (u + 0x7fffu + ((u >> 16) & 1u)) >> 16; }
__device__ __forceinline__ bf16_t f2bf(float f) { return (bf16_t)f2bf_u(f); }
__device__ __forceinline__ unsigned pk2(float lo, float hi) { return f2bf_u(lo) | (f2bf_u(hi) << 16); }
__device__ __forceinline__ float fast_silu(float v) { return v * __builtin_amdgcn_rcpf(1.f + __expf(-v)); }
__device__ __forceinline__ float fast_sigmoid(float v) { return __builtin_amdgcn_rcpf(1.f + __expf(-v)); }
struct NvGroup { int col, width, type; const float* gain; float scale; int dkind; void* dst; int ld, idx, col2; };

__device__ __forceinline__ NvGroup nv_group0(const KArgs& P, int gi) {
    NvGroup g; g.gain = nullptr; g.scale = 1.f; g.col2 = 0; g.width = 64;
    const int j = gi & 7;
    switch (gi >> 3) {
    case 0: g.col = 64 * j; g.col2 = 512 + 64 * j; g.type = 4; g.dkind = 0; g.dst = P.ws + WS_G0; g.ld = 512; g.idx = j; break;
    case 1: g.col = 1024 + 64 * j; g.type = 1; g.dkind = 0; g.dst = P.ws + WS_ZA; g.ld = 512; g.idx = j; break;
    case 2: g.col = 1536 + 64 * j; g.type = 2; g.gain = P.b_qnorm_g; g.scale = QSCALE; g.dkind = 1; g.dst = P.ws + WS_QB; g.ld = 8; g.idx = j; break;
    case 3: g.col = 2048 + 64 * j; g.type = 2; g.gain = P.b_knorm_g; g.dkind = 3; g.dst = P.ws + WS_KB; g.ld = 8; g.idx = j; break;
    case 4: g.col = 2560 + 64 * j; g.type = 0; g.dkind = 4; g.dst = P.ws + WS_VB; g.ld = 8; g.idx = j; break;
    default: g.col = 3072 + 64 * j; g.type = 1; g.dkind = 0; g.dst = P.ws + WS_ZB; g.ld = 512; g.idx = j; break;
    }
    return g;
}
__device__ __forceinline__ NvGroup nv_group1(const KArgs& P, int gi) {
    NvGroup g; g.gain = nullptr; g.scale = 1.f; g.col2 = 0; g.width = 64;
    if (gi < 8) { g.col = 64 * gi; g.type = 2; g.gain = P.c_qnorm_g; g.scale = QSCALE; g.dkind = 1; g.dst = P.ws + WS_QC; g.ld = 8; g.idx = gi; return g; }
    gi -= 8;
    if (gi < 12) {
        const int which = gi >> 1, hh = gi & 1;
        g.col = 512 + 128 * which + 64 * hh; g.dkind = (which < 2) ? 1 : ((which & 1) ? 4 : 3); g.ld = 2; g.idx = hh;
        g.dst = P.ws + (which == 0 ? WS_KCR : which == 1 ? WS_VCR : which == 2 ? WS_KS : which == 3 ? WS_VS : which == 4 ? WS_KW : WS_VW);
        if (which == 2) { g.type = 2; g.gain = P.c_knorm_slc_g; } else if (which == 4) { g.type = 2; g.gain = P.c_knorm_win_g; } else g.type = 0;
        return g;
    }
    gi -= 12;
    if (gi < 1) { g.col = 1280; g.width = 24; g.type = 3; g.dkind = 2; g.dst = P.ws + WS_GT; g.ld = 32; g.idx = 0; return g; }
    gi -= 1;
    if (gi < 8) { g.col = 1304 + 64 * gi; g.type = 1; g.dkind = 0; g.dst = P.ws + WS_ZC; g.ld = 512; g.idx = gi; return g; }
    gi -= 8;
    if (gi < 8) { g.col = 1816 + 64 * gi; g.type = 2; g.gain = P.d_qnorm_g; g.scale = QSCALE; g.dkind = 1; g.dst = P.ws + WS_QD; g.ld = 8; g.idx = gi; return g; }
    gi -= 8;
    if (gi < 2) { g.col = 2328 + 64 * gi; g.type = 2; g.gain = P.d_knorm_g; g.dkind = 3; g.dst = P.ws + WS_KD; g.ld = 2; g.idx = gi; return g; }
    gi -= 2;
    if (gi < 2) { g.col = 2456 + 64 * gi; g.type = 0; g.dkind = 4; g.dst = P.ws + WS_VD; g.ld = 2; g.idx = gi; return g; }
    gi -= 2;
    g.col = 2584 + 64 * gi; g.type = 1; g.dkind = 0; g.dst = P.ws + WS_ZD; g.ld = 512; g.idx = gi; return g;
}
namespace pg8 {
#define PG8_LAS __attribute__((address_space(3)))
typedef short bf16x8 __attribute__((ext_vector_type(8)));
typedef float f32x4 __attribute__((ext_vector_type(4)));
typedef unsigned u32x4 __attribute__((ext_vector_type(4)));
constexpr int BM = 256, BK = 64, HALF = 128, HTB = HALF * BK * 2  , STAGE_BYTES = 8 * HTB, NXCD = 8, WGM = 8;

__host__ __device__ __forceinline__ int lds_byte(int r, int c) { const int st = (r >> 4) * 2 + (c >> 5), rr = r & 15, cc = c & 31, ob = rr * 64 + cc * 2; return st * 1024 + (ob ^ (((ob >> 9) & 1) << 5)); }
__host__ __device__ __forceinline__ void stage_rc(int b, int& R, int& C) { const int st = b / 1024, sb = b % 1024, swz = sb ^ (((sb >> 9) & 1) << 5); R = (st >> 1) * 16 + swz / 64; C = (st & 1) * 32 + (swz % 64) / 2; }
__host__ __device__ __forceinline__ int perm32(int rho) { const int n = rho >> 4, i = rho & 15; return 8 * (i >> 2) + 4 * n + (i & 3); }

struct Unit { int pm, pn; };
struct Gemm { const bf16_t* A; const bf16_t* Bt; int M, N, K; };

struct StaticOrder {
    int nM, nN, nwg, G, c;
    __host__ __device__ void init(int M, int N, int G_, int c_) { nM = M / BM; nN = N / BM; nwg = nM * nN; G = G_; c = c_; }
    __host__ __device__ bool next(int i, Unit& u) const {
        const long L = (long)i * G + c; if (L >= nwg) return false;
        int wgid = (int)L; { const int q = nwg / NXCD, r = nwg % NXCD, xcd = wgid % NXCD, off = wgid / NXCD; wgid = (xcd < r ? xcd * (q + 1) : r * (q + 1) + (xcd - r) * q) + off; }
        const int nig = WGM * nN, gid = wgid / nig, fm = gid * WGM, gsz = (nM - fm) < WGM ? (nM - fm) : WGM;
        u.pm = fm + ((wgid % nig) % gsz); u.pn = (wgid % nig) / gsz; return true;
    }
    __device__ __forceinline__ void a_ready(const Unit&) const {}
    __device__ __forceinline__ void done(const Unit&) const {}
};

__device__ __forceinline__ unsigned cvt_pk_bf16(float lo, float hi) { unsigned r; asm volatile("v_cvt_pk_bf16_f32 %0, %1, %2" : "=v"(r) : "v"(lo), "v"(hi)); return r; }
template <class Epi, class Sched, bool ALIGN_EPI = false, bool SP2 = false>
__device__ __forceinline__ void gemm_phase(PG8_LAS unsigned char* lds, const Gemm g, const Sched& S, const Epi& E) {
    const int tid = threadIdx.x, wid = __builtin_amdgcn_readfirstlane(tid >> 6), lane = tid & 63, wr = wid >> 2, wc = wid & 3, fr = lane & 15, fq = lane >> 4;
    const int K = g.K, nt = K / BK;
    unsigned voffA[2], voffB[2];
#pragma unroll
    for (int i = 0; i < 2; ++i) { int R, C; stage_rc(tid * 16 + i * 8192, R, C); const int Rb = Epi::PERM ? ((R & ~31) + perm32(R & 31)) : R;
        voffA[i] = (unsigned)(R * K + C) * 2u; voffB[i] = (unsigned)(Rb * K + C) * 2u; }
    const size_t kstep = (size_t)(BK * 2);
    const size_t hstep = (size_t)HALF * K * 2;
    const size_t tstep = 2 * hstep;
    const unsigned ldsw = (unsigned)wid * 1024u;
    const int aoff = lds_byte(wr * 64 + fr, fq * 8), boff = lds_byte(wc * 32 + fr, fq * 8);
#define PG8_SA(b, h) (((b) * 2 + (h)) * HTB)
#define PG8_SB(b, h) ((4 + (b) * 2 + (h)) * HTB)
#define PG8_STAGE(bufoff, gbase, voff) do { _Pragma("unroll") for (int _i = 0; _i < 2; ++_i) \
        __builtin_amdgcn_global_load_lds((const unsigned*)((const char*)(gbase) + (voff)[_i]), (PG8_LAS unsigned*)(lds + (bufoff) + ldsw + _i * 8192), 16, 0, 0); } while (0)
#define PG8_LDA(dst, b, h) do { _Pragma("unroll") for (int m = 0; m < 4; ++m) _Pragma("unroll") for (int k = 0; k < 2; ++k) dst[m][k] = *(const PG8_LAS bf16x8*)(lds + PG8_SA(b, h) + aoff + m * 2048 + k * 1024); } while (0)
#define PG8_LDB(dst, b, h) do { _Pragma("unroll") for (int n = 0; n < 2; ++n) _Pragma("unroll") for (int k = 0; k < 2; ++k) dst[n][k] = *(const PG8_LAS bf16x8*)(lds + PG8_SB(b, h) + boff + n * 2048 + k * 1024); } while (0)
#define PG8_MMA(ai, bj, At, Bt) do { __builtin_amdgcn_s_setprio(1); _Pragma("unroll") for (int m = 0; m < 4; ++m) _Pragma("unroll") for (int n = 0; n < 2; ++n) _Pragma("unroll") for (int k = 0; k < 2; ++k) \
        acc[ai][bj][m][n] = __builtin_amdgcn_mfma_f32_16x16x32_bf16(Bt[n][k], At[m][k], acc[ai][bj][m][n], 0, 0, 0); __builtin_amdgcn_s_setprio(0); } while (0)
#define PG8_WAIT_V(n) asm volatile("s_waitcnt vmcnt(" #n ")" ::: "memory")
#define PG8_WAIT_L(n) asm volatile("s_waitcnt lgkmcnt(" #n ")" ::: "memory")
#define PG8_BAR __builtin_amdgcn_s_barrier()
#define PG8_SCHED __builtin_amdgcn_sched_barrier(0)
    Unit cur, nxt; int ui = 0;
    if (!S.next(0, cur)) return;
    f32x4 acc[2][2][4][2];
#pragma unroll
    for (int a = 0; a < 2; ++a)
#pragma unroll
        for (int b = 0; b < 2; ++b)
#pragma unroll
            for (int m = 0; m < 4; ++m)
#pragma unroll
                for (int n = 0; n < 2; ++n) acc[a][b][m][n] = (f32x4){0.f, 0.f, 0.f, 0.f};
    bf16x8 At[4][2], B0[2][2], B1[2][2];
    const char* cA = (const char*)g.A + (size_t)cur.pm * tstep; const char* cB = (const char*)g.Bt + (size_t)cur.pn * tstep;
    S.a_ready(cur);
    if constexpr (SP2) {
        PG8_STAGE(PG8_SB(0, 0), cB, voffB); PG8_STAGE(PG8_SB(0, 1), cB + hstep, voffB); PG8_STAGE(PG8_SA(0, 0), cA, voffA); PG8_STAGE(PG8_SA(0, 1), cA + hstep, voffA);
        if (wr == 1) PG8_BAR;
        PG8_WAIT_V(2); PG8_BAR;
        PG8_STAGE(PG8_SB(1, 0), cB + kstep, voffB); PG8_STAGE(PG8_SA(1, 0), cA + kstep, voffA); PG8_STAGE(PG8_SB(1, 1), cB + hstep + kstep, voffB);
        PG8_WAIT_V(6); PG8_BAR;
    } else {
        PG8_STAGE(PG8_SB(0, 0), cB, voffB); PG8_STAGE(PG8_SA(0, 0), cA, voffA); PG8_STAGE(PG8_SB(0, 1), cB + hstep, voffB); PG8_STAGE(PG8_SA(0, 1), cA + hstep, voffA);
        if (wr == 1) PG8_BAR;
        PG8_WAIT_V(4); PG8_BAR;
        PG8_STAGE(PG8_SB(1, 0), cB + kstep, voffB); PG8_STAGE(PG8_SA(1, 0), cA + kstep, voffA); PG8_STAGE(PG8_SB(1, 1), cB + hstep + kstep, voffB);
        PG8_WAIT_V(6); PG8_BAR;
    }
    for (;;) {
        const bool has_next = S.next(ui + 1, nxt);
        const char* nA = has_next ? (const char*)g.A + (size_t)nxt.pm * tstep : cA; const char* nB = has_next ? (const char*)g.Bt + (size_t)nxt.pn * tstep : cB;
        for (int t = 0; t < nt; t += 2) {
            const bool last = (t == nt - 2);
            const char* a1 = cA + (size_t)(t + 1) * kstep;
            const char* a2 = last ? nA : cA + (size_t)(t + 2) * kstep; const char* b2 = last ? nB : cB + (size_t)(t + 2) * kstep;
            const char* a3 = a2 + kstep; const char* b3 = b2 + kstep;
            if (last && has_next) S.a_ready(nxt);
            if constexpr (SP2) {
            PG8_LDB(B0, 0, 0); PG8_LDB(B1, 0, 1); PG8_SCHED; PG8_LDA(At, 0, 0); PG8_STAGE(PG8_SA(1, 1), a1 + hstep, voffA);
            PG8_WAIT_V(8); PG8_WAIT_L(0); PG8_BAR; PG8_MMA(0, 0, At, B0); PG8_MMA(0, 1, At, B1); PG8_BAR; PG8_SCHED;
            PG8_LDA(At, 0, 1); PG8_STAGE(PG8_SB(0, 0), b2, voffB); PG8_STAGE(PG8_SB(0, 1), b2 + hstep, voffB); PG8_STAGE(PG8_SA(0, 0), a2, voffA);
            PG8_WAIT_V(8); PG8_WAIT_L(0); PG8_BAR; PG8_MMA(1, 0, At, B0); PG8_MMA(1, 1, At, B1); PG8_BAR; PG8_SCHED;
            PG8_LDB(B0, 1, 0); PG8_LDB(B1, 1, 1); PG8_SCHED; PG8_LDA(At, 1, 0); PG8_STAGE(PG8_SA(0, 1), a2 + hstep, voffA);
            PG8_WAIT_V(8); PG8_WAIT_L(0); PG8_BAR; PG8_MMA(0, 0, At, B0); PG8_MMA(0, 1, At, B1); PG8_BAR; PG8_SCHED;
            PG8_LDA(At, 1, 1); PG8_STAGE(PG8_SB(1, 0), b3, voffB); PG8_STAGE(PG8_SB(1, 1), b3 + hstep, voffB); PG8_STAGE(PG8_SA(1, 0), a3, voffA);
            PG8_WAIT_V(8); PG8_WAIT_L(0); PG8_BAR; PG8_MMA(1, 0, At, B0); PG8_MMA(1, 1, At, B1); PG8_BAR; PG8_SCHED;
            } else {
            PG8_LDB(B0, 0, 0); PG8_SCHED; PG8_LDA(At, 0, 0); PG8_STAGE(PG8_SA(1, 1), a1 + hstep, voffA);
            PG8_WAIT_L(8); PG8_BAR; PG8_WAIT_L(0); PG8_MMA(0, 0, At, B0); PG8_BAR; PG8_SCHED;
            PG8_LDB(B1, 0, 1); PG8_STAGE(PG8_SB(0, 0), b2, voffB);
            PG8_BAR; PG8_WAIT_L(0); PG8_MMA(0, 1, At, B1); PG8_BAR;
            PG8_LDA(At, 0, 1); PG8_STAGE(PG8_SA(0, 0), a2, voffA);
            PG8_BAR; PG8_WAIT_L(0); PG8_MMA(1, 0, At, B0); PG8_BAR; PG8_SCHED;
            PG8_STAGE(PG8_SB(0, 1), b2 + hstep, voffB);
            PG8_WAIT_V(6); PG8_BAR; PG8_MMA(1, 1, At, B1); PG8_BAR;
            PG8_LDB(B0, 1, 0); PG8_SCHED; PG8_LDA(At, 1, 0); PG8_STAGE(PG8_SA(0, 1), a2 + hstep, voffA);
            PG8_WAIT_L(8); PG8_BAR; PG8_WAIT_L(0); PG8_MMA(0, 0, At, B0); PG8_BAR; PG8_SCHED;
            PG8_LDB(B1, 1, 1); PG8_STAGE(PG8_SB(1, 0), b3, voffB);
            PG8_BAR; PG8_WAIT_L(0); PG8_MMA(0, 1, At, B1); PG8_BAR;
            PG8_LDA(At, 1, 1); PG8_STAGE(PG8_SA(1, 0), a3, voffA);
            PG8_BAR; PG8_WAIT_L(0); PG8_MMA(1, 0, At, B0); PG8_BAR; PG8_SCHED;
            PG8_STAGE(PG8_SB(1, 1), b3 + hstep, voffB);
            PG8_WAIT_V(6); PG8_BAR; PG8_MMA(1, 1, At, B1); PG8_BAR;
            }
        }
        if constexpr (ALIGN_EPI) { if (wr == 0) PG8_BAR; }
        if constexpr (!Epi::AFTER_DRAIN) { E(acc, cur, wr, wc, fr, fq); S.done(cur); }
        if (!has_next) break;
#pragma unroll
        for (int a = 0; a < 2; ++a)
#pragma unroll
            for (int b = 0; b < 2; ++b)
#pragma unroll
                for (int m = 0; m < 4; ++m)
#pragma unroll
                    for (int n = 0; n < 2; ++n) acc[a][b][m][n] = (f32x4){0.f, 0.f, 0.f, 0.f};
        cur = nxt; cA = nA; cB = nB; ++ui;
        if constexpr (ALIGN_EPI) { if (wr == 1) PG8_BAR; }
    }
    PG8_WAIT_V(0);
    if constexpr (!ALIGN_EPI) { if (wr == 0) PG8_BAR; }
    PG8_BAR;
    if constexpr (Epi::AFTER_DRAIN) { E.fused(acc, cur, wr, wc, fr, fq, lds, wid, lane); S.done(cur); }
#undef PG8_SA
#undef PG8_SB
#undef PG8_STAGE
#undef PG8_LDA
#undef PG8_LDB
#undef PG8_MMA
#undef PG8_WAIT_V
#undef PG8_WAIT_L
#undef PG8_BAR
#undef PG8_SCHED
}
}
#define GAS __attribute__((address_space(1)))
#define LAS __attribute__((address_space(3)))
typedef unsigned v4u __attribute__((ext_vector_type(4)));
typedef float f32x4 __attribute__((ext_vector_type(4)));
typedef short bf16x8 __attribute__((ext_vector_type(8)));
typedef GAS unsigned gu32;
typedef GAS unsigned long long gu64;
#define RLX_AGENT __ATOMIC_RELAXED, __HIP_MEMORY_SCOPE_AGENT
#define LDS_WAIT() asm volatile("s_waitcnt lgkmcnt(0)" ::: "memory")
#define VM_WAIT() asm volatile("s_waitcnt vmcnt(0)" ::: "memory")
__device__ __forceinline__ unsigned long long rt() { return __builtin_amdgcn_s_memrealtime(); }

#define XB_TMO      128
#define XB_XCNT(j)  (256  + 64 * (j))
#define XB_XSUB(j)  (1280 + 64 * (j))
#define XB_XGEN(j)  (2304 + 64 * (j))
#define XB_TOP      3328
#define XB_TOPGEN   3392
#define XCD_BAR_WORDS 3456
#define XB_SPIN_CAP (1u << 18)

__device__ __forceinline__ unsigned xb_ld(unsigned* p)              { return __hip_atomic_load(p, __ATOMIC_RELAXED, __HIP_MEMORY_SCOPE_AGENT); }
__device__ __forceinline__ unsigned xb_add(unsigned* p, unsigned v) { return __hip_atomic_fetch_add(p, v, __ATOMIC_RELAXED, __HIP_MEMORY_SCOPE_AGENT); }
__device__ __forceinline__ unsigned xb_xcc_id() { return (unsigned)__builtin_amdgcn_s_getreg((3 << 11) | 20) & 0xFu; }
#define XB_SPIN(cond, bar) do { unsigned _sp = 0; while (cond) { __builtin_amdgcn_s_sleep(1); \
    if ((++_sp & 255u) == 0u) { if (xb_ld(&(bar)[XB_TMO])) break; if (_sp > XB_SPIN_CAP) { atomicAdd(&(bar)[XB_TMO], 1u); break; } } } } while (0)

struct XcdBarrier {
    unsigned* bar; unsigned x;
    volatile LAS unsigned* st;
};

__device__ __forceinline__ XcdBarrier xcd_barrier_post(unsigned* bar, volatile LAS unsigned* st) {
    XcdBarrier b; b.bar = bar; b.x = xb_xcc_id(); b.st = st;
    if (threadIdx.x == 0) (void)xb_add(&bar[XB_XCNT(b.x)], 1u);
    return b;
}
__device__ __forceinline__ void xcd_barrier_complete(unsigned* bar, unsigned x, unsigned& nloc, unsigned& nx) {
    const unsigned G = gridDim.x * gridDim.y * gridDim.z;
    unsigned sum, cnt, mine, sp = 0u;
    for (;;) {
        sum = 0u; cnt = 0u; mine = 0u;
#pragma unroll
        for (unsigned j = 0; j < 16; ++j) { const unsigned c = xb_ld(&bar[XB_XCNT(j)]); sum += c; cnt += (c > 0u) ? 1u : 0u; mine = (j == x) ? c : mine; }
        if (sum == G) break;
        __builtin_amdgcn_s_sleep(1);
        if ((++sp & 255u) == 0u) { if (xb_ld(&bar[XB_TMO])) break; if (sp > XB_SPIN_CAP) { atomicAdd(&bar[XB_TMO], 1u); break; } }
    }
    nloc = mine > 0u ? mine : 1u; nx = cnt > 0u ? cnt : 1u;
}

__device__ __forceinline__ void xcd_barrier(const XcdBarrier& b) {
    asm volatile("s_waitcnt vmcnt(0)" ::: "memory");
    __syncthreads();
    if (threadIdx.x == 0) {
        unsigned* bar = b.bar;
        __builtin_amdgcn_s_waitcnt(0);
        unsigned nloc = b.st[0], nx = b.st[1];
        if (nloc == 0u) { xcd_barrier_complete(bar, b.x, nloc, nx); b.st[0] = nloc; b.st[1] = nx; }
        const unsigned old = xb_add(&bar[XB_XSUB(b.x)], 1u);
        const unsigned gen = old / nloc;
        if (old + 1u == (gen + 1u) * nloc) {
            __builtin_amdgcn_fence(__ATOMIC_RELEASE, "agent");
            asm volatile("s_waitcnt vmcnt(0)" ::: "memory");
            const unsigned og = xb_add(&bar[XB_TOP], 1u);
            const unsigned tg = og / nx;
            if (og + 1u == (tg + 1u) * nx) xb_add(&bar[XB_TOPGEN], 1u);
            else XB_SPIN(xb_ld(&bar[XB_TOPGEN]) == tg, bar);
            __builtin_amdgcn_fence(__ATOMIC_ACQUIRE, "agent");
            xb_add(&bar[XB_XGEN(b.x)], 1u);
            asm volatile("s_waitcnt vmcnt(0)" ::: "memory");
        } else {
            XB_SPIN(xb_ld(&bar[XB_XGEN(b.x)]) == gen, bar);
            __builtin_amdgcn_fence(__ATOMIC_ACQUIRE, "agent");
            asm volatile("s_waitcnt vmcnt(0)" ::: "memory");
        }
    }
    __syncthreads();
}

namespace fa {
typedef short bf16x8 __attribute__((ext_vector_type(8)));
typedef short s16x4 __attribute__((ext_vector_type(4)));
typedef float f32x16 __attribute__((ext_vector_type(16)));
typedef unsigned u32x4 __attribute__((ext_vector_type(4)));
typedef short v4i16_t __attribute__((ext_vector_type(4)));
typedef __attribute__((address_space(3))) const char* lds_cptr;
typedef __attribute__((address_space(3))) char* lds_ptr;

constexpr int NSLOT = 3, SLOTB = 8192;
constexpr int LDS_K = 0, LDS_V = NSLOT * SLOTB;
constexpr int LDS_IMP = 2 * NSLOT * SLOTB;
constexpr int LDS_IMPT = LDS_IMP + 4 * 64 * 33 * 4;
constexpr int LDS_ROLE = 131072 + 320 + 4 * 110;
constexpr int LDS_SEL = 131072 - 256;
constexpr int LDS_OT = LDS_IMP;
static_assert(LDS_OT + 65536 <= LDS_SEL && LDS_IMPT + 64 * 33 * 4 <= LDS_SEL, "attention LDS map");

#define FA_NEG (-__builtin_inff())
__device__ __forceinline__ void glds16(const void* gsrc, unsigned lds_dst) { unsigned keep;
    asm volatile("s_mov_b32 %0, m0\n\ts_mov_b32 m0, %2\n\ts_nop 0\n\tglobal_load_lds_dwordx4 %1, off\n\ts_mov_b32 m0, %0" : "=&s"(keep) : "v"(gsrc), "s"(lds_dst) : "memory"); }
#define FA_WAIT_BAR(N) asm volatile("s_waitcnt vmcnt(" #N ") lgkmcnt(0)\n\ts_barrier" ::: "memory")
__device__ __forceinline__ s16x4 vtr(lds_cptr p) { return __builtin_bit_cast(s16x4, __builtin_amdgcn_ds_read_tr16_b64_v4i16((__attribute__((address_space(3))) v4i16_t*)p)); }
typedef float f32x2_t __attribute__((ext_vector_type(2))); typedef __bf16 bf16x2_t __attribute__((ext_vector_type(2)));
__device__ __forceinline__ unsigned cvtpk(float lo, float hi) { f32x2_t v = {lo, hi}; bf16x2_t b = __builtin_convertvector(v, bf16x2_t); return __builtin_bit_cast(unsigned, b); }

__device__ __forceinline__ unsigned char* launder(unsigned char* p) { asm volatile("" : "+s"(p)); return p; }
struct RowCtx {
    int hiAbs, loAbs;
    unsigned selmask; int selshift;
    float sk, lb;
};

__device__ __forceinline__ void qk_scores(lds_cptr kslot, int j, const bf16x8 (&qr)[4], const RowCtx& rc, int r32, int hi, int hk, int lk, bool rowok, f32x16& p0, f32x16& p1) {
    const float lbj = rc.sk * (float)(64 * j + 4 * hi) + rc.lb;
#pragma unroll
    for (int r = 0; r < 16; ++r) { const float c = (float)((r & 3) + 8 * (r >> 2)); p0[r] = __builtin_fmaf(rc.sk, c, lbj); p1[r] = __builtin_fmaf(rc.sk, c + 32.f, lbj); }
    const lds_cptr kp = kslot + hi * 1024 + r32 * 16;
#pragma unroll
    for (int d0 = 0; d0 < 4; ++d0) {
        const bf16x8 b0 = *(const __attribute__((address_space(3))) bf16x8*)(kp + d0 * 2048);
        const bf16x8 b1 = *(const __attribute__((address_space(3))) bf16x8*)(kp + d0 * 2048 + 512);
        p0 = __builtin_amdgcn_mfma_f32_32x32x16_bf16(b0, qr[d0], p0, 0, 0, 0);
        p1 = __builtin_amdgcn_mfma_f32_32x32x16_bf16(b1, qr[d0], p1, 0, 0, 0);
    }
    const bool full = (lk <= 0) && (hk >= 63);
    if (!__all(full)) {
        const int a = lk - 4 * hi, b = hk - 4 * hi;
#pragma unroll
        for (int r = 0; r < 16; ++r) { const int c = (r & 3) + 8 * (r >> 2);
            p0[r] = (c >= a && c <= b) ? p0[r] : FA_NEG; p1[r] = (c + 32 >= a && c + 32 <= b) ? p1[r] : FA_NEG; }
    }
    if (!__all(rowok)) {
#pragma unroll
        for (int r = 0; r < 16; ++r) { p0[r] = rowok ? p0[r] : FA_NEG; p1[r] = rowok ? p1[r] : FA_NEG; }
    }
}
__device__ __forceinline__ void pv_accum(lds_cptr vslot, const f32x16& p0, const f32x16& p1, int lane, int hi, f32x16 (&o)[2]) {
    u32x4 pw[4];
    pw[0] = (u32x4){cvtpk(p0[0], p0[1]), cvtpk(p0[2], p0[3]), cvtpk(p0[4], p0[5]), cvtpk(p0[6], p0[7])};
    pw[1] = (u32x4){cvtpk(p0[8], p0[9]), cvtpk(p0[10], p0[11]), cvtpk(p0[12], p0[13]), cvtpk(p0[14], p0[15])};
    pw[2] = (u32x4){cvtpk(p1[0], p1[1]), cvtpk(p1[2], p1[3]), cvtpk(p1[4], p1[5]), cvtpk(p1[6], p1[7])};
    pw[3] = (u32x4){cvtpk(p1[8], p1[9]), cvtpk(p1[10], p1[11]), cvtpk(p1[12], p1[13]), cvtpk(p1[14], p1[15])};
    const lds_cptr vp = vslot + ((lane >> 4) & 1) * 32 + (lane & 3) * 8 + (4 * hi + ((lane & 15) >> 2)) * 64;
#pragma unroll
    for (int d0 = 0; d0 < 2; ++d0)
#pragma unroll
        for (int ks = 0; ks < 4; ++ks) {
            const s16x4 lo = vtr(vp + d0 * 4096 + ks * 1024), hh = vtr(vp + d0 * 4096 + ks * 1024 + 512);
            const bf16x8 vf = (bf16x8){lo[0], lo[1], lo[2], lo[3], hh[0], hh[1], hh[2], hh[3]};
            o[d0] = __builtin_amdgcn_mfma_f32_32x32x16_bf16(vf, __builtin_bit_cast(bf16x8, pw[ks]), o[d0], 0, 0, 0);
        }
}
__device__ __forceinline__ float rowmax32(const f32x16& p0, const f32x16& p1) {
    float a = __builtin_fmaxf(p0[0], p1[0]);
#pragma unroll
    for (int r = 1; r < 16; ++r) a = __builtin_fmaxf(a, __builtin_fmaxf(p0[r], p1[r]));
    return __builtin_fmaxf(a, __shfl_xor(a, 32));
}


struct RowCtx2 { int hiAbs, loAbs; unsigned selmask; int selshift; float slope2; int kp_mul, kp_off; };
#define FA_THR 16.0f
__device__ __forceinline__ void attn_prefetch(lds_ptr ring, const bf16_t* Kb, const bf16_t* Vb, int jlo, int nt, int wid, int lane, bool withV) {
    if (nt <= 0) return;
    const unsigned lds0 = (unsigned)(uintptr_t)ring;
    const bf16_t* ksrc = Kb + wid * 512 + lane * 8 + (size_t)jlo * 4096;
    glds16(ksrc, (unsigned)__builtin_amdgcn_readfirstlane(lds0 + LDS_K + wid * 1024));
    if (nt > 1) glds16(ksrc + 4096, (unsigned)__builtin_amdgcn_readfirstlane(lds0 + LDS_K + SLOTB + wid * 1024));
    if (withV) { const bf16_t* vsrc = Vb + wid * 512 + lane * 8 + (size_t)jlo * 4096;
        glds16(vsrc, (unsigned)__builtin_amdgcn_readfirstlane(lds0 + LDS_V + wid * 1024)); }
}
#define FA_SBAR() __builtin_amdgcn_sched_barrier(0)
#define FA_PIN(x) asm volatile("" : "+v"(x))
__device__ __forceinline__ void attn_stream2(lds_ptr ring, const bf16_t* Kb, const bf16_t* Vb, int jlo, int jhi, const bf16x8 (&qr)[4], const RowCtx2& rc, int wid, int lane,
                                             float& m, float& l, f32x16 (&o)[2], bool chk, int pre = 0, const bf16_t* Knext = nullptr, int jlo_next = 0, int nt_next = 0, const bf16_t* zrow = nullptr, uint2* zreg = nullptr) {
    const int nt = jhi - jlo;
    if (nt <= 0) { if (Knext) attn_prefetch(ring, Knext, nullptr, jlo_next, nt_next, wid, lane, false); return; }
    const int r32 = lane & 31, hi = lane >> 5;
    const unsigned lds0 = (unsigned)(uintptr_t)ring;
    const bf16_t* ksrc = Kb + wid * 512 + lane * 8;
    const bf16_t* vsrc = Vb + wid * 512 + lane * 8;
    const unsigned kdst = lds0 + LDS_K + wid * 1024, vdst = lds0 + LDS_V + wid * 1024;
#define FA_DMAK(j_, so_) glds16(ksrc + (size_t)(j_) * 4096, (unsigned)__builtin_amdgcn_readfirstlane(kdst + (so_)))
#define FA_DMAV(j_, so_) glds16(vsrc + (size_t)(j_) * 4096, (unsigned)__builtin_amdgcn_readfirstlane(vdst + (so_)))
    if (pre == 0) { FA_DMAK(jlo, 0); if (nt > 1) FA_DMAK(jlo + 1, SLOTB); }
    if (pre < 2) FA_DMAV(jlo, 0);
    const lds_cptr kbase = (lds_cptr)ring + LDS_K + hi * 1024 + r32 * 16;
    const lds_cptr vbase = (lds_cptr)ring + LDS_V + ((lane >> 4) & 1) * 32 + (lane & 3) * 8 + (4 * hi + ((lane & 15) >> 2)) * 64;
    const float skm = rc.slope2 * (float)rc.kp_mul;
    const float a0v = hi ? 1.f : skm * (float)r32, a1v = hi ? 1.f : skm * (float)(r32 + 32);
#define FA_ZERO16 ((f32x16){0.f, 0.f, 0.f, 0.f, 0.f, 0.f, 0.f, 0.f, 0.f, 0.f, 0.f, 0.f, 0.f, 0.f, 0.f, 0.f})
#define FA_MFMA(a, b, c) __builtin_amdgcn_mfma_f32_32x32x16_bf16(a, b, c, 0, 0, 0)
#define FA_KLOAD2(kp, d0) do { kf[2 * (d0)] = *(const __attribute__((address_space(3))) bf16x8*)((kp) + (d0) * 2048); kf[2 * (d0) + 1] = *(const __attribute__((address_space(3))) bf16x8*)((kp) + (d0) * 2048 + 512); } while (0)
    f32x16 pA0, pA1, pB0, pB1; bf16x8 kf[8]; s16x4 vlo[8], vhi[8]; u32x4 pw0, pw1, pw2, pw3;
    int sl_prev = 0, sl_cur = 0, sl_next = SLOTB;
#define FA_ROT() do { sl_prev = sl_cur; sl_cur = sl_next; sl_next = (sl_next == 2 * SLOTB) ? 0 : sl_next + SLOTB; } while (0)
#define FA_TILEPAR(tt_) const int j = jlo + (tt_); int hk = rc.hiAbs - 64 * j; hk = hk > 63 ? 63 : hk; int lk = rc.loAbs - 64 * j; lk = lk < 0 ? 0 : lk; \
        const bool rowok = ((rc.selmask >> (j >> rc.selshift)) & 1u) != 0u; \
        const float lbj = rowok ? rc.slope2 * (float)(rc.kp_mul * 64 * j + rc.kp_off) - m : FA_NEG; \
        const float bv = hi ? lbj : 1.f;
#define FA_MASK(C0, C1) do { const bool full = (lk <= 0) && (hk >= 63); if (!__all(full)) { const int a = lk - 4 * hi, b = hk - 4 * hi; \
        _Pragma("unroll") for (int r = 0; r < 16; ++r) { const int c = (r & 3) + 8 * (r >> 2); \
            C0[r] = (c >= a && c <= b) ? C0[r] : FA_NEG; C1[r] = (c + 32 >= a && c + 32 <= b) ? C1[r] : FA_NEG; } } } while (0)
#define FA_CHK(C0, C1) do { if (chk) { float mx = __builtin_fmaxf(C0[0], C1[0]); \
        _Pragma("unroll") for (int r = 1; r < 16; ++r) mx = __builtin_fmaxf(mx, __builtin_fmaxf(C0[r], C1[r])); \
        if (__any(mx > FA_THR)) { mx = __builtin_fmaxf(mx, __shfl_xor(mx, 32)); \
            const float dl = __builtin_fmaxf(mx, 0.f); fresc = __builtin_amdgcn_exp2f(-dl); m += dl; l *= fresc; resc = true; \
            _Pragma("unroll") for (int r = 0; r < 16; ++r) { C0[r] -= dl; C1[r] -= dl; } } } } while (0)
#define FA_RESC() do { if (resc) { _Pragma("unroll") for (int r = 0; r < 16; ++r) { o[0][r] *= fresc; o[1][r] *= fresc; } } } while (0)
#define FA_PKW(P, i) cvtpk(P[i], P[(i) + 1])
#define FA_PAF(k) __builtin_bit_cast(bf16x8, pw##k)
#define FA_VFR(i) (bf16x8){vlo[i][0], vlo[i][1], vlo[i][2], vlo[i][3], vhi[i][0], vhi[i][1], vhi[i][2], vhi[i][3]}
#define FA_VRD(i) do { vlo[i] = vtr(vp_ + (((i) >> 2) * 4096 + ((i) & 3) * 1024)); vhi[i] = vtr(vp_ + (((i) >> 2) * 4096 + ((i) & 3) * 1024 + 512)); } while (0)
#define FA_KRD(d0) do { FA_KLOAD2(kbase + sl_next, d0); FA_SBAR(); } while (0)
#define FA_GAPA(MF, a0, a1, a2, a3, W0, W1, PW) do { MF; sacc += a0; sacc += a1; sacc += a2; sacc += a3; W0; W1; FA_PIN(PW); FA_PIN(sacc); FA_SBAR(); } while (0)
#define FA_GAPB(MF, X, i) do { MF; X[i] = __builtin_amdgcn_exp2f(X[i]); X[(i) + 1] = __builtin_amdgcn_exp2f(X[(i) + 1]); X[(i) + 2] = __builtin_amdgcn_exp2f(X[(i) + 2]); X[(i) + 3] = __builtin_amdgcn_exp2f(X[(i) + 3]); FA_PIN(X); FA_SBAR(); } while (0)
#define FA_STEP(C0, C1, P0, P1, tt_) do { const int tt = (tt_); FA_TILEPAR(tt) \
        const lds_cptr vp_ = vbase + sl_prev; bool resc = false; float fresc = 1.f; \
        FA_SBAR(); \
        C0 = __builtin_amdgcn_mfma_f32_32x32x2f32(a0v, bv, FA_ZERO16, 0, 0, 0); C1 = __builtin_amdgcn_mfma_f32_32x32x2f32(a1v, bv, FA_ZERO16, 0, 0, 0); FA_SBAR(); \
        FA_VRD(0); FA_SBAR(); float sacc = P0[0] + P0[1]; \
                            FA_GAPA(C0 = FA_MFMA(kf[0], qr[0], C0), P0[2], P0[3], P0[4], P0[5],     pw0[0] = FA_PKW(P0, 0),  pw0[1] = FA_PKW(P0, 2),  pw0); \
        FA_VRD(4); FA_SBAR(); FA_GAPA(C1 = FA_MFMA(kf[1], qr[0], C1), P0[6], P0[7], P0[8], P0[9],     pw0[2] = FA_PKW(P0, 4),  pw0[3] = FA_PKW(P0, 6),  pw0); \
        FA_VRD(1); FA_SBAR(); FA_GAPA(C0 = FA_MFMA(kf[2], qr[1], C0), P0[10], P0[11], P0[12], P0[13], pw1[0] = FA_PKW(P0, 8),  pw1[1] = FA_PKW(P0, 10), pw1); \
        FA_VRD(5); FA_SBAR(); FA_GAPA(C1 = FA_MFMA(kf[3], qr[1], C1), P0[14], P0[15], P1[0], P1[1],   pw1[2] = FA_PKW(P0, 12), pw1[3] = FA_PKW(P0, 14), pw1); \
        FA_VRD(2); FA_SBAR(); FA_GAPA(C0 = FA_MFMA(kf[4], qr[2], C0), P1[2], P1[3], P1[4], P1[5],     pw2[0] = FA_PKW(P1, 0),  pw2[1] = FA_PKW(P1, 2),  pw2); \
        FA_VRD(6); FA_SBAR(); FA_GAPA(C1 = FA_MFMA(kf[5], qr[2], C1), P1[6], P1[7], P1[8], P1[9],     pw2[2] = FA_PKW(P1, 4),  pw2[3] = FA_PKW(P1, 6),  pw2); \
        FA_VRD(3); FA_SBAR(); FA_GAPA(C0 = FA_MFMA(kf[6], qr[3], C0), P1[10], P1[11], P1[12], P1[13], pw3[0] = FA_PKW(P1, 8),  pw3[1] = FA_PKW(P1, 10), pw3); \
        FA_VRD(7); FA_SBAR(); FA_GAPA(C1 = FA_MFMA(kf[7], qr[3], C1), P1[14], P1[15], 0.f, 0.f,       pw3[2] = FA_PKW(P1, 12), pw3[3] = FA_PKW(P1, 14), pw3); \
        l += sacc; \
        if (tt + 3 < nt) FA_DMAK(j + 3, sl_cur);                   \
        if (tt + 1 < nt) FA_DMAV(j + 1, sl_next); \
        FA_MASK(C0, C1); FA_CHK(C0, C1); FA_SBAR(); \
        FA_GAPB(o[0] = FA_MFMA(FA_VFR(0), FA_PAF(0), o[0]), C0, 0);              FA_GAPB(o[1] = FA_MFMA(FA_VFR(4), FA_PAF(0), o[1]), C0, 4); \
        FA_KRD(0); FA_GAPB(o[0] = FA_MFMA(FA_VFR(1), FA_PAF(1), o[0]), C0, 8);   FA_KRD(1); FA_GAPB(o[1] = FA_MFMA(FA_VFR(5), FA_PAF(1), o[1]), C0, 12);     \
        FA_KRD(2); FA_GAPB(o[0] = FA_MFMA(FA_VFR(2), FA_PAF(2), o[0]), C1, 0);   FA_KRD(3); FA_GAPB(o[1] = FA_MFMA(FA_VFR(6), FA_PAF(2), o[1]), C1, 4); \
        FA_GAPB(o[0] = FA_MFMA(FA_VFR(3), FA_PAF(3), o[0]), C1, 8);              FA_GAPB(o[1] = FA_MFMA(FA_VFR(7), FA_PAF(3), o[1]), C1, 12); \
        FA_RESC(); \
    } while (0)
#define FA_ENDW(tt) do { if ((tt) + 3 < nt) { FA_WAIT_BAR(2); } else if ((tt) + 2 < nt) { FA_WAIT_BAR(1); } else { FA_WAIT_BAR(0); } } while (0)
    FA_WAIT_BAR(0);
    if (nt > 2) FA_DMAK(jlo + 2, 2 * SLOTB);
    _Pragma("unroll") for (int d0 = 0; d0 < 4; ++d0) FA_KLOAD2(kbase, d0);
    {   FA_TILEPAR(0) bool resc = false; float fresc = 1.f;
        pA0 = __builtin_amdgcn_mfma_f32_32x32x2f32(a0v, bv, FA_ZERO16, 0, 0, 0); pA1 = __builtin_amdgcn_mfma_f32_32x32x2f32(a1v, bv, FA_ZERO16, 0, 0, 0);
        _Pragma("unroll") for (int d0 = 0; d0 < 4; ++d0) { pA0 = FA_MFMA(kf[2 * d0], qr[d0], pA0); pA1 = FA_MFMA(kf[2 * d0 + 1], qr[d0], pA1); }
        FA_MASK(pA0, pA1); FA_CHK(pA0, pA1); FA_RESC();
        _Pragma("unroll") for (int r = 0; r < 16; ++r) { pA0[r] = __builtin_amdgcn_exp2f(pA0[r]); pA1[r] = __builtin_amdgcn_exp2f(pA1[r]); } }
    FA_WAIT_BAR(1);
    if (nt > 1) {
        if (nt > 3) FA_DMAK(jlo + 3, 0);
        FA_DMAV(jlo + 1, SLOTB); FA_ROT();
        _Pragma("unroll") for (int d0 = 0; d0 < 4; ++d0) FA_KLOAD2(kbase + sl_cur, d0);
        if (nt > 3) FA_WAIT_BAR(2); else FA_WAIT_BAR(0);
        int t = 1;
        for (; t + 1 < nt; t += 2) {
            FA_STEP(pB0, pB1, pA0, pA1, t); FA_ENDW(t); FA_ROT();
            FA_STEP(pA0, pA1, pB0, pB1, t + 1); if (t + 2 < nt) { FA_ENDW(t + 1); FA_ROT(); }
        }
        if (t < nt) { FA_STEP(pB0, pB1, pA0, pA1, t); pA0 = pB0; pA1 = pB1; }
    }
    if (Knext) attn_prefetch(ring, Knext, nullptr, jlo_next, nt_next, wid, lane, false);
    if (zrow) {
#pragma unroll
        for (int d0 = 0; d0 < 2; ++d0)
#pragma unroll
            for (int g4 = 0; g4 < 4; ++g4) zreg[d0 * 4 + g4] = *(const uint2*)(zrow + 32 * d0 + 8 * g4 + 4 * hi);
    }
    {   float sacc = pA0[0] + pA1[0];
#pragma unroll
        for (int r = 1; r < 16; ++r) sacc += pA0[r] + pA1[r];
        l += sacc;
        pw0 = (u32x4){FA_PKW(pA0, 0), FA_PKW(pA0, 2), FA_PKW(pA0, 4), FA_PKW(pA0, 6)}; pw1 = (u32x4){FA_PKW(pA0, 8), FA_PKW(pA0, 10), FA_PKW(pA0, 12), FA_PKW(pA0, 14)};
        pw2 = (u32x4){FA_PKW(pA1, 0), FA_PKW(pA1, 2), FA_PKW(pA1, 4), FA_PKW(pA1, 6)}; pw3 = (u32x4){FA_PKW(pA1, 8), FA_PKW(pA1, 10), FA_PKW(pA1, 12), FA_PKW(pA1, 14)};
        const lds_cptr vp_ = vbase + sl_cur;
        _Pragma("unroll") for (int i = 0; i < 8; ++i) FA_VRD(i);
        o[0] = FA_MFMA(FA_VFR(0), FA_PAF(0), o[0]); o[1] = FA_MFMA(FA_VFR(4), FA_PAF(0), o[1]); o[0] = FA_MFMA(FA_VFR(1), FA_PAF(1), o[0]); o[1] = FA_MFMA(FA_VFR(5), FA_PAF(1), o[1]);
        o[0] = FA_MFMA(FA_VFR(2), FA_PAF(2), o[0]); o[1] = FA_MFMA(FA_VFR(6), FA_PAF(2), o[1]); o[0] = FA_MFMA(FA_VFR(3), FA_PAF(3), o[0]); o[1] = FA_MFMA(FA_VFR(7), FA_PAF(3), o[1]); }
    asm volatile("s_waitcnt lgkmcnt(0)\n\ts_barrier" ::: "memory");
#undef FA_DMAK
#undef FA_DMAV
#undef FA_ZERO16
#undef FA_MFMA
#undef FA_KLOAD2
#undef FA_ROT
#undef FA_TILEPAR
#undef FA_MASK
#undef FA_CHK
#undef FA_RESC
#undef FA_PKW
#undef FA_PAF
#undef FA_VFR
#undef FA_VRD
#undef FA_KRD
#undef FA_GAPA
#undef FA_GAPB
#undef FA_STEP
#undef FA_ENDW
}

__device__ __forceinline__ bool need_maxcheck(const bf16x8 (&qr)[4], const float* gk, int lane, float refslack) {
    float qn = 0.f;
#pragma unroll
    for (int d0 = 0; d0 < 4; ++d0)
#pragma unroll
        for (int i = 0; i < 8; ++i) { const float v = bf2f((unsigned short)qr[d0][i]); qn += v * v; }
    qn += __shfl_xor(qn, 32);
    float gm = __builtin_fabsf(gk[lane]);
#pragma unroll
    for (int o = 1; o < 64; o <<= 1) gm = __builtin_fmaxf(gm, __shfl_xor(gm, o));
    const float bound = sqrtf(qn) * gm * 8.04f + refslack;
    return __any(!(bound <= FA_THR)) != 0;
}
__device__ __forceinline__ void store_oz(const f32x16 (&o)[2], float w, const uint2* zreg, bf16_t* Y, int t, int ycol, int hi) {
#pragma unroll
    for (int d0 = 0; d0 < 2; ++d0)
#pragma unroll
        for (int g4 = 0; g4 < 4; ++g4) {
            const int d = 32 * d0 + 8 * g4 + 4 * hi;
            const uint2 z = zreg[d0 * 4 + g4];
            const float v0 = o[d0][4 * g4 + 0] * w * bf2f(z.x & 0xffff), v1 = o[d0][4 * g4 + 1] * w * bf2f(z.x >> 16);
            const float v2 = o[d0][4 * g4 + 2] * w * bf2f(z.y & 0xffff), v3 = o[d0][4 * g4 + 3] * w * bf2f(z.y >> 16);
            uint2 y; y.x = cvtpk(v0, v1); y.y = cvtpk(v2, v3);
            *(uint2*)(Y + (size_t)t * 1024 + ycol + d) = y;
        }
}
__device__ __forceinline__ void load_q(bf16x8 (&qr)[4], const bf16_t* Qrow, int hi) {
#pragma unroll
    for (int d0 = 0; d0 < 4; ++d0) qr[d0] = *(const bf16x8*)(Qrow + d0 * 16 + hi * 8);
}

#ifdef PROBE_A
#define FA_STAMP(n) do { if (blockIdx.x == 0 && threadIdx.x == 0) ((volatile __attribute__((address_space(3))) unsigned*)(ring + 131072 + 320))[40 + (n)] = (unsigned)__builtin_amdgcn_s_memrealtime(); } while (0)
#else
#define FA_STAMP(n) do {} while (0)
#endif
__device__ __forceinline__ void moba_unit(const KArgs& P, lds_ptr ring, int b, int h, int own, int wid, int lane) {
    unsigned char* ws = launder(P.ws); asm volatile("" : "+v"(lane));
    const bf16_t* QB = (const bf16_t*)(ws + WS_QB); const bf16_t* KB = (const bf16_t*)(ws + WS_KB); const bf16_t* VB = (const bf16_t*)(ws + WS_VB);
    const float* KMP = (const float*)(ws + WS_KMP); const bf16_t* ZB = (const bf16_t*)(ws + WS_ZB); bf16_t* Y = (bf16_t*)(ws + WS_Y);
    const int r32 = lane & 31, hi = lane >> 5;
    const int sq = own * 256 + 32 * wid + r32, t = b * SEQ + sq;
    const size_t hb = (size_t)(b * 8 + h) * SEQ;
    FA_STAMP(own == 7 ? 24 : 28);
    attn_prefetch(ring, KB + hb * 64, VB + hb * 64, 0, 4 * own + 4, wid, lane, true);
    bf16x8 qr[4]; load_q(qr, QB + (hb + sq) * 64, hi);
    __attribute__((address_space(3))) float* kmS = (__attribute__((address_space(3))) float*)(ring + LDS_IMP);
    { const int tid = wid * 64 + lane, n = tid >> 6, d = tid & 63;
      const float* k0 = KMP + (size_t)(b * 8 + n) * 512 + h * 64 + d;
      kmS[tid] = k0[0] + k0[64 * 512]; }
    asm volatile("s_waitcnt vmcnt(0) lgkmcnt(0)\n\ts_barrier" ::: "memory");
    float gate[8];
#pragma unroll
    for (int n = 0; n < 8; ++n) gate[n] = -1e30f;
    if (own > 0) {
        float qf[32];
#pragma unroll
        for (int d0 = 0; d0 < 4; ++d0)
#pragma unroll
            for (int i = 0; i < 8; ++i) qf[8 * d0 + i] = bf2f((unsigned short)qr[d0][i]);
#pragma unroll
        for (int n = 0; n < 7; ++n) {
            float part = 0.f;
#pragma unroll
            for (int d0 = 0; d0 < 4; ++d0)
#pragma unroll
                for (int i = 0; i < 8; ++i) part += qf[8 * d0 + i] * kmS[n * 64 + d0 * 16 + hi * 8 + i];
            const float g = part + __shfl_xor(part, 32);
            gate[n] = n < own ? g : -1e30f;
        }
    }
    FA_STAMP(own == 7 ? 32 : 36);
    unsigned sel = 0;
#pragma unroll
    for (int it = 0; it < 3; ++it) {
        float best = -3e38f; int bi = 0;
#pragma unroll
        for (int n = 0; n < 8; ++n) { const bool ok = !((sel >> n) & 1u) && gate[n] > best; best = ok ? gate[n] : best; bi = ok ? n : bi; }
        sel |= 1u << bi;
    }
    FA_STAMP(own == 7 ? 33 : 37);
    sel &= (1u << own) - 1u;
    sel |= 1u << own;
    const float slope2 = exp2f(-(float)(h + 1)) * LOG2E;
    RowCtx2 rc; rc.hiAbs = sq; rc.loAbs = -(1 << 30); rc.selmask = sel; rc.selshift = 2; rc.slope2 = slope2; rc.kp_mul = 1; rc.kp_off = -sq;
    float m = 0.f, l = 0.f; f32x16 o[2]; uint2 zreg[8];
#pragma unroll
    for (int r = 0; r < 16; ++r) { o[0][r] = 0.f; o[1][r] = 0.f; }
    FA_STAMP(own == 7 ? 25 : 29);
    attn_stream2(ring, KB + hb * 64, VB + hb * 64, 0, 4 * own + 4, qr, rc, wid, lane, m, l, o, need_maxcheck(qr, P.b_knorm_g, lane, 0.f), 2, nullptr, 0, 0, ZB + (size_t)t * 512 + h * 64, zreg);
    FA_STAMP(own == 7 ? 26 : 30);
    l += __shfl_xor(l, 32);
    const float inv = l > 0.f ? 1.0f / l : 0.f;
    store_oz(o, inv, zreg, Y, t, 512 + h * 64, hi);
    FA_STAMP(own == 7 ? 27 : 31);
}

__device__ __forceinline__ void swa_unit(const KArgs& P, lds_ptr ring, int b, int g, int c, int wid, int lane) {
    unsigned char* ws = launder(P.ws); asm volatile("" : "+v"(lane));
    const bf16_t* QD = (const bf16_t*)(ws + WS_QD); const bf16_t* KD = (const bf16_t*)(ws + WS_KD); const bf16_t* VD = (const bf16_t*)(ws + WS_VD);
    const bf16_t* ZD = (const bf16_t*)(ws + WS_ZD); bf16_t* Y = (bf16_t*)(ws + WS_Y);
    const int r32 = lane & 31, hi = lane >> 5, h = 4 * g + (wid >> 1);
    const int sq = 64 * c + 32 * (wid & 1) + r32, t = b * SEQ + sq;
    const size_t gb = (size_t)(b * 2 + g) * SEQ * 64;
    attn_prefetch(ring, KD + gb, VD + gb, c >= 2 ? c - 2 : 0, c >= 2 ? 3 : c + 1, wid, lane, true);
    bf16x8 qr[4]; load_q(qr, QD + ((size_t)(b * 8 + h) * SEQ + sq) * 64, hi);
    const float slope2 = exp2f(-(float)(h + 1)) * LOG2E;
    RowCtx2 rc; rc.hiAbs = sq; rc.loAbs = sq - 127; rc.selmask = 0xffffffffu; rc.selshift = 0; rc.slope2 = slope2; rc.kp_mul = 1; rc.kp_off = -sq;
    float m = P.d_sinks[h] * LOG2E, l = hi == 0 ? 1.f : 0.f; f32x16 o[2]; uint2 zreg[8];
#pragma unroll
    for (int r = 0; r < 16; ++r) { o[0][r] = 0.f; o[1][r] = 0.f; }
    attn_stream2(ring, KD + gb, VD + gb, c >= 2 ? c - 2 : 0, c + 1, qr, rc, wid, lane, m, l, o, need_maxcheck(qr, P.d_knorm_g, lane, __builtin_fabsf(m)), 2, nullptr, 0, 0, ZD + (size_t)t * 512 + h * 64, zreg);
    l += __shfl_xor(l, 32);
    store_oz(o, 1.0f / l, zreg, Y, t, 512 + h * 64, hi);
}

__device__ __forceinline__ void nsa_unit(const KArgs& P, lds_ptr ring, int b, int g, int c, int wid, int lane, int tid) {
    unsigned char* ws = launder(P.ws); asm volatile("" : "+v"(lane));
    const bf16_t* QC = (const bf16_t*)(ws + WS_QC); const bf16_t* KC = (const bf16_t*)(ws + WS_KC); const bf16_t* VC = (const bf16_t*)(ws + WS_VC);
    const bf16_t* KS = (const bf16_t*)(ws + WS_KS); const bf16_t* VS = (const bf16_t*)(ws + WS_VS);
    const bf16_t* KW = (const bf16_t*)(ws + WS_KW); const bf16_t* VW = (const bf16_t*)(ws + WS_VW);
    const float* GT = (const float*)(ws + WS_GT); const bf16_t* ZC = (const bf16_t*)(ws + WS_ZC); bf16_t* Y = (bf16_t*)(ws + WS_Y);
    const int r32 = lane & 31, hi = lane >> 5, hh = wid >> 1, h = 4 * g + hh;
    const int tok = 32 * (wid & 1) + r32, sq = 64 * c + tok, t = b * SEQ + sq;
    if (c == 31) FA_STAMP(44);
    bf16x8 qr[4]; load_q(qr, QC + ((size_t)(b * 8 + h) * SEQ + sq) * 64, hi);
    const float slope2 = exp2f(-(float)(h + 1)) * LOG2E;
    const size_t gbe = (size_t)(b * 2 + g) * SEQ * 64;
    const float g0 = GT[(size_t)t * 32 + h], g1 = GT[(size_t)t * 32 + 8 + h], g2 = GT[(size_t)t * 32 + 16 + h];
    f32x16 o[2];
#pragma unroll
    for (int r = 0; r < 16; ++r) { o[0][r] = 0.f; o[1][r] = 0.f; }
    __attribute__((address_space(3))) float* otS = (__attribute__((address_space(3))) float*)(ring + LDS_OT) + wid * 2048 + lane;
    __attribute__((address_space(3))) float* impH = (__attribute__((address_space(3))) float*)(ring + LDS_IMP);
    __attribute__((address_space(3))) float* impT = (__attribute__((address_space(3))) float*)(ring + LDS_IMPT);
    __attribute__((address_space(3))) unsigned* selS = (__attribute__((address_space(3))) unsigned*)(ring + LDS_SEL);
    {
        const bf16_t* kc = KC + (size_t)(b * 2 + g) * 128 * 64; const bf16_t* vc = VC + (size_t)(b * 2 + g) * 128 * 64;
        const unsigned lds0 = (unsigned)(uintptr_t)ring;
        const bf16_t* ksrc = kc + wid * 512 + lane * 8;
        const bf16_t* vsrc = vc + wid * 512 + lane * 8;
        glds16(ksrc, (unsigned)__builtin_amdgcn_readfirstlane(lds0 + LDS_K + wid * 1024)); glds16(vsrc, (unsigned)__builtin_amdgcn_readfirstlane(lds0 + LDS_V + wid * 1024));
        glds16(ksrc + 4096, (unsigned)__builtin_amdgcn_readfirstlane(lds0 + LDS_K + SLOTB + wid * 1024)); glds16(vsrc + 4096, (unsigned)__builtin_amdgcn_readfirstlane(lds0 + LDS_V + SLOTB + wid * 1024));
        FA_WAIT_BAR(0);
        RowCtx rc; int hc = (sq - 31) >> 4; rc.hiAbs = hc > 126 ? 126 : hc; rc.loAbs = -(1 << 30); rc.selmask = 0xffffffffu; rc.selshift = 0; rc.sk = 16.f * slope2; rc.lb = slope2 * (float)(31 - 64 * c);
        f32x16 a0, a1, b0, b1;
        { int hk = rc.hiAbs; hk = hk > 63 ? 63 : hk; qk_scores((lds_cptr)ring + LDS_K, 0, qr, rc, r32, hi, hk, 0, true, a0, a1); }
        { int hk = rc.hiAbs - 64; hk = hk > 63 ? 63 : hk; qk_scores((lds_cptr)ring + LDS_K + SLOTB, 1, qr, rc, r32, hi, hk, 0, true, b0, b1); }
        float mx = __builtin_fmaxf(rowmax32(a0, a1), rowmax32(b0, b1));
        mx = mx > -1e37f ? mx : 0.f;
        float sum = 0.f;
#pragma unroll
        for (int r = 0; r < 16; ++r) { a0[r] = __builtin_amdgcn_exp2f(a0[r] - mx); a1[r] = __builtin_amdgcn_exp2f(a1[r] - mx); b0[r] = __builtin_amdgcn_exp2f(b0[r] - mx); b1[r] = __builtin_amdgcn_exp2f(b1[r] - mx);
            sum += (a0[r] + a1[r]) + (b0[r] + b1[r]); }
        sum += __shfl_xor(sum, 32);
        const float inv = sum > 0.f ? 1.0f / sum : 0.f;
#pragma unroll
        for (int r = 0; r < 16; ++r) { a0[r] *= inv; a1[r] *= inv; b0[r] *= inv; b1[r] *= inv; }
        float ss[16], ee[16];
#pragma unroll
        for (int i = 0; i < 4; ++i) {
            ss[i] = (a0[4 * i] + a0[4 * i + 1]) + (a0[4 * i + 2] + a0[4 * i + 3]); ee[i] = a0[4 * i + 3];
            ss[4 + i] = (a1[4 * i] + a1[4 * i + 1]) + (a1[4 * i + 2] + a1[4 * i + 3]); ee[4 + i] = a1[4 * i + 3];
            ss[8 + i] = (b0[4 * i] + b0[4 * i + 1]) + (b0[4 * i + 2] + b0[4 * i + 3]); ee[8 + i] = b0[4 * i + 3];
            ss[12 + i] = (b1[4 * i] + b1[4 * i + 1]) + (b1[4 * i + 2] + b1[4 * i + 3]); ee[12 + i] = b1[4 * i + 3];
        }
        float ep[16];
#pragma unroll
        for (int k = 0; k < 16; ++k) ep[k] = __shfl_xor(ee[k], 32);
#pragma unroll
        for (int k = 0; k < 16; ++k) {
            const float prev = k > 0 ? ep[k > 0 ? k - 1 : 0] : 0.f;
            const float v = ss[k] + (hi ? ep[k] : prev);
            impH[(hh * 64 + tok) * 33 + 2 * k + hi] = v;
        }
        pv_accum((lds_cptr)ring + LDS_V, a0, a1, lane, hi, o);
        pv_accum((lds_cptr)ring + LDS_V + SLOTB, b0, b1, lane, hi, o);
        asm volatile("s_waitcnt lgkmcnt(0)\n\ts_barrier" ::: "memory");
        attn_prefetch(ring, KS + gbe, VS + gbe, 0, c + 1, wid, lane, true);
        {
            const int tk = tid >> 3, part = tid & 7;
#pragma unroll
            for (int i = 0; i < 4; ++i) { const int n = 4 * part + i;
                float v = (impH[(0 * 64 + tk) * 33 + n] + impH[(1 * 64 + tk) * 33 + n]) + (impH[(2 * 64 + tk) * 33 + n] + impH[(3 * 64 + tk) * 33 + n]);
                if (n == 0 || n == c || n == c - 1) v = 1e4f;
                if (n > c) v = -1e30f;
                impT[tk * 33 + n] = v; }
            asm volatile("s_waitcnt lgkmcnt(0)\n\ts_barrier" ::: "memory");
            float mine[4]; int rank[4];
#pragma unroll
            for (int i = 0; i < 4; ++i) { mine[i] = impT[tk * 33 + 4 * part + i]; rank[i] = 0; }
#pragma unroll 1
            for (int mI = 0; mI < 32; ++mI) { const float v = impT[tk * 33 + mI];
#pragma unroll
                for (int i = 0; i < 4; ++i) rank[i] += (v > mine[i] || (v == mine[i] && mI < 4 * part + i)) ? 1 : 0; }
            unsigned bits = 0;
#pragma unroll
            for (int i = 0; i < 4; ++i) if (rank[i] < 16) bits |= 1u << (4 * part + i);
            bits |= __shfl_xor(bits, 1); bits |= __shfl_xor(bits, 2); bits |= __shfl_xor(bits, 4);
            if (part == 0) selS[tk] = bits;
            asm volatile("s_waitcnt lgkmcnt(0)\n\ts_barrier" ::: "memory");
        }
    }
    const unsigned sel = selS[tok];
    if (c == 31) FA_STAMP(45);
    const size_t gb = (size_t)(b * 2 + g) * SEQ * 64;
#pragma unroll
    for (int r = 0; r < 16; ++r) { otS[r * 64] = o[0][r] * g0; otS[(16 + r) * 64] = o[1][r] * g0; }
    {
        RowCtx2 rc; rc.hiAbs = sq; rc.loAbs = -(1 << 30); rc.selmask = sel; rc.selshift = 0; rc.slope2 = slope2; rc.kp_mul = 1; rc.kp_off = -sq;
        float m = 0.f, l = 0.f;
#pragma unroll
        for (int r = 0; r < 16; ++r) { o[0][r] = 0.f; o[1][r] = 0.f; }
        attn_stream2(ring, KS + gb, VS + gb, 0, c + 1, qr, rc, wid, lane, m, l, o, need_maxcheck(qr, P.c_knorm_slc_g, lane, 0.f), 2, KW + gb, c >= 8 ? c - 8 : 0, c >= 8 ? 9 : c + 1);
        l += __shfl_xor(l, 32);
        if (c == 31) FA_STAMP(46);
        const float w1 = l > 0.f ? g1 / l : 0.f;
#pragma unroll
        for (int r = 0; r < 16; ++r) { otS[r * 64] += o[0][r] * w1; otS[(16 + r) * 64] += o[1][r] * w1; }
    }
    uint2 zreg[8];
    {
        RowCtx2 rc; rc.hiAbs = sq; rc.loAbs = sq - 511; rc.selmask = 0xffffffffu; rc.selshift = 0; rc.slope2 = slope2; rc.kp_mul = 1; rc.kp_off = -sq;
        float m = 0.f, l = 0.f;
#pragma unroll
        for (int r = 0; r < 16; ++r) { o[0][r] = 0.f; o[1][r] = 0.f; }
        attn_stream2(ring, KW + gb, VW + gb, c >= 8 ? c - 8 : 0, c + 1, qr, rc, wid, lane, m, l, o, need_maxcheck(qr, P.c_knorm_win_g, lane, 0.f), 1, nullptr, 0, 0, ZC + (size_t)t * 512 + h * 64, zreg);
        l += __shfl_xor(l, 32);
        if (c == 31) FA_STAMP(47);
        const float w2 = l > 0.f ? g2 / l : 0.f;
#pragma unroll
        for (int r = 0; r < 16; ++r) { o[0][r] = o[0][r] * w2 + otS[r * 64]; o[1][r] = o[1][r] * w2 + otS[(16 + r) * 64]; }
    }
    store_oz(o, 1.f, zreg, Y, t, h * 64, hi);
    if (c == 31) FA_STAMP(48);
}
}
namespace fm {
typedef short bf16x8 __attribute__((ext_vector_type(8)));
typedef float f32x4 __attribute__((ext_vector_type(4)));
typedef float f32x2 __attribute__((ext_vector_type(2)));
__device__ __forceinline__ float wave_sum(float v) {
#pragma unroll
    for (int o = 1; o < 64; o <<= 1) v += __shfl_xor(v, o);
    return v;
}
struct ConvW { float w0[31], w1[31]; float2 bias; float4 ga, gb, ba, bb2; };
__device__ __forceinline__ void conv_load_w(const KArgs& P, ConvW& W, int tid, int lane) {
    const int cp = tid & 255;
#pragma unroll
    for (int j = 0; j < 31; ++j) { const float2 w = *(const float2*)(P.a_conv_w + j * 512 + 2 * cp); W.w0[j] = w.x; W.w1[j] = w.y; }
    W.bias = *(const float2*)(P.a_conv_b + 2 * cp);
    W.ga = *(const float4*)(P.a_ln_g + 4 * lane); W.gb = *(const float4*)(P.a_ln_g + 256 + 4 * lane);
    W.ba = *(const float4*)(P.a_ln_b + 4 * lane); W.bb2 = *(const float4*)(P.a_ln_b + 256 + 4 * lane);
}
__device__ __forceinline__ void conv_unit(const KArgs& P, LAS unsigned char* lds, int u, const ConvW& W, int tid, int wave, int lane) {
    const bf16_t* G0 = (const bf16_t*)(P.ws + WS_G0); const bf16_t* ZA = (const bf16_t*)(P.ws + WS_ZA); bf16_t* Y = (bf16_t*)(P.ws + WS_Y);
    LAS float* cy = (LAS float*)lds;
    const int cp = tid & 255, sb = tid >> 8;
    {
        const int t0 = u * 32, s0 = t0 & (SEQ - 1);
        float acc0[16], acc1[16];
#pragma unroll
        for (int o = 0; o < 16; ++o) { acc0[o] = W.bias.x; acc1[o] = W.bias.y; }
        const int sbase = s0 + 16 * sb - 30, tmin = t0 - s0, tb = t0 + 16 * sb - 30;
        unsigned xv[46];
#pragma unroll
        for (int i = 0; i < 46; ++i) { int row = tb + i; row = row < tmin ? tmin : row; xv[i] = *(const unsigned*)(G0 + (size_t)row * 512 + 2 * cp); }
#pragma unroll
        for (int i = 0; i < 46; ++i) {
            const bool ok = sbase + i >= 0;
            const float x0 = ok ? bf2f(xv[i] & 0xffff) : 0.f, x1 = ok ? bf2f(xv[i] >> 16) : 0.f;
#pragma unroll
            for (int o = 0; o < 16; ++o) { const int j = i - o; if (j >= 0 && j <= 30) { acc0[o] += x0 * W.w0[j]; acc1[o] += x1 * W.w1[j]; } }
        }
#pragma unroll
        for (int o = 0; o < 16; ++o) { f32x2 r; r.x = acc0[o]; r.y = acc1[o]; *(LAS f32x2*)(cy + (16 * sb + o) * 512 + 2 * cp) = r; }
        __syncthreads();
#pragma unroll
        for (int k = 0; k < 4; ++k) {
            const int tok = 4 * wave + k, t = t0 + tok;
            f32x4 a = *(const LAS f32x4*)(cy + tok * 512 + 4 * lane), b = *(const LAS f32x4*)(cy + tok * 512 + 256 + 4 * lane);
            const float mean = wave_sum((a.x + a.y) + (a.z + a.w) + (b.x + b.y) + (b.z + b.w)) * (1.0f / 512);
            a.x -= mean; a.y -= mean; a.z -= mean; a.w -= mean; b.x -= mean; b.y -= mean; b.z -= mean; b.w -= mean;
            const float var = wave_sum((a.x * a.x + a.y * a.y) + (a.z * a.z + a.w * a.w) + (b.x * b.x + b.y * b.y) + (b.z * b.z + b.w * b.w)) * (1.0f / 512);
            const float rstd = 1.0f / sqrtf(var + EPSF);
            const uint2 za = *(const uint2*)(ZA + (size_t)t * 512 + 4 * lane), zb = *(const uint2*)(ZA + (size_t)t * 512 + 256 + 4 * lane);
            float y0 = fast_silu(a.x * rstd * W.ga.x + W.ba.x) * bf2f(za.x & 0xffff), y1 = fast_silu(a.y * rstd * W.ga.y + W.ba.y) * bf2f(za.x >> 16);
            float y2 = fast_silu(a.z * rstd * W.ga.z + W.ba.z) * bf2f(za.y & 0xffff), y3 = fast_silu(a.w * rstd * W.ga.w + W.ba.w) * bf2f(za.y >> 16);
            uint2 o; o.x = pk2(y0, y1); o.y = pk2(y2, y3);
            *(uint2*)(Y + (size_t)t * 1024 + 4 * lane) = o;
            y0 = fast_silu(b.x * rstd * W.gb.x + W.bb2.x) * bf2f(zb.x & 0xffff); y1 = fast_silu(b.y * rstd * W.gb.y + W.bb2.y) * bf2f(zb.x >> 16);
            y2 = fast_silu(b.z * rstd * W.gb.z + W.bb2.z) * bf2f(zb.y & 0xffff); y3 = fast_silu(b.w * rstd * W.gb.w + W.bb2.w) * bf2f(zb.y >> 16);
            o.x = pk2(y0, y1); o.y = pk2(y2, y3);
            *(uint2*)(Y + (size_t)t * 1024 + 256 + 4 * lane) = o;
        }
        __syncthreads();
    }
}

__device__ __forceinline__ void cmp_unit(const KArgs& P, LAS unsigned char* lds, int u, int tid, int wave, int lane) {
    const int kv = u >> 7, bg = (u >> 3) & 15, rb = u & 7, fr = lane & 15, fq = lane >> 4;
    const bf16_t* X = (const bf16_t*)(P.ws + (kv == 0 ? WS_KCR : WS_VCR)) + ((size_t)bg * SEQ + 256 * rb) * 64;
    const bf16_t* W1f = (const bf16_t*)(P.ws + WS_CW1) + (size_t)kv * 256 * 2048;
    const bf16_t* W2t = (const bf16_t*)(P.ws + WS_CW2) + (size_t)kv * 64 * 256;
    const float* B1P = (const float*)(P.ws + WS_B1P) + (size_t)kv * 16 * 256;
    LAS unsigned char* xs = lds;
    LAS bf16_t* hidS = (LAS bf16_t*)(lds + 272 * 128);
    LAS float* outS = (LAS float*)(lds + 272 * 128 + 16 * 264 * 2);
    const bf16_t* bp0 = W1f + (size_t)(2 * wave) * 64 * 512 + lane * 8; const bf16_t* bp1 = bp0 + 64 * 512;
    bf16x8 bb[4][8];
#define CMP_LOADB(buf, ch) do { _Pragma("unroll") for (int q_ = 0; q_ < 4; ++q_) { bb[buf][2 * q_] = *(const bf16x8*)(bp0 + (size_t)(4 * (ch) + q_) * 512); bb[buf][2 * q_ + 1] = *(const bf16x8*)(bp1 + (size_t)(4 * (ch) + q_) * 512); } } while (0)
    CMP_LOADB(0, 0); CMP_LOADB(1, 1); CMP_LOADB(2, 2);
#pragma unroll
    for (int i = 0; i < 5; ++i) { const int idx = tid + 512 * i;
        if (idx < 2176) { const int t = idx >> 3, c = idx & 7; const uint4 v = *(const uint4*)(X + (size_t)t * 64 + c * 8);
            *(LAS v4u*)(xs + t * 128 + ((c ^ ((t >> 4) & 7)) << 4)) = (v4u){v.x, v.y, v.z, v.w}; } }
    __syncthreads();
    {
        const int n0 = 32 * wave;
        f32x4 acc0 = {0.f, 0.f, 0.f, 0.f}, acc1 = {0.f, 0.f, 0.f, 0.f};
#pragma unroll
        for (int ch = 0; ch < 16; ++ch) {
            if (ch + 3 < 16) CMP_LOADB((ch + 3) & 3, ch + 3);
#pragma unroll
            for (int q = 0; q < 4; ++q) {
                const int ks = 4 * ch + q, tau = ks >> 1, c = (ks & 1) * 4 + fq, t = 16 * fr + tau;
                const bf16x8 a = *(const LAS bf16x8*)(xs + t * 128 + ((c ^ ((t >> 4) & 7)) << 4));
                acc0 = __builtin_amdgcn_mfma_f32_16x16x32_bf16(a, bb[ch & 3][2 * q], acc0, 0, 0, 0);
                acc1 = __builtin_amdgcn_mfma_f32_16x16x32_bf16(a, bb[ch & 3][2 * q + 1], acc1, 0, 0, 0);
            }
        }
#undef CMP_LOADB
        const float* b1 = kv == 0 ? P.c_k_b1 : P.c_v_b1;
#pragma unroll
        for (int f = 0; f < 2; ++f) {
            const int n = n0 + 16 * f + fr;
            float bias = b1[n];
#pragma unroll
            for (int kc = 0; kc < 16; ++kc) bias += B1P[kc * 256 + n];
#pragma unroll
            for (int r = 0; r < 4; ++r) { const float v = (f == 0 ? acc0[r] : acc1[r]) + bias; hidS[(4 * fq + r) * 264 + n] = f2bf(fast_silu(v)); }
        }
    }
    __syncthreads();
    if (wave < 4) {
        const int d0 = 16 * wave;
        f32x4 acc = {0.f, 0.f, 0.f, 0.f};
#pragma unroll
        for (int k0 = 0; k0 < 256; k0 += 32) {
            const bf16x8 a = *(const LAS bf16x8*)(hidS + fr * 264 + k0 + 8 * fq);
            const bf16x8 b = *(const bf16x8*)(W2t + (size_t)(d0 + fr) * 256 + k0 + 8 * fq);
            acc = __builtin_amdgcn_mfma_f32_16x16x32_bf16(a, b, acc, 0, 0, 0);
        }
        const float b2 = (kv == 0 ? P.c_k_b2 : P.c_v_b2)[d0 + fr];
#pragma unroll
        for (int r = 0; r < 4; ++r) outS[(4 * fq + r) * 65 + d0 + fr] = acc[r] + b2;
    }
    __syncthreads();
    {
        bf16_t* dst = (bf16_t*)(P.ws + (kv == 0 ? WS_KC : WS_VC)) + (size_t)bg * 128 * 64;
#pragma unroll
        for (int k = 0; k < 2; ++k) {
            const int row = 2 * wave + k, c = 16 * rb + row;
            float v = outS[row * 65 + lane];
            if (kv == 0) { const float ss = wave_sum(v * v); v = v * (1.0f / sqrtf(ss * (1.0f / 64) + EPSF)) * P.c_knorm_cmp_g[lane]; }
            const size_t off = kv == 0 ? (size_t)(c >> 6) * 4096 + (lane >> 3) * 512 + (c & 63) * 8 + (lane & 7)
                                       : (size_t)(c >> 6) * 4096 + (lane >> 5) * 2048 + (c & 63) * 32 + (lane & 31);
            dst[off] = c < 127 ? f2bf(v) : (bf16_t)0;
        }
    }
    __syncthreads();
}

__device__ __forceinline__ void gate_unit(const KArgs& P, LAS unsigned char* lds, int u, int tid, int wave, int lane) {
    const bf16_t* XB = (const bf16_t*)(P.ws + WS_XB); const bf16_t* WG = (const bf16_t*)(P.ws + WS_WGATE); const float* SSQ = (const float*)(P.ws + WS_SSQ); float* GT = (float*)(P.ws + WS_GT);
    const int fr = lane & 15, fq = lane >> 4, mf = wave & 3, kh = wave >> 2, t0 = 64 * u + 16 * mf;
    constexpr int ROWB = 2064;
    LAS float* part = (LAS float*)(lds + 32 * ROWB);
#pragma unroll
    for (int i = 0; i < 8; ++i) { const int idx = tid + 512 * i, n = idx >> 7, ch = idx & 127;
        const uint4 v = *(const uint4*)(WG + (size_t)n * DM + ch * 8);
        *(LAS v4u*)(lds + n * ROWB + ch * 16) = (v4u){v.x, v.y, v.z, v.w}; }
    bf16x8 a[16];
    const bf16_t* ap = XB + (size_t)(t0 + fr) * DM + kh * 512 + 8 * fq;
#pragma unroll
    for (int i = 0; i < 16; ++i) a[i] = *(const bf16x8*)(ap + 32 * i);
    __syncthreads();
    f32x4 acc0 = {0.f, 0.f, 0.f, 0.f}, acc1 = {0.f, 0.f, 0.f, 0.f};
    const LAS unsigned char* bp = lds + fr * ROWB + (kh * 512 + 8 * fq) * 2;
#pragma unroll
    for (int i = 0; i < 16; ++i) {
        const bf16x8 b0 = *(const LAS bf16x8*)(bp + 64 * i), b1 = *(const LAS bf16x8*)(bp + 16 * ROWB + 64 * i);
        acc0 = __builtin_amdgcn_mfma_f32_16x16x32_bf16(a[i], b0, acc0, 0, 0, 0);
        acc1 = __builtin_amdgcn_mfma_f32_16x16x32_bf16(a[i], b1, acc1, 0, 0, 0);
    }
    if (kh == 1) {
#pragma unroll
        for (int r = 0; r < 4; ++r) { part[(mf * 64 + lane) * 8 + r] = acc0[r]; part[(mf * 64 + lane) * 8 + 4 + r] = acc1[r]; }
    }
    __syncthreads();
    if (kh == 0) {
#pragma unroll
        for (int r = 0; r < 4; ++r) {
            const int t = t0 + 4 * fq + r;
            const float4* sq = (const float4*)(SSQ + (size_t)t * 16);
            const float4 q0 = sq[0], q1 = sq[1], q2 = sq[2], q3 = sq[3];
            const float ssq = ((q0.x + q0.y) + (q0.z + q0.w)) + ((q1.x + q1.y) + (q1.z + q1.w)) + ((q2.x + q2.y) + (q2.z + q2.w)) + ((q3.x + q3.y) + (q3.z + q3.w));
            const float rstd = 1.0f / sqrtf(ssq * (1.0f / DM) + EPSF);
            GT[(size_t)t * 32 + fr] = fast_sigmoid((acc0[r] + part[(mf * 64 + lane) * 8 + r]) * rstd);
            if (fr < 8) GT[(size_t)t * 32 + 16 + fr] = fast_sigmoid((acc1[r] + part[(mf * 64 + lane) * 8 + 4 + r]) * rstd);
        }
    }
    __syncthreads();
}

__device__ __forceinline__ void b1p_item(const KArgs& P, int it, int lane) {
    const int kv = it >> 6, kc = (it >> 2) & 15, n = (it & 3) * 64 + lane;
    const float* pos = kv == 0 ? P.c_pos_k : P.c_pos_v; const float* w1 = kv == 0 ? P.c_k_w1 : P.c_v_w1;
    float s = 0.f;
#pragma unroll 32
    for (int k = kc * 128; k < kc * 128 + 128; ++k) s += pos[k] * w1[(size_t)k * 256 + n];
    ((float*)(P.ws + WS_B1P))[((size_t)kv * 16 + kc) * 256 + n] = s;
}
__device__ __forceinline__ void w1f_item(const KArgs& P, int it, int lane) {
    const int kv = it >> 7, nf = (it >> 3) & 15, ks8 = it & 7, fr = lane & 15, fq = lane >> 4;
    const float* w1 = kv == 0 ? P.c_k_w1 : P.c_v_w1;
    bf16_t* dst = (bf16_t*)(P.ws + WS_CW1) + (size_t)kv * 256 * 2048 + (size_t)nf * 64 * 512 + lane * 8;
    float v[8][8];
#pragma unroll
    for (int q = 0; q < 8; ++q) {
        const float* src = w1 + (size_t)(32 * (ks8 * 8 + q) + 8 * fq) * 256 + 16 * nf + fr;
#pragma unroll
        for (int j = 0; j < 8; ++j) v[q][j] = src[j * 256];
    }
#pragma unroll
    for (int q = 0; q < 8; ++q) {
        uint4 o; o.x = pk2(v[q][0], v[q][1]); o.y = pk2(v[q][2], v[q][3]); o.z = pk2(v[q][4], v[q][5]); o.w = pk2(v[q][6], v[q][7]);
        *(uint4*)(dst + (size_t)(ks8 * 8 + q) * 512) = o;
    }
}
}
__device__ __forceinline__ NvGroup fast_group(const KArgs& P, int layer, int pn, int wc) {
    if (layer == 0) {
        if (pn < 4) { NvGroup g; g.gain = nullptr; g.scale = 1.f; g.width = 32; g.type = 4; g.col = 128 * pn + 32 * wc; g.col2 = 512 + g.col; g.dkind = 0; g.dst = P.ws + WS_G0; g.ld = 512; g.idx = 0; return g; }
        return nv_group0(P, 8 + 4 * (pn - 4) + wc);
    }
    int gi;
    if (pn < 2) gi = 4 * pn + wc;
    else if (pn < 4) gi = 21 + 4 * (pn - 2) + wc;
    else if (pn < 6) gi = 29 + 4 * (pn - 4) + wc;
    else if (pn < 8) gi = 41 + 4 * (pn - 6) + wc;
    else if (pn == 8) gi = 8 + wc;
    else if (pn == 9) gi = wc < 2 ? 12 + wc : 16 + (wc - 2);
    else if (pn == 10) gi = wc < 2 ? 14 + wc : 18 + (wc - 2);
    else if (pn == 11) gi = wc < 2 ? 37 + wc : 39 + (wc - 2);
    else { NvGroup g; g.gain = nullptr; g.scale = 1.f; g.width = 0; g.type = 5; g.col = 0; g.col2 = 0; g.dkind = 0; g.dst = nullptr; g.ld = 0; g.idx = 0; return g; }
    return nv_group1(P, gi);
}
constexpr int NTILE_IN0 = 14, NTILE_IN1 = 12;


struct EpiIn {
    static constexpr bool PERM = true, AFTER_DRAIN = false;
    KArgs P; int layer;
    __device__ __forceinline__ void operator()(const pg8::f32x4 (&acc)[2][2][4][2], const pg8::Unit& u, int wr, int wc, int fr, int fq) const {
        const NvGroup g = fast_group(P, layer, u.pn, wc);
        if (g.type == 5) return;
        const float* SSQ = (const float*)(P.ws + WS_SSQ);
        const bool do_km = (layer == 0 && g.type == 2 && u.pn >= 8);
        float gn[16], km[16];
#pragma unroll
        for (int i = 0; i < 16; ++i) { gn[i] = 1.f; km[i] = 0.f; }
        if (g.type == 2) {
#pragma unroll
            for (int bj = 0; bj < 2; ++bj)
#pragma unroll
                for (int i = 0; i < 8; ++i) gn[8 * bj + i] = g.gain[32 * bj + 8 * fq + i] * g.scale;
        }
#pragma unroll
        for (int ai = 0; ai < 2; ++ai)
#pragma unroll
            for (int m = 0; m < 4; ++m) {
                const int t = u.pm * 256 + ai * 128 + wr * 64 + m * 16 + fr, b = t >> 11, s = t & 2047;
                const float4* sq = (const float4*)(SSQ + (size_t)t * 16);
                const float4 q0 = sq[0], q1 = sq[1], q2 = sq[2], q3 = sq[3];
                const float ssq = ((q0.x + q0.y) + (q0.z + q0.w)) + ((q1.x + q1.y) + (q1.z + q1.w)) + ((q2.x + q2.y) + (q2.z + q2.w)) + ((q3.x + q3.y) + (q3.z + q3.w));
                const float rstd = 1.0f / sqrtf(ssq * (1.0f / DM) + EPSF);
                float v[16];
#pragma unroll
                for (int bj = 0; bj < 2; ++bj)
#pragma unroll
                    for (int n = 0; n < 2; ++n)
#pragma unroll
                        for (int r = 0; r < 4; ++r) v[8 * bj + 4 * n + r] = acc[ai][bj][m][n][r] * rstd;
                if (g.type == 4) {
                    pg8::u32x4 w;
                    float o[8];
#pragma unroll
                    for (int i = 0; i < 8; ++i) o[i] = v[i] * fast_sigmoid(v[8 + i]);
                    w.x = pg8::cvt_pk_bf16(o[0], o[1]); w.y = pg8::cvt_pk_bf16(o[2], o[3]); w.z = pg8::cvt_pk_bf16(o[4], o[5]); w.w = pg8::cvt_pk_bf16(o[6], o[7]);
                    *(pg8::u32x4*)((bf16_t*)g.dst + (size_t)t * 512 + g.col + 8 * fq) = w;
                    continue;
                }
                if (g.type == 3) {
                    if (fq < 3) {
                        float4 o0, o1;
                        o0.x = fast_sigmoid(v[0]); o0.y = fast_sigmoid(v[1]); o0.z = fast_sigmoid(v[2]); o0.w = fast_sigmoid(v[3]);
                        o1.x = fast_sigmoid(v[4]); o1.y = fast_sigmoid(v[5]); o1.z = fast_sigmoid(v[6]); o1.w = fast_sigmoid(v[7]);
                        float* gp = (float*)g.dst + (size_t)t * 32 + 8 * fq;
                        *(float4*)gp = o0; *(float4*)(gp + 4) = o1;
                    }
                    continue;
                }
                if (g.type == 1) {
#pragma unroll
                    for (int i = 0; i < 16; ++i) v[i] = fast_silu(v[i]);
                } else if (g.type == 2) {
                    float ss = 0.f;
#pragma unroll
                    for (int i = 0; i < 16; ++i) ss += v[i] * v[i];
                    ss += __shfl_xor(ss, 16); ss += __shfl_xor(ss, 32);
                    const float nrm = 1.0f / sqrtf(ss * (1.0f / 64) + EPSF);
#pragma unroll
                    for (int i = 0; i < 16; ++i) v[i] = v[i] * nrm * gn[i];
                    if (do_km) {
#pragma unroll
                        for (int i = 0; i < 16; ++i) km[i] += v[i];
                    }
                }
                bf16_t* dp = g.dkind == 0 ? (bf16_t*)g.dst + (size_t)t * g.ld + g.idx * 64 + 8 * fq
                                          : (bf16_t*)g.dst + ((size_t)(b * g.ld + g.idx) * SEQ + s) * 64 + 8 * fq;
                int bjstep = 32;
                if (g.dkind == 3) { dp = (bf16_t*)g.dst + (size_t)(b * g.ld + g.idx) * SEQ * 64 + (size_t)(s >> 6) * 4096 + fq * 512 + (s & 63) * 8; bjstep = 2048; }
                else if (g.dkind == 4) { dp = (bf16_t*)g.dst + (size_t)(b * g.ld + g.idx) * SEQ * 64 + (size_t)(s >> 6) * 4096 + (s & 63) * 32 + 8 * fq; bjstep = 2048; }
#pragma unroll
                for (int bj = 0; bj < 2; ++bj) {
                    pg8::u32x4 w;
                    w.x = pg8::cvt_pk_bf16(v[8 * bj + 0], v[8 * bj + 1]); w.y = pg8::cvt_pk_bf16(v[8 * bj + 2], v[8 * bj + 3]);
                    w.z = pg8::cvt_pk_bf16(v[8 * bj + 4], v[8 * bj + 5]); w.w = pg8::cvt_pk_bf16(v[8 * bj + 6], v[8 * bj + 7]);
                    *(pg8::u32x4*)(dp + bjstep * bj) = w;
                }
            }
        if (do_km) {
#pragma unroll
            for (int i = 0; i < 16; ++i) { float a = km[i]; a += __shfl_xor(a, 1); a += __shfl_xor(a, 2); a += __shfl_xor(a, 4); a += __shfl_xor(a, 8); km[i] = a * (1.0f / 256); }
            if (fr == 0) {
                float* kp = (float*)(P.ws + WS_KMP) + ((size_t)wr * 64 + u.pm) * 512 + g.idx * 64 + 8 * fq;
#pragma unroll
                for (int bj = 0; bj < 2; ++bj) {
                    float4 o0, o1; o0.x = km[8 * bj + 0]; o0.y = km[8 * bj + 1]; o0.z = km[8 * bj + 2]; o0.w = km[8 * bj + 3];
                    o1.x = km[8 * bj + 4]; o1.y = km[8 * bj + 5]; o1.z = km[8 * bj + 6]; o1.w = km[8 * bj + 7];
                    *(float4*)(kp + 32 * bj) = o0; *(float4*)(kp + 32 * bj + 4) = o1;
                }
            }
        }
    }
};

struct EpiOut {
    static constexpr bool PERM = true, AFTER_DRAIN = false;
    float* out; bf16_t* XB; float* SSQ; int layer;
    __device__ __forceinline__ void operator()(const pg8::f32x4 (&acc)[2][2][4][2], const pg8::Unit& u, int wr, int wc, int fr, int fq) const {
        const int col0 = u.pn * 256 + wc * 32 + 8 * fq;
#pragma unroll
        for (int ai = 0; ai < 2; ++ai)
#pragma unroll
            for (int m = 0; m < 4; ++m) {
                const int t = u.pm * 256 + ai * 128 + wr * 64 + m * 16 + fr;
                float ss = 0.f;
#pragma unroll
                for (int bj = 0; bj < 2; ++bj) {
                    const size_t o = (size_t)t * DM + col0 + 128 * bj;
                    const pg8::u32x4 rb = *(const pg8::u32x4*)(XB + o);
                    pg8::f32x4 x0, x1;
                    x0[0] = bf2f(rb.x & 0xffff) + acc[ai][bj][m][0][0]; x0[1] = bf2f(rb.x >> 16) + acc[ai][bj][m][0][1]; x0[2] = bf2f(rb.y & 0xffff) + acc[ai][bj][m][0][2]; x0[3] = bf2f(rb.y >> 16) + acc[ai][bj][m][0][3];
                    x1[0] = bf2f(rb.z & 0xffff) + acc[ai][bj][m][1][0]; x1[1] = bf2f(rb.z >> 16) + acc[ai][bj][m][1][1]; x1[2] = bf2f(rb.w & 0xffff) + acc[ai][bj][m][1][2]; x1[3] = bf2f(rb.w >> 16) + acc[ai][bj][m][1][3];
                    if (layer == 0) {
                        pg8::u32x4 w; w.x = pg8::cvt_pk_bf16(x0[0], x0[1]); w.y = pg8::cvt_pk_bf16(x0[2], x0[3]); w.z = pg8::cvt_pk_bf16(x1[0], x1[1]); w.w = pg8::cvt_pk_bf16(x1[2], x1[3]);
                        *(pg8::u32x4*)(XB + o) = w;
                        ss += (x0[0] * x0[0] + x0[1] * x0[1]) + (x0[2] * x0[2] + x0[3] * x0[3]) + (x1[0] * x1[0] + x1[1] * x1[1]) + (x1[2] * x1[2] + x1[3] * x1[3]);
                    } else { *(pg8::f32x4*)(out + o) = x0; *(pg8::f32x4*)(out + o + 4) = x1; }
                }
                if (layer == 0) { ss += __shfl_xor(ss, 16); ss += __shfl_xor(ss, 32); if (fq == 0) SSQ[(size_t)t * 16 + u.pn * 4 + wc] = ss; }
            }
    }
};

__device__ __forceinline__ void cvt_item(const float* __restrict__ W, int ldw, const float* __restrict__ gain, bf16_t* __restrict__ Bt, int Kd, int k0, int drow0, int src0, int vw, LAS float* scr, int lane) {
    {
        const int c = lane & 31, h = lane >> 5;
        if (vw == 32) {
            float v[32];
#pragma unroll
            for (int i = 0; i < 32; ++i) v[i] = W[(size_t)(k0 + 2 * i + h) * ldw + src0 + c];
            if (gain) {
#pragma unroll
                for (int i = 0; i < 32; ++i) v[i] *= gain[k0 + 2 * i + h];
            }
#pragma unroll
            for (int i = 0; i < 32; ++i) scr[(2 * i + h) * 33 + c] = v[i];
        } else {
            const int cc = c < vw ? c : (vw > 0 ? vw - 1 : 0);
#pragma unroll 8
            for (int i = 0; i < 32; ++i) { const int kk = 2 * i + h;
                float v = vw > 0 ? W[(size_t)(k0 + kk) * ldw + src0 + cc] : 0.f; if (gain) v *= gain[k0 + kk];
                scr[kk * 33 + c] = c < vw ? v : 0.f; }
        }
    }
    LDS_WAIT(); asm volatile("" ::: "memory");
    const int c = lane & 7;
#pragma unroll
    for (int j = 0; j < 4; ++j) { const int n = (lane >> 3) + 8 * j; const LAS float* s = scr + (8 * c) * 33 + n;
        v4u o; o.x = pk2(s[0 * 33], s[1 * 33]); o.y = pk2(s[2 * 33], s[3 * 33]); o.z = pk2(s[4 * 33], s[5 * 33]); o.w = pk2(s[6 * 33], s[7 * 33]);
        *(v4u*)(Bt + (size_t)(drow0 + n) * Kd + k0 + 8 * c) = o; }
    LDS_WAIT(); asm volatile("" ::: "memory");
}
__device__ __forceinline__ void cvt_in_item(const KArgs& P, int layer, int it, LAS float* scr, int lane) {
    const int kb = it & 15, blk = it >> 4, pn = blk >> 3, pb = blk & 7, wc = pb & 3, bj = pb >> 2;
    const NvGroup g = fast_group(P, layer, pn, wc);
    int src0 = 0, vw = 0;
    if (g.type == 4) { src0 = bj ? g.col2 : g.col; vw = 32; }
    else if (g.type != 5) { src0 = g.col + 32 * bj; vw = g.width - 32 * bj; vw = vw < 0 ? 0 : (vw > 32 ? 32 : vw); }
    const float* W = layer == 0 ? P.e_w_in : P.o_w_in; const int ldw = layer == 0 ? 3584 : 3096;
    bf16_t* Bt = (bf16_t*)(P.ws + (layer == 0 ? WS_WIN0 : WS_WIN1));
    cvt_item(W, ldw, P.norm_g + layer * DM, Bt, DM, 64 * kb, 256 * pn + 128 * bj + 32 * wc, src0, vw, scr, lane);
}
__device__ __forceinline__ void p0_deferred_item(const KArgs& P, int r, LAS float* scr, int lane) {
    constexpr int I_B1P = 128, I_WG = 16, I_IN1 = NTILE_IN1 * 8 * 16, I_OUT = 32 * 16, I_W1 = 128, I_W2 = 2 * 4;
    if (r < I_B1P) { fm::b1p_item(P, r, lane); return; } r -= I_B1P;
    if (r < I_WG) { cvt_item(P.o_w_in, 3096, P.norm_g + DM, (bf16_t*)(P.ws + WS_WGATE), DM, 64 * r, 0, 1280, 24, scr, lane); return; } r -= I_WG;
    if (r < 2 * I_W2) { const int kv = r / I_W2; r -= kv * I_W2; const int kb = r & 3, nb = r >> 2;
        cvt_item(kv == 0 ? P.c_k_w2 : P.c_v_w2, 64, nullptr, (bf16_t*)(P.ws + WS_CW2) + (size_t)kv * 64 * 256, 256, 64 * kb, 32 * nb, 32 * nb, 32, scr, lane); return; }
    r -= 2 * I_W2;
    if (r < 2 * I_W1) { fm::w1f_item(P, r, lane); return; } r -= 2 * I_W1;
    if (r < 2 * I_OUT) { const int l = r / I_OUT; r -= l * I_OUT; const int kb = r & 15, nb = r >> 4;
        cvt_item(P.w_out + (size_t)l * DM * DM, DM, nullptr, (bf16_t*)(P.ws + (l == 0 ? WS_WOUT0 : WS_WOUT1)), DM, 64 * kb, 32 * nb, 32 * nb, 32, scr, lane); return; }
    r -= 2 * I_OUT;
    cvt_in_item(P, 1, r, scr, lane);
}
constexpr int N_EARLY = 128 + 16 + 16;
constexpr int N_DEFERRED = 2 * 512 + NTILE_IN1 * 128 + 256 + 128 + 16 + 16;
constexpr int CW_WQD = 8192 + 2048;
__device__ __forceinline__ void p0_deferred(const KArgs& P, LAS unsigned char* lds, volatile LAS unsigned* MISC, int nwg, int G, int c, int tid, int wave, int lane) {
    const int maxu = (nwg + G - 1) / G, c0 = nwg - (maxu - 1) * G;
    if (c0 < G && c < c0) return;
    LAS float* scr = (LAS float*)(lds + wave * 16384);
    unsigned* ctr = (unsigned*)(P.ws + WS_CTL) + CW_WQD;
    for (;;) {
        __syncthreads();
        if (tid == 0) MISC[13] = __hip_atomic_fetch_add(ctr, 8u, __ATOMIC_RELAXED, __HIP_MEMORY_SCOPE_AGENT);
        __syncthreads();
        const int base = N_EARLY + (int)MISC[13];
        if (base >= N_DEFERRED) break;
        { const int r = base + wave; if (r < N_DEFERRED) p0_deferred_item(P, r, scr, lane); }
    }
}
__device__ __forceinline__ void p0_prologue(const KArgs& P, LAS unsigned char* lds, int vcu, int G, int wave, int lane) {
    LAS float* scr = (LAS float*)(lds + wave * 16384);
    const int gw = vcu * 8 + wave, NGW = G * 8;
    constexpr int I_IN0 = NTILE_IN0 * 8 * 16;
    for (int it = vcu + G * wave; it < N_EARLY + I_IN0; it += NGW) {
        if (it < N_EARLY) p0_deferred_item(P, it, scr, lane); else cvt_in_item(P, 0, it - N_EARLY, scr, lane);
    }
    bf16_t* XB = (bf16_t*)(P.ws + WS_XB); float* SSQ = (float*)(P.ws + WS_SSQ);
    const int rows_per_wave = (NT + NGW - 1) / NGW;
    for (int m0 = gw * rows_per_wave; m0 < (gw + 1) * rows_per_wave && m0 < NT; m0 += 4) {
        float4 v[4][4];
#pragma unroll
        for (int q = 0; q < 4; ++q) { const int m = m0 + q < NT ? m0 + q : NT - 1; const float4* r = (const float4*)(P.x + (size_t)m * DM) + 2 * lane;
            v[q][0] = r[0]; v[q][1] = r[1]; v[q][2] = r[128]; v[q][3] = r[129]; }
#pragma unroll
        for (int q = 0; q < 4; ++q) {
            const int m = m0 + q;
            float s = 0.f;
#pragma unroll
            for (int j = 0; j < 4; ++j) s += (v[q][j].x * v[q][j].x + v[q][j].y * v[q][j].y) + (v[q][j].z * v[q][j].z + v[q][j].w * v[q][j].w);
#pragma unroll
            for (int o = 1; o < 64; o <<= 1) s += __shfl_xor(s, o);
            if (m < NT && m < (gw + 1) * rows_per_wave) {
                uint4 o0, o1;
                o0.x = pg8::cvt_pk_bf16(v[q][0].x, v[q][0].y); o0.y = pg8::cvt_pk_bf16(v[q][0].z, v[q][0].w); o0.z = pg8::cvt_pk_bf16(v[q][1].x, v[q][1].y); o0.w = pg8::cvt_pk_bf16(v[q][1].z, v[q][1].w);
                o1.x = pg8::cvt_pk_bf16(v[q][2].x, v[q][2].y); o1.y = pg8::cvt_pk_bf16(v[q][2].z, v[q][2].w); o1.z = pg8::cvt_pk_bf16(v[q][3].x, v[q][3].y); o1.w = pg8::cvt_pk_bf16(v[q][3].z, v[q][3].w);
                *(uint4*)(XB + (size_t)m * DM + 8 * lane) = o0; *(uint4*)(XB + (size_t)m * DM + 512 + 8 * lane) = o1;
                if (lane < 4) { float4 z; z.x = lane == 0 ? s : 0.f; z.y = 0.f; z.z = 0.f; z.w = 0.f; *(float4*)(SSQ + (size_t)m * 16 + lane * 4) = z; }
            }
        }
    }
}

constexpr int CW_WQ2 = 8192, CW_WQ2C = 8192 + 512, CW_WQ6 = 8192 + 1024;
#define WQ_FIRST(ctrptr) unsigned* ctr_ = (ctrptr); \
        if (tid == 0) MISC[12] = __hip_atomic_fetch_add(ctr_, 1u, __ATOMIC_RELAXED, __HIP_MEMORY_SCOPE_AGENT); \
        __syncthreads(); \
        int it_ = (int)MISC[12];
#define WQ_WHILE(LIMIT, ...) while (it_ < (LIMIT)) { \
            unsigned nx_ = 0u; if (tid == 0) nx_ = __hip_atomic_fetch_add(ctr_, 1u, __ATOMIC_RELAXED, __HIP_MEMORY_SCOPE_AGENT);     \
            { const int it = it_; __VA_ARGS__ } \
            __syncthreads(); if (tid == 0) MISC[12] = nx_; __syncthreads(); it_ = (int)MISC[12]; \
        }
#define WQ_QUEUES(cwbase, QLEN, ...) do { const int xcc_ = (int)(xb_xcc_id() & 7u); unsigned* qb_ = (unsigned*)(P.ws + WS_CTL) + (cwbase); \
        for (int qi_ = 0; qi_ < 8; ++qi_) { const int q = (xcc_ + qi_) & 7; \
            if (qi_ == 1) { __syncthreads(); if (tid < 8) MISC[24 + tid] = __hip_atomic_load(qb_ + 64 * tid, __ATOMIC_RELAXED, __HIP_MEMORY_SCOPE_AGENT); __syncthreads(); } \
            if (qi_ >= 1 && MISC[24 + q] >= (unsigned)(QLEN)) continue; \
            WQ_FIRST(qb_ + 64 * q) __VA_ARGS__ } } while (0)

constexpr int RING_BYTES = 131072, LDSCTL_OFF = RING_BYTES, MISC_OFF = LDSCTL_OFF + 320, LDS_BYTES = 147456;
constexpr int CW_BAR = 4096;
constexpr int NPHASE = 8;

__global__ void __launch_bounds__(512, 2) mk_fwd(KArgs P) {
    extern __shared__ __attribute__((aligned(16))) unsigned char lds_raw[];
    LAS unsigned char* lds = (LAS unsigned char*)lds_raw;
    volatile LAS unsigned* MISC = (volatile LAS unsigned*)(lds + MISC_OFF);
    const int tid = threadIdx.x, lane = tid & 63, wave = __builtin_amdgcn_readfirstlane(tid >> 6);
    const int G = gridDim.x, bx = blockIdx.x, vcu = (G % 8 == 0) ? (bx % 8) * (G / 8) + bx / 8 : bx;
    for (int u = tid; u < (LDS_BYTES - LDSCTL_OFF) / 4; u += 512) ((LAS unsigned*)(lds + LDSCTL_OFF))[u] = 0u;
    __syncthreads();
#ifdef PROBE_A
#ifndef PROBE_BX
#define PROBE_BX 0
#endif
#define STAMP(n) do { if (bx == PROBE_BX && tid == 0) { MISC[40 + (n)] = (unsigned)__builtin_amdgcn_s_memrealtime(); MISC[80 + (n)] = (unsigned)__builtin_amdgcn_s_memtime(); } } while (0)
#else
#define STAMP(n) do {} while (0)
#endif
    {
        if (lane == 0) MISC[100 + wave] = ((unsigned)__builtin_amdgcn_s_getreg(63492) >> 4) & 3u;
        __syncthreads();
        unsigned role = 0;
        for (int w = 0; w < 8; ++w) if (w < wave && MISC[100 + w] == MISC[100 + wave]) role = 1;
        if (lane == 0) MISC[110 + wave] = role;
        __syncthreads();
    }
    const int lo = P.ph_lo, hi = P.ph_hi;
    STAMP(0);
    XcdBarrier bar; bar.bar = (unsigned*)(P.ws + WS_CTL) + CW_BAR; bar.x = 0; bar.st = nullptr;
    if (hi - lo > 1) bar = xcd_barrier_post((unsigned*)(P.ws + WS_CTL) + CW_BAR, MISC + 8);
#define IN(k) (lo <= (k) && (k) < hi)
#define SEAM(k) do { STAMP(2 * (k) + 1); if (IN(k) && IN((k) + 1)) xcd_barrier(bar); STAMP(2 * (k) + 2); } while (0)

    if (IN(0)) {
        p0_prologue(P, lds, vcu, G, wave, lane); SEAM(0);
    }
    if (IN(1)) {
        pg8::Gemm g{(const bf16_t*)(P.ws + WS_XB), (const bf16_t*)(P.ws + WS_WIN0), NT, NTILE_IN0 * 256, DM}; pg8::StaticOrder S; S.init(NT, NTILE_IN0 * 256, G, bx);
        EpiIn E{P, 0};
        pg8::gemm_phase<EpiIn, pg8::StaticOrder, true, true>(lds, g, S, E);
        p0_deferred(P, lds, MISC, (NT / 256) * NTILE_IN0, G, bx, tid, wave, lane);
        SEAM(1);
    }
    if (IN(2)) {
        for (int k = vcu; k < 512; k += G) { const int kk = k < 256 ? k : k - 256, bh = kk >> 2, own = k < 256 ? 7 - (kk & 3) : (kk & 3);
            fa::moba_unit(P, (fa::lds_ptr)lds, bh >> 3, bh & 7, own, wave, lane); }
        STAMP(20);
        {
            fm::ConvW cw; fm::conv_load_w(P, cw, tid, lane);
            WQ_QUEUES(CW_WQ2C, 64, WQ_WHILE(64, fm::conv_unit(P, lds, 64 * q + it, cw, tid, wave, lane);));
        }
        SEAM(2);
    }
    if (IN(3)) {
        pg8::Gemm g{(const bf16_t*)(P.ws + WS_Y), (const bf16_t*)(P.ws + WS_WOUT0), NT, DM, DM}; pg8::StaticOrder S; S.init(NT, DM, G, bx);
        EpiOut E{P.out, (bf16_t*)(P.ws + WS_XB), (float*)(P.ws + WS_SSQ), 0};
        pg8::gemm_phase<EpiOut, pg8::StaticOrder, true, true>(lds, g, S, E);
        SEAM(3);
    }
    if (IN(4)) {
        pg8::Gemm g{(const bf16_t*)(P.ws + WS_XB), (const bf16_t*)(P.ws + WS_WIN1), NT, NTILE_IN1 * 256, DM}; pg8::StaticOrder S; S.init(NT, NTILE_IN1 * 256, G, bx);
        EpiIn E{P, 1};
        pg8::gemm_phase<EpiIn, pg8::StaticOrder, true, true>(lds, g, S, E);
        SEAM(4);
    }
    if (IN(5)) {
        for (int k = vcu; k < 256; k += G) fm::gate_unit(P, lds, k, tid, wave, lane);
        STAMP(21);
        if (P.flags & 16) for (int k = vcu; k < 256; k += G) fm::cmp_unit(P, lds, k, tid, wave, lane);
        SEAM(5);
    }
    if (IN(6)) {
        for (int k = vcu; k < 512; k += G) { const int kk = k < 256 ? k : k - 256, bg = kk >> 4, c = k < 256 ? 31 - (kk & 15) : (kk & 15);
            fa::nsa_unit(P, (fa::lds_ptr)lds, bg >> 1, bg & 1, c, wave, lane, tid); }
        STAMP(22);
        WQ_QUEUES(CW_WQ6, 64, WQ_WHILE(64, fa::swa_unit(P, (fa::lds_ptr)lds, q, it & 1, 31 - (it >> 1), wave, lane);));
        SEAM(6);
    }
    if (IN(7)) {
        pg8::Gemm g{(const bf16_t*)(P.ws + WS_Y), (const bf16_t*)(P.ws + WS_WOUT1), NT, DM, DM}; pg8::StaticOrder S; S.init(NT, DM, G, bx);
        EpiOut E{P.out, (bf16_t*)(P.ws + WS_XB), nullptr, 1};
        pg8::gemm_phase<EpiOut, pg8::StaticOrder, true, true>(lds, g, S, E);
    }
#ifdef PROBE_A
    if (bx == PROBE_BX && tid == 0) {
#ifdef PROBE_CLK
        const unsigned dt = (unsigned)(1000.f * (float)(MISC[80 + PROBE_B] - MISC[80 + PROBE_A]) / (float)(MISC[40 + PROBE_B] - MISC[40 + PROBE_A])), t0 = (unsigned)__builtin_amdgcn_s_memrealtime();
#else
        const unsigned dt = (MISC[40 + PROBE_B] - MISC[40 + PROBE_A]) * 8u, t0 = (unsigned)__builtin_amdgcn_s_memrealtime();
#endif
        while ((unsigned)__builtin_amdgcn_s_memrealtime() - t0 < dt) __builtin_amdgcn_s_sleep(8);
    }
#endif
#undef IN
#undef SEAM
}
static void fill_args(KArgs& a, void* const* d_in, void* d_out, void* d_ws) {
    const float** p = (const float**)&a;
    for (int i = 0; i < 28; ++i) p[i] = (const float*)d_in[i];
    a.out = (float*)d_out; a.ws = (unsigned char*)d_ws; a.ph_lo = 0; a.ph_hi = NPHASE; a.flags = 31; a.pad = 0;
}
static int g_grid = 0;
extern "C" void kernel_launch(void* const* d_in, const int* in_sizes, int n_in, void* d_out, int out_size, void* d_ws, size_t ws_size, hipStream_t stream) {
    if (n_in != 28 || out_size != NT * DM || ws_size < WS_END) { fprintf(stderr, "kernel_launch: unexpected shapes n_in %d out %d ws %zu\n", n_in, out_size, ws_size); return; }
    if (g_grid == 0) {
        int dev = 0, cus = 0;
        if (hipGetDevice(&dev) != hipSuccess || hipDeviceGetAttribute(&cus, hipDeviceAttributeMultiprocessorCount, dev) != hipSuccess) { fprintf(stderr, "kernel_launch: device query failed\n"); g_grid = -1; return; }
        if (hipFuncSetAttribute((const void*)mk_fwd, hipFuncAttributeMaxDynamicSharedMemorySize, LDS_BYTES) != hipSuccess) { fprintf(stderr, "kernel_launch: hipFuncSetAttribute failed\n"); g_grid = -1; return; }
        int per_cu = 0;
        if (hipOccupancyMaxActiveBlocksPerMultiprocessor(&per_cu, (const void*)mk_fwd, 512, LDS_BYTES) != hipSuccess || per_cu < 1) { fprintf(stderr, "kernel_launch: occupancy query says %d blocks/CU\n", per_cu); }
        (void)hipGetLastError();
        g_grid = cus;
    }
    if (g_grid < 0) return;
    KArgs a{}; fill_args(a, d_in, d_out, d_ws);
    (void)hipMemsetAsync((char*)d_ws + WS_CTL, 0, 64 * 1024, stream);
    hipLaunchKernelGGL(mk_fwd, dim3(g_grid), dim3(512), LDS_BYTES, stream, a);
}
```

```cpp
#include <hip/hip_runtime.h>
#include <stdint.h>
#include <stdio.h>

typedef unsigned short bf16_t;
constexpr int NB = 8, SEQ = 2048, NT = NB * SEQ, DM = 1024;
#define EPSF 1e-6f
#define LOG2E 1.4426950408889634f
#define QSCALE (0.125f * 1.4426950408889634f)

constexpr size_t MiB = 1u << 20;
constexpr size_t WS_CTL = 0, WS_SSQ = 5 * MiB, WS_KMP = 1 * MiB + 512 * 1024, WS_B1P = 1 * MiB + 768 * 1024, WS_GT = 2 * MiB, WS_KC = 4 * MiB, WS_VC = 4 * MiB + 256 * 1024;
constexpr size_t WS_WIN0 = 6 * MiB, WS_WOUT0 = 13 * MiB, WS_WIN1 = 15 * MiB, WS_WOUT1 = 22 * MiB, WS_CW1 = 24 * MiB, WS_CW2 = 26 * MiB, WS_WGATE = 27 * MiB;
constexpr size_t WS_XB = 32 * MiB, WS_Y = 64 * MiB;
constexpr size_t WS_G0 = 96 * MiB, WS_ZA = 112 * MiB, WS_QB = 128 * MiB, WS_KB = 144 * MiB, WS_VB = 160 * MiB, WS_ZB = 176 * MiB;
constexpr size_t WS_QC = 96 * MiB, WS_ZC = 112 * MiB, WS_QD = 128 * MiB, WS_ZD = 144 * MiB;
constexpr size_t WS_KCR = 160 * MiB, WS_VCR = 164 * MiB, WS_KS = 168 * MiB, WS_VS = 172 * MiB, WS_KW = 176 * MiB, WS_VW = 180 * MiB, WS_KD = 184 * MiB, WS_VD = 188 * MiB;
constexpr size_t WS_NVTMP = 192 * MiB, WS_END = 200 * MiB;

struct KArgs {
    const float *x, *norm_g, *w_out, *e_w_in, *a_conv_w, *a_conv_b, *a_ln_g, *a_ln_b, *b_qnorm_g, *b_knorm_g, *o_w_in, *c_qnorm_g, *c_knorm_cmp_g, *c_knorm_slc_g,
        *c_knorm_win_g, *c_pos_k, *c_pos_v, *c_k_w1, *c_k_b1, *c_k_w2, *c_k_b2, *c_v_w1, *c_v_b1, *c_v_w2, *c_v_b2, *d_qnorm_g, *d_knorm_g, *d_sinks;
    float* out; unsigned char* ws;
    int ph_lo, ph_hi, flags, pad;
};

__device__ __forceinline__ float bf2f(unsigned v) { return __uint_as_float(v << 16); }
__device__ __forceinline__ unsigned f2bf_u(float f) { unsigned u = __float_as_uint(f); return (u + 0x7fffu + ((u >> 16) & 1u)) >> 16; }
__device__ __forceinline__ bf16_t f2bf(float f) { return (bf16_t)f2bf_u(f); }
__device__ __forceinline__ unsigned pk2(float lo, float hi) { return f2bf_u(lo) | (f2bf_u(hi) << 16); }
__device__ __forceinline__ float fast_silu(float v) { return v * __builtin_amdgcn_rcpf(1.f + __expf(-v)); }
__device__ __forceinline__ float fast_sigmoid(float v) { return __builtin_amdgcn_rcpf(1.f + __expf(-v)); }
struct NvGroup { int col, width, type; const float* gain; float scale; int dkind; void* dst; int ld, idx, col2; };

__device__ __forceinline__ NvGroup nv_group0(const KArgs& P, int gi) {
    NvGroup g; g.gain = nullptr; g.scale = 1.f; g.col2 = 0; g.width = 64;
    const int j = gi & 7;
    switch (gi >> 3) {
    case 0: g.col = 64 * j; g.col2 = 512 + 64 * j; g.type = 4; g.dkind = 0; g.dst = P.ws + WS_G0; g.ld = 512; g.idx = j; break;
    case 1: g.col = 1024 + 64 * j; g.type = 1; g.dkind = 0; g.dst = P.ws + WS_ZA; g.ld = 512; g.idx = j; break;
    case 2: g.col = 1536 + 64 * j; g.type = 2; g.gain = P.b_qnorm_g; g.scale = QSCALE; g.dkind = 1; g.dst = P.ws + WS_QB; g.ld = 8; g.idx = j; break;
    case 3: g.col = 2048 + 64 * j; g.type = 2; g.gain = P.b_knorm_g; g.dkind = 3; g.dst = P.ws + WS_KB; g.ld = 8; g.idx = j; break;
    case 4: g.col = 2560 + 64 * j; g.type = 0; g.dkind = 4; g.dst = P.ws + WS_VB; g.ld = 8; g.idx = j; break;
    default: g.col = 3072 + 64 * j; g.type = 1; g.dkind = 0; g.dst = P.ws + WS_ZB; g.ld = 512; g.idx = j; break;
    }
    return g;
}
__device__ __forceinline__ NvGroup nv_group1(const KArgs& P, int gi) {
    NvGroup g; g.gain = nullptr; g.scale = 1.f; g.col2 = 0; g.width = 64;
    if (gi < 8) { g.col = 64 * gi; g.type = 2; g.gain = P.c_qnorm_g; g.scale = QSCALE; g.dkind = 1; g.dst = P.ws + WS_QC; g.ld = 8; g.idx = gi; return g; }
    gi -= 8;
    if (gi < 12) {
        const int which = gi >> 1, hh = gi & 1;
        g.col = 512 + 128 * which + 64 * hh; g.dkind = (which < 2) ? 1 : ((which & 1) ? 4 : 3); g.ld = 2; g.idx = hh;
        g.dst = P.ws + (which == 0 ? WS_KCR : which == 1 ? WS_VCR : which == 2 ? WS_KS : which == 3 ? WS_VS : which == 4 ? WS_KW : WS_VW);
        if (which == 2) { g.type = 2; g.gain = P.c_knorm_slc_g; } else if (which == 4) { g.type = 2; g.gain = P.c_knorm_win_g; } else g.type = 0;
        return g;
    }
    gi -= 12;
    if (gi < 1) { g.col = 1280; g.width = 24; g.type = 3; g.dkind = 2; g.dst = P.ws + WS_GT; g.ld = 32; g.idx = 0; return g; }
    gi -= 1;
    if (gi < 8) { g.col = 1304 + 64 * gi; g.type = 1; g.dkind = 0; g.dst = P.ws + WS_ZC; g.ld = 512; g.idx = gi; return g; }
    gi -= 8;
    if (gi < 8) { g.col = 1816 + 64 * gi; g.type = 2; g.gain = P.d_qnorm_g; g.scale = QSCALE; g.dkind = 1; g.dst = P.ws + WS_QD; g.ld = 8; g.idx = gi; return g; }
    gi -= 8;
    if (gi < 2) { g.col = 2328 + 64 * gi; g.type = 2; g.gain = P.d_knorm_g; g.dkind = 3; g.dst = P.ws + WS_KD; g.ld = 2; g.idx = gi; return g; }
    gi -= 2;
    if (gi < 2) { g.col = 2456 + 64 * gi; g.type = 0; g.dkind = 4; g.dst = P.ws + WS_VD; g.ld = 2; g.idx = gi; return g; }
    gi -= 2;
    g.col = 2584 + 64 * gi; g.type = 1; g.dkind = 0; g.dst = P.ws + WS_ZD; g.ld = 512; g.idx = gi; return g;
}
namespace pg8 {
#define PG8_LAS __attribute__((address_space(3)))
typedef short bf16x8 __attribute__((ext_vector_type(8)));
typedef float f32x4 __attribute__((ext_vector_type(4)));
typedef unsigned u32x4 __attribute__((ext_vector_type(4)));
constexpr int BM = 256, BK = 64, HALF = 128, HTB = HALF * BK * 2  , STAGE_BYTES = 8 * HTB, NXCD = 8, WGM = 8;

__host__ __device__ __forceinline__ int lds_byte(int r, int c) { const int st = (r >> 4) * 2 + (c >> 5), rr = r & 15, cc = c & 31, ob = rr * 64 + cc * 2; return st * 1024 + (ob ^ (((ob >> 9) & 1) << 5)); }
__host__ __device__ __forceinline__ void stage_rc(int b, int& R, int& C) { const int st = b / 1024, sb = b % 1024, swz = sb ^ (((sb >> 9) & 1) << 5); R = (st >> 1) * 16 + swz / 64; C = (st & 1) * 32 + (swz % 64) / 2; }
__host__ __device__ __forceinline__ int perm32(int rho) { const int n = rho >> 4, i = rho & 15; return 8 * (i >> 2) + 4 * n + (i & 3); }

struct Unit { int pm, pn; };
struct Gemm { const bf16_t* A; const bf16_t* Bt; int M, N, K; };

struct StaticOrder {
    int nM, nN, nwg, G, c;
    __host__ __device__ void init(int M, int N, int G_, int c_) { nM = M / BM; nN = N / BM; nwg = nM * nN; G = G_; c = c_; }
    __host__ __device__ bool next(int i, Unit& u) const {
        const long L = (long)i * G + c; if (L >= nwg) return false;
        int wgid = (int)L; { const int q = nwg / NXCD, r = nwg % NXCD, xcd = wgid % NXCD, off = wgid / NXCD; wgid = (xcd < r ? xcd * (q + 1) : r * (q + 1) + (xcd - r) * q) + off; }
        const int nig = WGM * nN, gid = wgid / nig, fm = gid * WGM, gsz = (nM - fm) < WGM ? (nM - fm) : WGM;
        u.pm = fm + ((wgid % nig) % gsz); u.pn = (wgid % nig) / gsz; return true;
    }
    __device__ __forceinline__ void a_ready(const Unit&) const {}
    __device__ __forceinline__ void done(const Unit&) const {}
};

__device__ __forceinline__ unsigned cvt_pk_bf16(float lo, float hi) { unsigned r; asm volatile("v_cvt_pk_bf16_f32 %0, %1, %2" : "=v"(r) : "v"(lo), "v"(hi)); return r; }
template <class Epi, class Sched, bool ALIGN_EPI = false, bool SP2 = false>
__device__ __forceinline__ void gemm_phase(PG8_LAS unsigned char* lds, const Gemm g, const Sched& S, const Epi& E) {
    const int tid = threadIdx.x, wid = __builtin_amdgcn_readfirstlane(tid >> 6), lane = tid & 63, wr = wid >> 2, wc = wid & 3, fr = lane & 15, fq = lane >> 4;
    const int K = g.K, nt = K / BK;
    unsigned voffA[2], voffB[2];
#pragma unroll
    for (int i = 0; i < 2; ++i) { int R, C; stage_rc(tid * 16 + i * 8192, R, C); const int Rb = Epi::PERM ? ((R & ~31) + perm32(R & 31)) : R;
        voffA[i] = (unsigned)(R * K + C) * 2u; voffB[i] = (unsigned)(Rb * K + C) * 2u; }
    const size_t kstep = (size_t)(BK * 2);
    const size_t hstep = (size_t)HALF * K * 2;
    const size_t tstep = 2 * hstep;
    const unsigned ldsw = (unsigned)wid * 1024u;
    const int aoff = lds_byte(wr * 64 + fr, fq * 8), boff = lds_byte(wc * 32 + fr, fq * 8);
#define PG8_SA(b, h) (((b) * 2 + (h)) * HTB)
#define PG8_SB(b, h) ((4 + (b) * 2 + (h)) * HTB)
#define PG8_STAGE(bufoff, gbase, voff) do { _Pragma("unroll") for (int _i = 0; _i < 2; ++_i) \
        __builtin_amdgcn_global_load_lds((const unsigned*)((const char*)(gbase) + (voff)[_i]), (PG8_LAS unsigned*)(lds + (bufoff) + ldsw + _i * 8192), 16, 0, 0); } while (0)
#define PG8_LDA(dst, b, h) do { _Pragma("unroll") for (int m = 0; m < 4; ++m) _Pragma("unroll") for (int k = 0; k < 2; ++k) dst[m][k] = *(const PG8_LAS bf16x8*)(lds + PG8_SA(b, h) + aoff + m * 2048 + k * 1024); } while (0)
#define PG8_LDB(dst, b, h) do { _Pragma("unroll") for (int n = 0; n < 2; ++n) _Pragma("unroll") for (int k = 0; k < 2; ++k) dst[n][k] = *(const PG8_LAS bf16x8*)(lds + PG8_SB(b, h) + boff + n * 2048 + k * 1024); } while (0)
#define PG8_MMA(ai, bj, At, Bt) do { __builtin_amdgcn_s_setprio(1); _Pragma("unroll") for (int m = 0; m < 4; ++m) _Pragma("unroll") for (int n = 0; n < 2; ++n) _Pragma("unroll") for (int k = 0; k < 2; ++k) \
        acc[ai][bj][m][n] = __builtin_amdgcn_mfma_f32_16x16x32_bf16(Bt[n][k], At[m][k], acc[ai][bj][m][n], 0, 0, 0); __builtin_amdgcn_s_setprio(0); } while (0)
#define PG8_WAIT_V(n) asm volatile("s_waitcnt vmcnt(" #n ")" ::: "memory")
#define PG8_WAIT_L(n) asm volatile("s_waitcnt lgkmcnt(" #n ")" ::: "memory")
#define PG8_BAR __builtin_amdgcn_s_barrier()
#define PG8_SCHED __builtin_amdgcn_sched_barrier(0)
    Unit cur, nxt; int ui = 0;
    if (!S.next(0, cur)) return;
    f32x4 acc[2][2][4][2];
#pragma unroll
    for (int a = 0; a < 2; ++a)
#pragma unroll
        for (int b = 0; b < 2; ++b)
#pragma unroll
            for (int m = 0; m < 4; ++m)
#pragma unroll
                for (int n = 0; n < 2; ++n) acc[a][b][m][n] = (f32x4){0.f, 0.f, 0.f, 0.f};
    bf16x8 At[4][2], B0[2][2], B1[2][2];
    const char* cA = (const char*)g.A + (size_t)cur.pm * tstep; const char* cB = (const char*)g.Bt + (size_t)cur.pn * tstep;
    S.a_ready(cur);
    if constexpr (SP2) {
        PG8_STAGE(PG8_SB(0, 0), cB, voffB); PG8_STAGE(PG8_SB(0, 1), cB + hstep, voffB); PG8_STAGE(PG8_SA(0, 0), cA, voffA); PG8_STAGE(PG8_SA(0, 1), cA + hstep, voffA);
        if (wr == 1) PG8_BAR;
        PG8_WAIT_V(2); PG8_BAR;
        PG8_STAGE(PG8_SB(1, 0), cB + kstep, voffB); PG8_STAGE(PG8_SA(1, 0), cA + kstep, voffA); PG8_STAGE(PG8_SB(1, 1), cB + hstep + kstep, voffB);
        PG8_WAIT_V(6); PG8_BAR;
    } else {
        PG8_STAGE(PG8_SB(0, 0), cB, voffB); PG8_STAGE(PG8_SA(0, 0), cA, voffA); PG8_STAGE(PG8_SB(0, 1), cB + hstep, voffB); PG8_STAGE(PG8_SA(0, 1), cA + hstep, voffA);
        if (wr == 1) PG8_BAR;
        PG8_WAIT_V(4); PG8_BAR;
        PG8_STAGE(PG8_SB(1, 0), cB + kstep, voffB); PG8_STAGE(PG8_SA(1, 0), cA + kstep, voffA); PG8_STAGE(PG8_SB(1, 1), cB + hstep + kstep, voffB);
        PG8_WAIT_V(6); PG8_BAR;
    }
    for (;;) {
        const bool has_next = S.next(ui + 1, nxt);
        const char* nA = has_next ? (const char*)g.A + (size_t)nxt.pm * tstep : cA; const char* nB = has_next ? (const char*)g.Bt + (size_t)nxt.pn * tstep : cB;
        for (int t = 0; t < nt; t += 2) {
            const bool last = (t == nt - 2);
            const char* a1 = cA + (size_t)(t + 1) * kstep;
            const char* a2 = last ? nA : cA + (size_t)(t + 2) * kstep; const char* b2 = last ? nB : cB + (size_t)(t + 2) * kstep;
            const char* a3 = a2 + kstep; const char* b3 = b2 + kstep;
            if (last && has_next) S.a_ready(nxt);
            if constexpr (SP2) {
            PG8_LDB(B0, 0, 0); PG8_LDB(B1, 0, 1); PG8_SCHED; PG8_LDA(At, 0, 0); PG8_STAGE(PG8_SA(1, 1), a1 + hstep, voffA);
            PG8_WAIT_V(8); PG8_WAIT_L(0); PG8_BAR; PG8_MMA(0, 0, At, B0); PG8_MMA(0, 1, At, B1); PG8_BAR; PG8_SCHED;
            PG8_LDA(At, 0, 1); PG8_STAGE(PG8_SB(0, 0), b2, voffB); PG8_STAGE(PG8_SB(0, 1), b2 + hstep, voffB); PG8_STAGE(PG8_SA(0, 0), a2, voffA);
            PG8_WAIT_V(8); PG8_WAIT_L(0); PG8_BAR; PG8_MMA(1, 0, At, B0); PG8_MMA(1, 1, At, B1); PG8_BAR; PG8_SCHED;
            PG8_LDB(B0, 1, 0); PG8_LDB(B1, 1, 1); PG8_SCHED; PG8_LDA(At, 1, 0); PG8_STAGE(PG8_SA(0, 1), a2 + hstep, voffA);
            PG8_WAIT_V(8); PG8_WAIT_L(0); PG8_BAR; PG8_MMA(0, 0, At, B0); PG8_MMA(0, 1, At, B1); PG8_BAR; PG8_SCHED;
            PG8_LDA(At, 1, 1); PG8_STAGE(PG8_SB(1, 0), b3, voffB); PG8_STAGE(PG8_SB(1, 1), b3 + hstep, voffB); PG8_STAGE(PG8_SA(1, 0), a3, voffA);
            PG8_WAIT_V(8); PG8_WAIT_L(0); PG8_BAR; PG8_MMA(1, 0, At, B0); PG8_MMA(1, 1, At, B1); PG8_BAR; PG8_SCHED;
            } else {
            PG8_LDB(B0, 0, 0); PG8_SCHED; PG8_LDA(At, 0, 0); PG8_STAGE(PG8_SA(1, 1), a1 + hstep, voffA);
            PG8_WAIT_L(8); PG8_BAR; PG8_WAIT_L(0); PG8_MMA(0, 0, At, B0); PG8_BAR; PG8_SCHED;
            PG8_LDB(B1, 0, 1); PG8_STAGE(PG8_SB(0, 0), b2, voffB);
            PG8_BAR; PG8_WAIT_L(0); PG8_MMA(0, 1, At, B1); PG8_BAR;
            PG8_LDA(At, 0, 1); PG8_STAGE(PG8_SA(0, 0), a2, voffA);
            PG8_BAR; PG8_WAIT_L(0); PG8_MMA(1, 0, At, B0); PG8_BAR; PG8_SCHED;
            PG8_STAGE(PG8_SB(0, 1), b2 + hstep, voffB);
            PG8_WAIT_V(6); PG8_BAR; PG8_MMA(1, 1, At, B1); PG8_BAR;
            PG8_LDB(B0, 1, 0); PG8_SCHED; PG8_LDA(At, 1, 0); PG8_STAGE(PG8_SA(0, 1), a2 + hstep, voffA);
            PG8_WAIT_L(8); PG8_BAR; PG8_WAIT_L(0); PG8_MMA(0, 0, At, B0); PG8_BAR; PG8_SCHED;
            PG8_LDB(B1, 1, 1); PG8_STAGE(PG8_SB(1, 0), b3, voffB);
            PG8_BAR; PG8_WAIT_L(0); PG8_MMA(0, 1, At, B1); PG8_BAR;
            PG8_LDA(At, 1, 1); PG8_STAGE(PG8_SA(1, 0), a3, voffA);
            PG8_BAR; PG8_WAIT_L(0); PG8_MMA(1, 0, At, B0); PG8_BAR; PG8_SCHED;
            PG8_STAGE(PG8_SB(1, 1), b3 + hstep, voffB);
            PG8_WAIT_V(6); PG8_BAR; PG8_MMA(1, 1, At, B1); PG8_BAR;
            }
        }
        if constexpr (ALIGN_EPI) { if (wr == 0) PG8_BAR; }
        if constexpr (!Epi::AFTER_DRAIN) { E(acc, cur, wr, wc, fr, fq); S.done(cur); }
        if (!has_next) break;
#pragma unroll
        for (int a = 0; a < 2; ++a)
#pragma unroll
            for (int b = 0; b < 2; ++b)
#pragma unroll
                for (int m = 0; m < 4; ++m)
#pragma unroll
                    for (int n = 0; n < 2; ++n) acc[a][b][m][n] = (f32x4){0.f, 0.f, 0.f, 0.f};
        cur = nxt; cA = nA; cB = nB; ++ui;
        if constexpr (ALIGN_EPI) { if (wr == 1) PG8_BAR; }
    }
    PG8_WAIT_V(0);
    if constexpr (!ALIGN_EPI) { if (wr == 0) PG8_BAR; }
    PG8_BAR;
    if constexpr (Epi::AFTER_DRAIN) { E.fused(acc, cur, wr, wc, fr, fq, lds, wid, lane); S.done(cur); }
#undef PG8_SA
#undef PG8_SB
#undef PG8_STAGE
#undef PG8_LDA
#undef PG8_LDB
#undef PG8_MMA
#undef PG8_WAIT_V
#undef PG8_WAIT_L
#undef PG8_BAR
#undef PG8_SCHED
}
}
#define GAS __attribute__((address_space(1)))
#define LAS __attribute__((address_space(3)))
typedef unsigned v4u __attribute__((ext_vector_type(4)));
typedef float f32x4 __attribute__((ext_vector_type(4)));
typedef short bf16x8 __attribute__((ext_vector_type(8)));
typedef GAS unsigned gu32;
typedef GAS unsigned long long gu64;
#define RLX_AGENT __ATOMIC_RELAXED, __HIP_MEMORY_SCOPE_AGENT
#define LDS_WAIT() asm volatile("s_waitcnt lgkmcnt(0)" ::: "memory")
#define VM_WAIT() asm volatile("s_waitcnt vmcnt(0)" ::: "memory")
__device__ __forceinline__ unsigned long long rt() { return __builtin_amdgcn_s_memrealtime(); }

#define XB_TMO      128
#define XB_XCNT(j)  (256  + 64 * (j))
#define XB_XSUB(j)  (1280 + 64 * (j))
#define XB_XGEN(j)  (2304 + 64 * (j))
#define XB_TOP      3328
#define XB_TOPGEN   3392
#define XCD_BAR_WORDS 3456
#define XB_SPIN_CAP (1u << 18)

__device__ __forceinline__ unsigned xb_ld(unsigned* p)              { return __hip_atomic_load(p, __ATOMIC_RELAXED, __HIP_MEMORY_SCOPE_AGENT); }
__device__ __forceinline__ unsigned xb_add(unsigned* p, unsigned v) { return __hip_atomic_fetch_add(p, v, __ATOMIC_RELAXED, __HIP_MEMORY_SCOPE_AGENT); }
__device__ __forceinline__ unsigned xb_xcc_id() { return (unsigned)__builtin_amdgcn_s_getreg((3 << 11) | 20) & 0xFu; }
#define XB_SPIN(cond, bar) do { unsigned _sp = 0; while (cond) { __builtin_amdgcn_s_sleep(1); \
    if ((++_sp & 255u) == 0u) { if (xb_ld(&(bar)[XB_TMO])) break; if (_sp > XB_SPIN_CAP) { atomicAdd(&(bar)[XB_TMO], 1u); break; } } } } while (0)

struct XcdBarrier {
    unsigned* bar; unsigned x;
    volatile LAS unsigned* st;
};

__device__ __forceinline__ XcdBarrier xcd_barrier_post(unsigned* bar, volatile LAS unsigned* st) {
    XcdBarrier b; b.bar = bar; b.x = xb_xcc_id(); b.st = st;
    if (threadIdx.x == 0) (void)xb_add(&bar[XB_XCNT(b.x)], 1u);
    return b;
}
__device__ __forceinline__ void xcd_barrier_complete(unsigned* bar, unsigned x, unsigned& nloc, unsigned& nx) {
    const unsigned G = gridDim.x * gridDim.y * gridDim.z;
    unsigned sum, cnt, mine, sp = 0u;
    for (;;) {
        sum = 0u; cnt = 0u; mine = 0u;
#pragma unroll
        for (unsigned j = 0; j < 16; ++j) { const unsigned c = xb_ld(&bar[XB_XCNT(j)]); sum += c; cnt += (c > 0u) ? 1u : 0u; mine = (j == x) ? c : mine; }
        if (sum == G) break;
        __builtin_amdgcn_s_sleep(1);
        if ((++sp & 255u) == 0u) { if (xb_ld(&bar[XB_TMO])) break; if (sp > XB_SPIN_CAP) { atomicAdd(&bar[XB_TMO], 1u); break; } }
    }
    nloc = mine > 0u ? mine : 1u; nx = cnt > 0u ? cnt : 1u;
}

__device__ __forceinline__ void xcd_barrier(const XcdBarrier& b) {
    asm volatile("s_waitcnt vmcnt(0)" ::: "memory");
    __syncthreads();
    if (threadIdx.x == 0) {
        unsigned* bar = b.bar;
        __builtin_amdgcn_s_waitcnt(0);
        unsigned nloc = b.st[0], nx = b.st[1];
        if (nloc == 0u) { xcd_barrier_complete(bar, b.x, nloc, nx); b.st[0] = nloc; b.st[1] = nx; }
        const unsigned old = xb_add(&bar[XB_XSUB(b.x)], 1u);
        const unsigned gen = old / nloc;
        if (old + 1u == (gen + 1u) * nloc) {
            __builtin_amdgcn_fence(__ATOMIC_RELEASE, "agent");
            asm volatile("s_waitcnt vmcnt(0)" ::: "memory");
            const unsigned og = xb_add(&bar[XB_TOP], 1u);
            const unsigned tg = og / nx;
            if (og + 1u == (tg + 1u) * nx) xb_add(&bar[XB_TOPGEN], 1u);
            else XB_SPIN(xb_ld(&bar[XB_TOPGEN]) == tg, bar);
            __builtin_amdgcn_fence(__ATOMIC_ACQUIRE, "agent");
            xb_add(&bar[XB_XGEN(b.x)], 1u);
            asm volatile("s_waitcnt vmcnt(0)" ::: "memory");
        } else {
            XB_SPIN(xb_ld(&bar[XB_XGEN(b.x)]) == gen, bar);
            __builtin_amdgcn_fence(__ATOMIC_ACQUIRE, "agent");
            asm volatile("s_waitcnt vmcnt(0)" ::: "memory");
        }
    }
    __syncthreads();
}

namespace fa {
typedef short bf16x8 __attribute__((ext_vector_type(8)));
typedef short s16x4 __attribute__((ext_vector_type(4)));
typedef float f32x16 __attribute__((ext_vector_type(16)));
typedef unsigned u32x4 __attribute__((ext_vector_type(4)));
typedef short v4i16_t __attribute__((ext_vector_type(4)));
typedef __attribute__((address_space(3))) const char* lds_cptr;
typedef __attribute__((address_space(3))) char* lds_ptr;

constexpr int NSLOT = 3, SLOTB = 8192;
constexpr int LDS_K = 0, LDS_V = NSLOT * SLOTB;
constexpr int LDS_IMP = 2 * NSLOT * SLOTB;
constexpr int LDS_IMPT = LDS_IMP + 4 * 64 * 33 * 4;
constexpr int LDS_ROLE = 131072 + 320 + 4 * 110;
constexpr int LDS_SEL = 131072 - 256;
constexpr int LDS_OT = LDS_IMP;
static_assert(LDS_OT + 65536 <= LDS_SEL && LDS_IMPT + 64 * 33 * 4 <= LDS_SEL, "attention LDS map");

#define FA_NEG (-__builtin_inff())
__device__ __forceinline__ void glds16(const void* gsrc, unsigned lds_dst) { unsigned keep;
    asm volatile("s_mov_b32 %0, m0\n\ts_mov_b32 m0, %2\n\ts_nop 0\n\tglobal_load_lds_dwordx4 %1, off\n\ts_mov_b32 m0, %0" : "=&s"(keep) : "v"(gsrc), "s"(lds_dst) : "memory"); }
#define FA_WAIT_BAR(N) asm volatile("s_waitcnt vmcnt(" #N ") lgkmcnt(0)\n\ts_barrier" ::: "memory")
__device__ __forceinline__ s16x4 vtr(lds_cptr p) { return __builtin_bit_cast(s16x4, __builtin_amdgcn_ds_read_tr16_b64_v4i16((__attribute__((address_space(3))) v4i16_t*)p)); }
typedef float f32x2_t __attribute__((ext_vector_type(2))); typedef __bf16 bf16x2_t __attribute__((ext_vector_type(2)));
__device__ __forceinline__ unsigned cvtpk(float lo, float hi) { f32x2_t v = {lo, hi}; bf16x2_t b = __builtin_convertvector(v, bf16x2_t); return __builtin_bit_cast(unsigned, b); }

__device__ __forceinline__ unsigned char* launder(unsigned char* p) { asm volatile("" : "+s"(p)); return p; }
struct RowCtx {
    int hiAbs, loAbs;
    unsigned selmask; int selshift;
    float sk, lb;
};

__device__ __forceinline__ void qk_scores(lds_cptr kslot, int j, const bf16x8 (&qr)[4], const RowCtx& rc, int r32, int hi, int hk, int lk, bool rowok, f32x16& p0, f32x16& p1) {
    const float lbj = rc.sk * (float)(64 * j + 4 * hi) + rc.lb;
#pragma unroll
    for (int r = 0; r < 16; ++r) { const float c = (float)((r & 3) + 8 * (r >> 2)); p0[r] = __builtin_fmaf(rc.sk, c, lbj); p1[r] = __builtin_fmaf(rc.sk, c + 32.f, lbj); }
    const lds_cptr kp = kslot + hi * 1024 + r32 * 16;
#pragma unroll
    for (int d0 = 0; d0 < 4; ++d0) {
        const bf16x8 b0 = *(const __attribute__((address_space(3))) bf16x8*)(kp + d0 * 2048);
        const bf16x8 b1 = *(const __attribute__((address_space(3))) bf16x8*)(kp + d0 * 2048 + 512);
        p0 = __builtin_amdgcn_mfma_f32_32x32x16_bf16(b0, qr[d0], p0, 0, 0, 0);
        p1 = __builtin_amdgcn_mfma_f32_32x32x16_bf16(b1, qr[d0], p1, 0, 0, 0);
    }
    const bool full = (lk <= 0) && (hk >= 63);
    if (!__all(full)) {
        const int a = lk - 4 * hi, b = hk - 4 * hi;
#pragma unroll
        for (int r = 0; r < 16; ++r) { const int c = (r & 3) + 8 * (r >> 2);
            p0[r] = (c >= a && c <= b) ? p0[r] : FA_NEG; p1[r] = (c + 32 >= a && c + 32 <= b) ? p1[r] : FA_NEG; }
    }
    if (!__all(rowok)) {
#pragma unroll
        for (int r = 0; r < 16; ++r) { p0[r] = rowok ? p0[r] : FA_NEG; p1[r] = rowok ? p1[r] : FA_NEG; }
    }
}
__device__ __forceinline__ void pv_accum(lds_cptr vslot, const f32x16& p0, const f32x16& p1, int lane, int hi, f32x16 (&o)[2]) {
    u32x4 pw[4];
    pw[0] = (u32x4){cvtpk(p0[0], p0[1]), cvtpk(p0[2], p0[3]), cvtpk(p0[4], p0[5]), cvtpk(p0[6], p0[7])};
    pw[1] = (u32x4){cvtpk(p0[8], p0[9]), cvtpk(p0[10], p0[11]), cvtpk(p0[12], p0[13]), cvtpk(p0[14], p0[15])};
    pw[2] = (u32x4){cvtpk(p1[0], p1[1]), cvtpk(p1[2], p1[3]), cvtpk(p1[4], p1[5]), cvtpk(p1[6], p1[7])};
    pw[3] = (u32x4){cvtpk(p1[8], p1[9]), cvtpk(p1[10], p1[11]), cvtpk(p1[12], p1[13]), cvtpk(p1[14], p1[15])};
    const lds_cptr vp = vslot + ((lane >> 4) & 1) * 32 + (lane & 3) * 8 + (4 * hi + ((lane & 15) >> 2)) * 64;
#pragma unroll
    for (int d0 = 0; d0 < 2; ++d0)
#pragma unroll
        for (int ks = 0; ks < 4; ++ks) {
            const s16x4 lo = vtr(vp + d0 * 4096 + ks * 1024), hh = vtr(vp + d0 * 4096 + ks * 1024 + 512);
            const bf16x8 vf = (bf16x8){lo[0], lo[1], lo[2], lo[3], hh[0], hh[1], hh[2], hh[3]};
            o[d0] = __builtin_amdgcn_mfma_f32_32x32x16_bf16(vf, __builtin_bit_cast(bf16x8, pw[ks]), o[d0], 0, 0, 0);
        }
}
__device__ __forceinline__ float rowmax32(const f32x16& p0, const f32x16& p1) {
    float a = __builtin_fmaxf(p0[0], p1[0]);
#pragma unroll
    for (int r = 1; r < 16; ++r) a = __builtin_fmaxf(a, __builtin_fmaxf(p0[r], p1[r]));
    return __builtin_fmaxf(a, __shfl_xor(a, 32));
}


struct RowCtx2 { int hiAbs, loAbs; unsigned selmask; int selshift; float slope2; int kp_mul, kp_off; };
#define FA_THR 16.0f
__device__ __forceinline__ void attn_prefetch(lds_ptr ring, const bf16_t* Kb, const bf16_t* Vb, int jlo, int nt, int wid, int lane, bool withV) {
    if (nt <= 0) return;
    const unsigned lds0 = (unsigned)(uintptr_t)ring;
    const bf16_t* ksrc = Kb + wid * 512 + lane * 8 + (size_t)jlo * 4096;
    glds16(ksrc, (unsigned)__builtin_amdgcn_readfirstlane(lds0 + LDS_K + wid * 1024));
    if (nt > 1) glds16(ksrc + 4096, (unsigned)__builtin_amdgcn_readfirstlane(lds0 + LDS_K + SLOTB + wid * 1024));
    if (withV) { const bf16_t* vsrc = Vb + wid * 512 + lane * 8 + (size_t)jlo * 4096;
        glds16(vsrc, (unsigned)__builtin_amdgcn_readfirstlane(lds0 + LDS_V + wid * 1024)); }
}
#define FA_SBAR() __builtin_amdgcn_sched_barrier(0)
#define FA_PIN(x) asm volatile("" : "+v"(x))
__device__ __forceinline__ void attn_stream2(lds_ptr ring, const bf16_t* Kb, const bf16_t* Vb, int jlo, int jhi, const bf16x8 (&qr)[4], const RowCtx2& rc, int wid, int lane,
                                             float& m, float& l, f32x16 (&o)[2], bool chk, int pre = 0, const bf16_t* Knext = nullptr, int jlo_next = 0, int nt_next = 0, const bf16_t* zrow = nullptr, uint2* zreg = nullptr) {
    const int nt = jhi - jlo;
    if (nt <= 0) { if (Knext) attn_prefetch(ring, Knext, nullptr, jlo_next, nt_next, wid, lane, false); return; }
    const int r32 = lane & 31, hi = lane >> 5;
    const unsigned lds0 = (unsigned)(uintptr_t)ring;
    const bf16_t* ksrc = Kb + wid * 512 + lane * 8;
    const bf16_t* vsrc = Vb + wid * 512 + lane * 8;
    const unsigned kdst = lds0 + LDS_K + wid * 1024, vdst = lds0 + LDS_V + wid * 1024;
#define FA_DMAK(j_, so_) glds16(ksrc + (size_t)(j_) * 4096, (unsigned)__builtin_amdgcn_readfirstlane(kdst + (so_)))
#define FA_DMAV(j_, so_) glds16(vsrc + (size_t)(j_) * 4096, (unsigned)__builtin_amdgcn_readfirstlane(vdst + (so_)))
    if (pre == 0) { FA_DMAK(jlo, 0); if (nt > 1) FA_DMAK(jlo + 1, SLOTB); }
    if (pre < 2) FA_DMAV(jlo, 0);
    const lds_cptr kbase = (lds_cptr)ring + LDS_K + hi * 1024 + r32 * 16;
    const lds_cptr vbase = (lds_cptr)ring + LDS_V + ((lane >> 4) & 1) * 32 + (lane & 3) * 8 + (4 * hi + ((lane & 15) >> 2)) * 64;
    const float skm = rc.slope2 * (float)rc.kp_mul;
    const float a0v = hi ? 1.f : skm * (float)r32, a1v = hi ? 1.f : skm * (float)(r32 + 32);
#define FA_ZERO16 ((f32x16){0.f, 0.f, 0.f, 0.f, 0.f, 0.f, 0.f, 0.f, 0.f, 0.f, 0.f, 0.f, 0.f, 0.f, 0.f, 0.f})
#define FA_MFMA(a, b, c) __builtin_amdgcn_mfma_f32_32x32x16_bf16(a, b, c, 0, 0, 0)
#define FA_KLOAD2(kp, d0) do { kf[2 * (d0)] = *(const __attribute__((address_space(3))) bf16x8*)((kp) + (d0) * 2048); kf[2 * (d0) + 1] = *(const __attribute__((address_space(3))) bf16x8*)((kp) + (d0) * 2048 + 512); } while (0)
    f32x16 pA0, pA1, pB0, pB1; bf16x8 kf[8]; s16x4 vlo[8], vhi[8]; u32x4 pw0, pw1, pw2, pw3;
    int sl_prev = 0, sl_cur = 0, sl_next = SLOTB;
#define FA_ROT() do { sl_prev = sl_cur; sl_cur = sl_next; sl_next = (sl_next == 2 * SLOTB) ? 0 : sl_next + SLOTB; } while (0)
#define FA_TILEPAR(tt_) const int j = jlo + (tt_); int hk = rc.hiAbs - 64 * j; hk = hk > 63 ? 63 : hk; int lk = rc.loAbs - 64 * j; lk = lk < 0 ? 0 : lk; \
        const bool rowok = ((rc.selmask >> (j >> rc.selshift)) & 1u) != 0u; \
        const float lbj = rowok ? rc.slope2 * (float)(rc.kp_mul * 64 * j + rc.kp_off) - m : FA_NEG; \
        const float bv = hi ? lbj : 1.f;
#define FA_MASK(C0, C1) do { const bool full = (lk <= 0) && (hk >= 63); if (!__all(full)) { const int a = lk - 4 * hi, b = hk - 4 * hi; \
        _Pragma("unroll") for (int r = 0; r < 16; ++r) { const int c = (r & 3) + 8 * (r >> 2); \
            C0[r] = (c >= a && c <= b) ? C0[r] : FA_NEG; C1[r] = (c + 32 >= a && c + 32 <= b) ? C1[r] : FA_NEG; } } } while (0)
#define FA_CHK(C0, C1) do { if (chk) { float mx = __builtin_fmaxf(C0[0], C1[0]); \
        _Pragma("unroll") for (int r = 1; r < 16; ++r) mx = __builtin_fmaxf(mx, __builtin_fmaxf(C0[r], C1[r])); \
        if (__any(mx > FA_THR)) { mx = __builtin_fmaxf(mx, __shfl_xor(mx, 32)); \
            const float dl = __builtin_fmaxf(mx, 0.f); fresc = __builtin_amdgcn_exp2f(-dl); m += dl; l *= fresc; resc = true; \
            _Pragma("unroll") for (int r = 0; r < 16; ++r) { C0[r] -= dl; C1[r] -= dl; } } } } while (0)
#define FA_RESC() do { if (resc) { _Pragma("unroll") for (int r = 0; r < 16; ++r) { o[0][r] *= fresc; o[1][r] *= fresc; } } } while (0)
#define FA_PKW(P, i) cvtpk(P[i], P[(i) + 1])
#define FA_PAF(k) __builtin_bit_cast(bf16x8, pw##k)
#define FA_VFR(i) (bf16x8){vlo[i][0], vlo[i][1], vlo[i][2], vlo[i][3], vhi[i][0], vhi[i][1], vhi[i][2], vhi[i][3]}
#define FA_VRD(i) do { vlo[i] = vtr(vp_ + (((i) >> 2) * 4096 + ((i) & 3) * 1024)); vhi[i] = vtr(vp_ + (((i) >> 2) * 4096 + ((i) & 3) * 1024 + 512)); } while (0)
#define FA_KRD(d0) do { FA_KLOAD2(kbase + sl_next, d0); FA_SBAR(); } while (0)
#define FA_GAPA(MF, a0, a1, a2, a3, W0, W1, PW) do { MF; sacc += a0; sacc += a1; sacc += a2; sacc += a3; W0; W1; FA_PIN(PW); FA_PIN(sacc); FA_SBAR(); } while (0)
#define FA_GAPB(MF, X, i) do { MF; X[i] = __builtin_amdgcn_exp2f(X[i]); X[(i) + 1] = __builtin_amdgcn_exp2f(X[(i) + 1]); X[(i) + 2] = __builtin_amdgcn_exp2f(X[(i) + 2]); X[(i) + 3] = __builtin_amdgcn_exp2f(X[(i) + 3]); FA_PIN(X); FA_SBAR(); } while (0)
#define FA_STEP(C0, C1, P0, P1, tt_) do { const int tt = (tt_); FA_TILEPAR(tt) \
        const lds_cptr vp_ = vbase + sl_prev; bool resc = false; float fresc = 1.f; \
        FA_SBAR(); \
        C0 = __builtin_amdgcn_mfma_f32_32x32x2f32(a0v, bv, FA_ZERO16, 0, 0, 0); C1 = __builtin_amdgcn_mfma_f32_32x32x2f32(a1v, bv, FA_ZERO16, 0, 0, 0); FA_SBAR(); \
        FA_VRD(0); FA_SBAR(); float sacc = P0[0] + P0[1]; \
                            FA_GAPA(C0 = FA_MFMA(kf[0], qr[0], C0), P0[2], P0[3], P0[4], P0[5],     pw0[0] = FA_PKW(P0, 0),  pw0[1] = FA_PKW(P0, 2),  pw0); \
        FA_VRD(4); FA_SBAR(); FA_GAPA(C1 = FA_MFMA(kf[1], qr[0], C1), P0[6], P0[7], P0[8], P0[9],     pw0[2] = FA_PKW(P0, 4),  pw0[3] = FA_PKW(P0, 6),  pw0); \
        FA_VRD(1); FA_SBAR(); FA_GAPA(C0 = FA_MFMA(kf[2], qr[1], C0), P0[10], P0[11], P0[12], P0[13], pw1[0] = FA_PKW(P0, 8),  pw1[1] = FA_PKW(P0, 10), pw1); \
        FA_VRD(5); FA_SBAR(); FA_GAPA(C1 = FA_MFMA(kf[3], qr[1], C1), P0[14], P0[15], P1[0], P1[1],   pw1[2] = FA_PKW(P0, 12), pw1[3] = FA_PKW(P0, 14), pw1); \
        FA_VRD(2); FA_SBAR(); FA_GAPA(C0 = FA_MFMA(kf[4], qr[2], C0), P1[2], P1[3], P1[4], P1[5],     pw2[0] = FA_PKW(P1, 0),  pw2[1] = FA_PKW(P1, 2),  pw2); \
        FA_VRD(6); FA_SBAR(); FA_GAPA(C1 = FA_MFMA(kf[5], qr[2], C1), P1[6], P1[7], P1[8], P1[9],     pw2[2] = FA_PKW(P1, 4),  pw2[3] = FA_PKW(P1, 6),  pw2); \
        FA_VRD(3); FA_SBAR(); FA_GAPA(C0 = FA_MFMA(kf[6], qr[3], C0), P1[10], P1[11], P1[12], P1[13], pw3[0] = FA_PKW(P1, 8),  pw3[1] = FA_PKW(P1, 10), pw3); \
        FA_VRD(7); FA_SBAR(); FA_GAPA(C1 = FA_MFMA(kf[7], qr[3], C1), P1[14], P1[15], 0.f, 0.f,       pw3[2] = FA_PKW(P1, 12), pw3[3] = FA_PKW(P1, 14), pw3); \
        l += sacc; \
        if (tt + 3 < nt) FA_DMAK(j + 3, sl_cur);                   \
        if (tt + 1 < nt) FA_DMAV(j + 1, sl_next); \
        FA_MASK(C0, C1); FA_CHK(C0, C1); FA_SBAR(); \
        FA_GAPB(o[0] = FA_MFMA(FA_VFR(0), FA_PAF(0), o[0]), C0, 0);              FA_GAPB(o[1] = FA_MFMA(FA_VFR(4), FA_PAF(0), o[1]), C0, 4); \
        FA_KRD(0); FA_GAPB(o[0] = FA_MFMA(FA_VFR(1), FA_PAF(1), o[0]), C0, 8);   FA_KRD(1); FA_GAPB(o[1] = FA_MFMA(FA_VFR(5), FA_PAF(1), o[1]), C0, 12);     \
        FA_KRD(2); FA_GAPB(o[0] = FA_MFMA(FA_VFR(2), FA_PAF(2), o[0]), C1, 0);   FA_KRD(3); FA_GAPB(o[1] = FA_MFMA(FA_VFR(6), FA_PAF(2), o[1]), C1, 4); \
        FA_GAPB(o[0] = FA_MFMA(FA_VFR(3), FA_PAF(3), o[0]), C1, 8);              FA_GAPB(o[1] = FA_MFMA(FA_VFR(7), FA_PAF(3), o[1]), C1, 12); \
        FA_RESC(); \
    } while (0)
#define FA_ENDW(tt) do { if ((tt) + 3 < nt) { FA_WAIT_BAR(2); } else if ((tt) + 2 < nt) { FA_WAIT_BAR(1); } else { FA_WAIT_BAR(0); } } while (0)
    FA_WAIT_BAR(0);
    if (nt > 2) FA_DMAK(jlo + 2, 2 * SLOTB);
    _Pragma("unroll") for (int d0 = 0; d0 < 4; ++d0) FA_KLOAD2(kbase, d0);
    {   FA_TILEPAR(0) bool resc = false; float fresc = 1.f;
        pA0 = __builtin_amdgcn_mfma_f32_32x32x2f32(a0v, bv, FA_ZERO16, 0, 0, 0); pA1 = __builtin_amdgcn_mfma_f32_32x32x2f32(a1v, bv, FA_ZERO16, 0, 0, 0);
        _Pragma("unroll") for (int d0 = 0; d0 < 4; ++d0) { pA0 = FA_MFMA(kf[2 * d0], qr[d0], pA0); pA1 = FA_MFMA(kf[2 * d0 + 1], qr[d0], pA1); }
        FA_MASK(pA0, pA1); FA_CHK(pA0, pA1); FA_RESC();
        _Pragma("unroll") for (int r = 0; r < 16; ++r) { pA0[r] = __builtin_amdgcn_exp2f(pA0[r]); pA1[r] = __builtin_amdgcn_exp2f(pA1[r]); } }
    FA_WAIT_BAR(1);
    if (nt > 1) {
        if (nt > 3) FA_DMAK(jlo + 3, 0);
        FA_DMAV(jlo + 1, SLOTB); FA_ROT();
        _Pragma("unroll") for (int d0 = 0; d0 < 4; ++d0) FA_KLOAD2(kbase + sl_cur, d0);
        if (nt > 3) FA_WAIT_BAR(2); else FA_WAIT_BAR(0);
        int t = 1;
        for (; t + 1 < nt; t += 2) {
            FA_STEP(pB0, pB1, pA0, pA1, t); FA_ENDW(t); FA_ROT();
            FA_STEP(pA0, pA1, pB0, pB1, t + 1); if (t + 2 < nt) { FA_ENDW(t + 1); FA_ROT(); }
        }
        if (t < nt) { FA_STEP(pB0, pB1, pA0, pA1, t); pA0 = pB0; pA1 = pB1; }
    }
    if (Knext) attn_prefetch(ring, Knext, nullptr, jlo_next, nt_next, wid, lane, false);
    if (zrow) {
#pragma unroll
        for (int d0 = 0; d0 < 2; ++d0)
#pragma unroll
            for (int g4 = 0; g4 < 4; ++g4) zreg[d0 * 4 + g4] = *(const uint2*)(zrow + 32 * d0 + 8 * g4 + 4 * hi);
    }
    {   float sacc = pA0[0] + pA1[0];
#pragma unroll
        for (int r = 1; r < 16; ++r) sacc += pA0[r] + pA1[r];
        l += sacc;
        pw0 = (u32x4){FA_PKW(pA0, 0), FA_PKW(pA0, 2), FA_PKW(pA0, 4), FA_PKW(pA0, 6)}; pw1 = (u32x4){FA_PKW(pA0, 8), FA_PKW(pA0, 10), FA_PKW(pA0, 12), FA_PKW(pA0, 14)};
        pw2 = (u32x4){FA_PKW(pA1, 0), FA_PKW(pA1, 2), FA_PKW(pA1, 4), FA_PKW(pA1, 6)}; pw3 = (u32x4){FA_PKW(pA1, 8), FA_PKW(pA1, 10), FA_PKW(pA1, 12), FA_PKW(pA1, 14)};
        const lds_cptr vp_ = vbase + sl_cur;
        _Pragma("unroll") for (int i = 0; i < 8; ++i) FA_VRD(i);
        o[0] = FA_MFMA(FA_VFR(0), FA_PAF(0), o[0]); o[1] = FA_MFMA(FA_VFR(4), FA_PAF(0), o[1]); o[0] = FA_MFMA(FA_VFR(1), FA_PAF(1), o[0]); o[1] = FA_MFMA(FA_VFR(5), FA_PAF(1), o[1]);
        o[0] = FA_MFMA(FA_VFR(2), FA_PAF(2), o[0]); o[1] = FA_MFMA(FA_VFR(6), FA_PAF(2), o[1]); o[0] = FA_MFMA(FA_VFR(3), FA_PAF(3), o[0]); o[1] = FA_MFMA(FA_VFR(7), FA_PAF(3), o[1]); }
    asm volatile("s_waitcnt lgkmcnt(0)\n\ts_barrier" ::: "memory");
#undef FA_DMAK
#undef FA_DMAV
#undef FA_ZERO16
#undef FA_MFMA
#undef FA_KLOAD2
#undef FA_ROT
#undef FA_TILEPAR
#undef FA_MASK
#undef FA_CHK
#undef FA_RESC
#undef FA_PKW
#undef FA_PAF
#undef FA_VFR
#undef FA_VRD
#undef FA_KRD
#undef FA_GAPA
#undef FA_GAPB
#undef FA_STEP
#undef FA_ENDW
}

__device__ __forceinline__ bool need_maxcheck(const bf16x8 (&qr)[4], const float* gk, int lane, float refslack) {
    float qn = 0.f;
#pragma unroll
    for (int d0 = 0; d0 < 4; ++d0)
#pragma unroll
        for (int i = 0; i < 8; ++i) { const float v = bf2f((unsigned short)qr[d0][i]); qn += v * v; }
    qn += __shfl_xor(qn, 32);
    float gm = __builtin_fabsf(gk[lane]);
#pragma unroll
    for (int o = 1; o < 64; o <<= 1) gm = __builtin_fmaxf(gm, __shfl_xor(gm, o));
    const float bound = sqrtf(qn) * gm * 8.04f + refslack;
    return __any(!(bound <= FA_THR)) != 0;
}
__device__ __forceinline__ void store_oz(const f32x16 (&o)[2], float w, const uint2* zreg, bf16_t* Y, int t, int ycol, int hi) {
#pragma unroll
    for (int d0 = 0; d0 < 2; ++d0)
#pragma unroll
        for (int g4 = 0; g4 < 4; ++g4) {
            const int d = 32 * d0 + 8 * g4 + 4 * hi;
            const uint2 z = zreg[d0 * 4 + g4];
            const float v0 = o[d0][4 * g4 + 0] * w * bf2f(z.x & 0xffff), v1 = o[d0][4 * g4 + 1] * w * bf2f(z.x >> 16);
            const float v2 = o[d0][4 * g4 + 2] * w * bf2f(z.y & 0xffff), v3 = o[d0][4 * g4 + 3] * w * bf2f(z.y >> 16);
            uint2 y; y.x = cvtpk(v0, v1); y.y = cvtpk(v2, v3);
            *(uint2*)(Y + (size_t)t * 1024 + ycol + d) = y;
        }
}
__device__ __forceinline__ void load_q(bf16x8 (&qr)[4], const bf16_t* Qrow, int hi) {
#pragma unroll
    for (int d0 = 0; d0 < 4; ++d0) qr[d0] = *(const bf16x8*)(Qrow + d0 * 16 + hi * 8);
}

#ifdef PROBE_A
#define FA_STAMP(n) do { if (blockIdx.x == 0 && threadIdx.x == 0) ((volatile __attribute__((address_space(3))) unsigned*)(ring + 131072 + 320))[40 + (n)] = (unsigned)__builtin_amdgcn_s_memrealtime(); } while (0)
#else
#define FA_STAMP(n) do {} while (0)
#endif
__device__ __forceinline__ void moba_unit(const KArgs& P, lds_ptr ring, int b, int h, int own, int wid, int lane) {
    unsigned char* ws = launder(P.ws); asm volatile("" : "+v"(lane));
    const bf16_t* QB = (const bf16_t*)(ws + WS_QB); const bf16_t* KB = (const bf16_t*)(ws + WS_KB); const bf16_t* VB = (const bf16_t*)(ws + WS_VB);
    const float* KMP = (const float*)(ws + WS_KMP); const bf16_t* ZB = (const bf16_t*)(ws + WS_ZB); bf16_t* Y = (bf16_t*)(ws + WS_Y);
    const int r32 = lane & 31, hi = lane >> 5;
    const int sq = own * 256 + 32 * wid + r32, t = b * SEQ + sq;
    const size_t hb = (size_t)(b * 8 + h) * SEQ;
    FA_STAMP(own == 7 ? 24 : 28);
    attn_prefetch(ring, KB + hb * 64, VB + hb * 64, 0, 4 * own + 4, wid, lane, true);
    bf16x8 qr[4]; load_q(qr, QB + (hb + sq) * 64, hi);
    __attribute__((address_space(3))) float* kmS = (__attribute__((address_space(3))) float*)(ring + LDS_IMP);
    { const int tid = wid * 64 + lane, n = tid >> 6, d = tid & 63;
      const float* k0 = KMP + (size_t)(b * 8 + n) * 512 + h * 64 + d;
      kmS[tid] = k0[0] + k0[64 * 512]; }
    asm volatile("s_waitcnt vmcnt(0) lgkmcnt(0)\n\ts_barrier" ::: "memory");
    float gate[8];
#pragma unroll
    for (int n = 0; n < 8; ++n) gate[n] = -1e30f;
    if (own > 0) {
        float qf[32];
#pragma unroll
        for (int d0 = 0; d0 < 4; ++d0)
#pragma unroll
            for (int i = 0; i < 8; ++i) qf[8 * d0 + i] = bf2f((unsigned short)qr[d0][i]);
#pragma unroll
        for (int n = 0; n < 7; ++n) {
            float part = 0.f;
#pragma unroll
            for (int d0 = 0; d0 < 4; ++d0)
#pragma unroll
                for (int i = 0; i < 8; ++i) part += qf[8 * d0 + i] * kmS[n * 64 + d0 * 16 + hi * 8 + i];
            const float g = part + __shfl_xor(part, 32);
            gate[n] = n < own ? g : -1e30f;
        }
    }
    FA_STAMP(own == 7 ? 32 : 36);
    unsigned sel = 0;
#pragma unroll
    for (int it = 0; it < 3; ++it) {
        float best = -3e38f; int bi = 0;
#pragma unroll
        for (int n = 0; n < 8; ++n) { const bool ok = !((sel >> n) & 1u) && gate[n] > best; best = ok ? gate[n] : best; bi = ok ? n : bi; }
        sel |= 1u << bi;
    }
    FA_STAMP(own == 7 ? 33 : 37);
    sel &= (1u << own) - 1u;
    sel |= 1u << own;
    const float slope2 = exp2f(-(float)(h + 1)) * LOG2E;
    RowCtx2 rc; rc.hiAbs = sq; rc.loAbs = -(1 << 30); rc.selmask = sel; rc.selshift = 2; rc.slope2 = slope2; rc.kp_mul = 1; rc.kp_off = -sq;
    float m = 0.f, l = 0.f; f32x16 o[2]; uint2 zreg[8];
#pragma unroll
    for (int r = 0; r < 16; ++r) { o[0][r] = 0.f; o[1][r] = 0.f; }
    FA_STAMP(own == 7 ? 25 : 29);
    attn_stream2(ring, KB + hb * 64, VB + hb * 64, 0, 4 * own + 4, qr, rc, wid, lane, m, l, o, need_maxcheck(qr, P.b_knorm_g, lane, 0.f), 2, nullptr, 0, 0, ZB + (size_t)t * 512 + h * 64, zreg);
    FA_STAMP(own == 7 ? 26 : 30);
    l += __shfl_xor(l, 32);
    const float inv = l > 0.f ? __builtin_amdgcn_rcpf(l) : 0.f;
    store_oz(o, inv, zreg, Y, t, 512 + h * 64, hi);
    FA_STAMP(own == 7 ? 27 : 31);
}

__device__ __forceinline__ void swa_unit(const KArgs& P, lds_ptr ring, int b, int g, int c, int wid, int lane) {
    unsigned char* ws = launder(P.ws); asm volatile("" : "+v"(lane));
    const bf16_t* QD = (const bf16_t*)(ws + WS_QD); const bf16_t* KD = (const bf16_t*)(ws + WS_KD); const bf16_t* VD = (const bf16_t*)(ws + WS_VD);
    const bf16_t* ZD = (const bf16_t*)(ws + WS_ZD); bf16_t* Y = (bf16_t*)(ws + WS_Y);
    const int r32 = lane & 31, hi = lane >> 5, h = 4 * g + (wid >> 1);
    const int sq = 64 * c + 32 * (wid & 1) + r32, t = b * SEQ + sq;
    const size_t gb = (size_t)(b * 2 + g) * SEQ * 64;
    attn_prefetch(ring, KD + gb, VD + gb, c >= 2 ? c - 2 : 0, c >= 2 ? 3 : c + 1, wid, lane, true);
    bf16x8 qr[4]; load_q(qr, QD + ((size_t)(b * 8 + h) * SEQ + sq) * 64, hi);
    const float slope2 = exp2f(-(float)(h + 1)) * LOG2E;
    RowCtx2 rc; rc.hiAbs = sq; rc.loAbs = sq - 127; rc.selmask = 0xffffffffu; rc.selshift = 0; rc.slope2 = slope2; rc.kp_mul = 1; rc.kp_off = -sq;
    float m = P.d_sinks[h] * LOG2E, l = hi == 0 ? 1.f : 0.f; f32x16 o[2]; uint2 zreg[8];
#pragma unroll
    for (int r = 0; r < 16; ++r) { o[0][r] = 0.f; o[1][r] = 0.f; }
    attn_stream2(ring, KD + gb, VD + gb, c >= 2 ? c - 2 : 0, c + 1, qr, rc, wid, lane, m, l, o, need_maxcheck(qr, P.d_knorm_g, lane, __builtin_fabsf(m)), 2, nullptr, 0, 0, ZD + (size_t)t * 512 + h * 64, zreg);
    l += __shfl_xor(l, 32);
    store_oz(o, __builtin_amdgcn_rcpf(l), zreg, Y, t, 512 + h * 64, hi);
}

__device__ __forceinline__ void nsa_unit(const KArgs& P, lds_ptr ring, int b, int g, int c, int wid, int lane, int tid) {
    unsigned char* ws = launder(P.ws); asm volatile("" : "+v"(lane));
    const bf16_t* QC = (const bf16_t*)(ws + WS_QC); const bf16_t* KC = (const bf16_t*)(ws + WS_KC); const bf16_t* VC = (const bf16_t*)(ws + WS_VC);
    const bf16_t* KS = (const bf16_t*)(ws + WS_KS); const bf16_t* VS = (const bf16_t*)(ws + WS_VS);
    const bf16_t* KW = (const bf16_t*)(ws + WS_KW); const bf16_t* VW = (const bf16_t*)(ws + WS_VW);
    const float* GT = (const float*)(ws + WS_GT); const bf16_t* ZC = (const bf16_t*)(ws + WS_ZC); bf16_t* Y = (bf16_t*)(ws + WS_Y);
    const int r32 = lane & 31, hi = lane >> 5, hh = wid >> 1, h = 4 * g + hh;
    const int tok = 32 * (wid & 1) + r32, sq = 64 * c + tok, t = b * SEQ + sq;
    if (c == 31) FA_STAMP(44);
    bf16x8 qr[4]; load_q(qr, QC + ((size_t)(b * 8 + h) * SEQ + sq) * 64, hi);
    const float slope2 = exp2f(-(float)(h + 1)) * LOG2E;
    const size_t gbe = (size_t)(b * 2 + g) * SEQ * 64;
    const float g0 = GT[(size_t)t * 32 + h], g1 = GT[(size_t)t * 32 + 8 + h], g2 = GT[(size_t)t * 32 + 16 + h];
    f32x16 o[2];
#pragma unroll
    for (int r = 0; r < 16; ++r) { o[0][r] = 0.f; o[1][r] = 0.f; }
    __attribute__((address_space(3))) float* otS = (__attribute__((address_space(3))) float*)(ring + LDS_OT) + wid * 2048 + lane;
    __attribute__((address_space(3))) float* impH = (__attribute__((address_space(3))) float*)(ring + LDS_IMP);
    __attribute__((address_space(3))) float* impT = (__attribute__((address_space(3))) float*)(ring + LDS_IMPT);
    __attribute__((address_space(3))) unsigned* selS = (__attribute__((address_space(3))) unsigned*)(ring + LDS_SEL);
    {
        const bf16_t* kc = KC + (size_t)(b * 2 + g) * 128 * 64; const bf16_t* vc = VC + (size_t)(b * 2 + g) * 128 * 64;
        const unsigned lds0 = (unsigned)(uintptr_t)ring;
        const bf16_t* ksrc = kc + wid * 512 + lane * 8;
        const bf16_t* vsrc = vc + wid * 512 + lane * 8;
        glds16(ksrc, (unsigned)__builtin_amdgcn_readfirstlane(lds0 + LDS_K + wid * 1024)); glds16(vsrc, (unsigned)__builtin_amdgcn_readfirstlane(lds0 + LDS_V + wid * 1024));
        glds16(ksrc + 4096, (unsigned)__builtin_amdgcn_readfirstlane(lds0 + LDS_K + SLOTB + wid * 1024)); glds16(vsrc + 4096, (unsigned)__builtin_amdgcn_readfirstlane(lds0 + LDS_V + SLOTB + wid * 1024));
        FA_WAIT_BAR(0);
        RowCtx rc; int hc = (sq - 31) >> 4; rc.hiAbs = hc > 126 ? 126 : hc; rc.loAbs = -(1 << 30); rc.selmask = 0xffffffffu; rc.selshift = 0; rc.sk = 16.f * slope2; rc.lb = slope2 * (float)(31 - 64 * c);
        f32x16 a0, a1, b0, b1;
        { int hk = rc.hiAbs; hk = hk > 63 ? 63 : hk; qk_scores((lds_cptr)ring + LDS_K, 0, qr, rc, r32, hi, hk, 0, true, a0, a1); }
        { int hk = rc.hiAbs - 64; hk = hk > 63 ? 63 : hk; qk_scores((lds_cptr)ring + LDS_K + SLOTB, 1, qr, rc, r32, hi, hk, 0, true, b0, b1); }
        float mx = __builtin_fmaxf(rowmax32(a0, a1), rowmax32(b0, b1));
        mx = mx > -1e37f ? mx : 0.f;
        float sum = 0.f;
#pragma unroll
        for (int r = 0; r < 16; ++r) { a0[r] = __builtin_amdgcn_exp2f(a0[r] - mx); a1[r] = __builtin_amdgcn_exp2f(a1[r] - mx); b0[r] = __builtin_amdgcn_exp2f(b0[r] - mx); b1[r] = __builtin_amdgcn_exp2f(b1[r] - mx);
            sum += (a0[r] + a1[r]) + (b0[r] + b1[r]); }
        sum += __shfl_xor(sum, 32);
        const float inv = sum > 0.f ? __builtin_amdgcn_rcpf(sum) : 0.f;
#pragma unroll
        for (int r = 0; r < 16; ++r) { a0[r] *= inv; a1[r] *= inv; b0[r] *= inv; b1[r] *= inv; }
        float ss[16], ee[16];
#pragma unroll
        for (int i = 0; i < 4; ++i) {
            ss[i] = (a0[4 * i] + a0[4 * i + 1]) + (a0[4 * i + 2] + a0[4 * i + 3]); ee[i] = a0[4 * i + 3];
            ss[4 + i] = (a1[4 * i] + a1[4 * i + 1]) + (a1[4 * i + 2] + a1[4 * i + 3]); ee[4 + i] = a1[4 * i + 3];
            ss[8 + i] = (b0[4 * i] + b0[4 * i + 1]) + (b0[4 * i + 2] + b0[4 * i + 3]); ee[8 + i] = b0[4 * i + 3];
            ss[12 + i] = (b1[4 * i] + b1[4 * i + 1]) + (b1[4 * i + 2] + b1[4 * i + 3]); ee[12 + i] = b1[4 * i + 3];
        }
        float ep[16];
#pragma unroll
        for (int k = 0; k < 16; ++k) ep[k] = __shfl_xor(ee[k], 32);
#pragma unroll
        for (int k = 0; k < 16; ++k) {
            const float prev = k > 0 ? ep[k > 0 ? k - 1 : 0] : 0.f;
            const float v = ss[k] + (hi ? ep[k] : prev);
            impH[(hh * 64 + tok) * 33 + 2 * k + hi] = v;
        }
        pv_accum((lds_cptr)ring + LDS_V, a0, a1, lane, hi, o);
        pv_accum((lds_cptr)ring + LDS_V + SLOTB, b0, b1, lane, hi, o);
        asm volatile("s_waitcnt lgkmcnt(0)\n\ts_barrier" ::: "memory");
        attn_prefetch(ring, KS + gbe, VS + gbe, 0, c + 1, wid, lane, true);
        {
            const int tk = tid >> 3, part = tid & 7;
#pragma unroll
            for (int i = 0; i < 4; ++i) { const int n = 4 * part + i;
                float v = (impH[(0 * 64 + tk) * 33 + n] + impH[(1 * 64 + tk) * 33 + n]) + (impH[(2 * 64 + tk) * 33 + n] + impH[(3 * 64 + tk) * 33 + n]);
                if (n == 0 || n == c || n == c - 1) v = 1e4f;
                if (n > c) v = -1e30f;
                impT[tk * 33 + n] = v; }
            asm volatile("s_waitcnt lgkmcnt(0)\n\ts_barrier" ::: "memory");
            float mine[4]; int rank[4];
#pragma unroll
            for (int i = 0; i < 4; ++i) { mine[i] = impT[tk * 33 + 4 * part + i]; rank[i] = 0; }
#pragma unroll 1
            for (int mI = 0; mI < 32; ++mI) { const float v = impT[tk * 33 + mI];
#pragma unroll
                for (int i = 0; i < 4; ++i) rank[i] += (v > mine[i] || (v == mine[i] && mI < 4 * part + i)) ? 1 : 0; }
            unsigned bits = 0;
#pragma unroll
            for (int i = 0; i < 4; ++i) if (rank[i] < 16) bits |= 1u << (4 * part + i);
            bits |= __shfl_xor(bits, 1); bits |= __shfl_xor(bits, 2); bits |= __shfl_xor(bits, 4);
            if (part == 0) selS[tk] = bits;
            asm volatile("s_waitcnt lgkmcnt(0)\n\ts_barrier" ::: "memory");
        }
    }
    const unsigned sel = selS[tok];
    if (c == 31) FA_STAMP(45);
    const size_t gb = (size_t)(b * 2 + g) * SEQ * 64;
#pragma unroll
    for (int r = 0; r < 16; ++r) { otS[r * 64] = o[0][r] * g0; otS[(16 + r) * 64] = o[1][r] * g0; }
    {
        RowCtx2 rc; rc.hiAbs = sq; rc.loAbs = -(1 << 30); rc.selmask = sel; rc.selshift = 0; rc.slope2 = slope2; rc.kp_mul = 1; rc.kp_off = -sq;
        float m = 0.f, l = 0.f;
#pragma unroll
        for (int r = 0; r < 16; ++r) { o[0][r] = 0.f; o[1][r] = 0.f; }
        attn_stream2(ring, KS + gb, VS + gb, 0, c + 1, qr, rc, wid, lane, m, l, o, need_maxcheck(qr, P.c_knorm_slc_g, lane, 0.f), 2, KW + gb, c >= 8 ? c - 8 : 0, c >= 8 ? 9 : c + 1);
        l += __shfl_xor(l, 32);
        if (c == 31) FA_STAMP(46);
        const float w1 = l > 0.f ? g1 * __builtin_amdgcn_rcpf(l) : 0.f;
#pragma unroll
        for (int r = 0; r < 16; ++r) { otS[r * 64] += o[0][r] * w1; otS[(16 + r) * 64] += o[1][r] * w1; }
    }
    uint2 zreg[8];
    {
        RowCtx2 rc; rc.hiAbs = sq; rc.loAbs = sq - 511; rc.selmask = 0xffffffffu; rc.selshift = 0; rc.slope2 = slope2; rc.kp_mul = 1; rc.kp_off = -sq;
        float m = 0.f, l = 0.f;
#pragma unroll
        for (int r = 0; r < 16; ++r) { o[0][r] = 0.f; o[1][r] = 0.f; }
        attn_stream2(ring, KW + gb, VW + gb, c >= 8 ? c - 8 : 0, c + 1, qr, rc, wid, lane, m, l, o, need_maxcheck(qr, P.c_knorm_win_g, lane, 0.f), 1, nullptr, 0, 0, ZC + (size_t)t * 512 + h * 64, zreg);
        l += __shfl_xor(l, 32);
        if (c == 31) FA_STAMP(47);
        const float w2 = l > 0.f ? g2 * __builtin_amdgcn_rcpf(l) : 0.f;
#pragma unroll
        for (int r = 0; r < 16; ++r) { o[0][r] = o[0][r] * w2 + otS[r * 64]; o[1][r] = o[1][r] * w2 + otS[(16 + r) * 64]; }
    }
    store_oz(o, 1.f, zreg, Y, t, h * 64, hi);
    if (c == 31) FA_STAMP(48);
}
}
namespace fm {
typedef short bf16x8 __attribute__((ext_vector_type(8)));
typedef float f32x4 __attribute__((ext_vector_type(4)));
typedef float f32x2 __attribute__((ext_vector_type(2)));
__device__ __forceinline__ float wave_sum(float v) {
#pragma unroll
    for (int o = 1; o < 64; o <<= 1) v += __shfl_xor(v, o);
    return v;
}
struct ConvW { float w0[31], w1[31]; float2 bias; float4 ga, gb, ba, bb2; };
__device__ __forceinline__ void conv_load_w(const KArgs& P, ConvW& W, int tid, int lane) {
    const int cp = tid & 255;
#pragma unroll
    for (int j = 0; j < 31; ++j) { const float2 w = *(const float2*)(P.a_conv_w + j * 512 + 2 * cp); W.w0[j] = w.x; W.w1[j] = w.y; }
    W.bias = *(const float2*)(P.a_conv_b + 2 * cp);
    W.ga = *(const float4*)(P.a_ln_g + 4 * lane); W.gb = *(const float4*)(P.a_ln_g + 256 + 4 * lane);
    W.ba = *(const float4*)(P.a_ln_b + 4 * lane); W.bb2 = *(const float4*)(P.a_ln_b + 256 + 4 * lane);
}
__device__ __forceinline__ void conv_unit(const KArgs& P, LAS unsigned char* lds, int u, const ConvW& W, int tid, int wave, int lane) {
    const bf16_t* G0 = (const bf16_t*)(P.ws + WS_G0); const bf16_t* ZA = (const bf16_t*)(P.ws + WS_ZA); bf16_t* Y = (bf16_t*)(P.ws + WS_Y);
    LAS float* cy = (LAS float*)lds;
    const int cp = tid & 255, sb = tid >> 8;
    {
        const int t0 = u * 32, s0 = t0 & (SEQ - 1);
        float acc0[16], acc1[16];
#pragma unroll
        for (int o = 0; o < 16; ++o) { acc0[o] = W.bias.x; acc1[o] = W.bias.y; }
        const int sbase = s0 + 16 * sb - 30, tmin = t0 - s0, tb = t0 + 16 * sb - 30;
        unsigned xv[46];
#pragma unroll
        for (int i = 0; i < 46; ++i) { int row = tb + i; row = row < tmin ? tmin : row; xv[i] = *(const unsigned*)(G0 + (size_t)row * 512 + 2 * cp); }
#pragma unroll
        for (int i = 0; i < 46; ++i) {
            const bool ok = sbase + i >= 0;
            const float x0 = ok ? bf2f(xv[i] & 0xffff) : 0.f, x1 = ok ? bf2f(xv[i] >> 16) : 0.f;
#pragma unroll
            for (int o = 0; o < 16; ++o) { const int j = i - o; if (j >= 0 && j <= 30) { acc0[o] += x0 * W.w0[j]; acc1[o] += x1 * W.w1[j]; } }
        }
#pragma unroll
        for (int o = 0; o < 16; ++o) { f32x2 r; r.x = acc0[o]; r.y = acc1[o]; *(LAS f32x2*)(cy + (16 * sb + o) * 512 + 2 * cp) = r; }
        __syncthreads();
#pragma unroll
        for (int k = 0; k < 4; ++k) {
            const int tok = 4 * wave + k, t = t0 + tok;
            f32x4 a = *(const LAS f32x4*)(cy + tok * 512 + 4 * lane), b = *(const LAS f32x4*)(cy + tok * 512 + 256 + 4 * lane);
            const float mean = wave_sum((a.x + a.y) + (a.z + a.w) + (b.x + b.y) + (b.z + b.w)) * (1.0f / 512);
            a.x -= mean; a.y -= mean; a.z -= mean; a.w -= mean; b.x -= mean; b.y -= mean; b.z -= mean; b.w -= mean;
            const float var = wave_sum((a.x * a.x + a.y * a.y) + (a.z * a.z + a.w * a.w) + (b.x * b.x + b.y * b.y) + (b.z * b.z + b.w * b.w)) * (1.0f / 512);
            const float rstd = __builtin_amdgcn_rsqf(var + EPSF);
            const uint2 za = *(const uint2*)(ZA + (size_t)t * 512 + 4 * lane), zb = *(const uint2*)(ZA + (size_t)t * 512 + 256 + 4 * lane);
            float y0 = fast_silu(a.x * rstd * W.ga.x + W.ba.x) * bf2f(za.x & 0xffff), y1 = fast_silu(a.y * rstd * W.ga.y + W.ba.y) * bf2f(za.x >> 16);
            float y2 = fast_silu(a.z * rstd * W.ga.z + W.ba.z) * bf2f(za.y & 0xffff), y3 = fast_silu(a.w * rstd * W.ga.w + W.ba.w) * bf2f(za.y >> 16);
            uint2 o; o.x = pk2(y0, y1); o.y = pk2(y2, y3);
            *(uint2*)(Y + (size_t)t * 1024 + 4 * lane) = o;
            y0 = fast_silu(b.x * rstd * W.gb.x + W.bb2.x) * bf2f(zb.x & 0xffff); y1 = fast_silu(b.y * rstd * W.gb.y + W.bb2.y) * bf2f(zb.x >> 16);
            y2 = fast_silu(b.z * rstd * W.gb.z + W.bb2.z) * bf2f(zb.y & 0xffff); y3 = fast_silu(b.w * rstd * W.gb.w + W.bb2.w) * bf2f(zb.y >> 16);
            o.x = pk2(y0, y1); o.y = pk2(y2, y3);
            *(uint2*)(Y + (size_t)t * 1024 + 256 + 4 * lane) = o;
        }
        __syncthreads();
    }
}

__device__ __forceinline__ void cmp_unit(const KArgs& P, LAS unsigned char* lds, int u, int tid, int wave, int lane) {
    const int kv = u >> 7, bg = (u >> 3) & 15, rb = u & 7, fr = lane & 15, fq = lane >> 4;
    const bf16_t* X = (const bf16_t*)(P.ws + (kv == 0 ? WS_KCR : WS_VCR)) + ((size_t)bg * SEQ + 256 * rb) * 64;
    const bf16_t* W1f = (const bf16_t*)(P.ws + WS_CW1) + (size_t)kv * 256 * 2048;
    const bf16_t* W2t = (const bf16_t*)(P.ws + WS_CW2) + (size_t)kv * 64 * 256;
    const float* B1P = (const float*)(P.ws + WS_B1P) + (size_t)kv * 16 * 256;
    LAS unsigned char* xs = lds;
    LAS bf16_t* hidS = (LAS bf16_t*)(lds + 272 * 128);
    LAS float* outS = (LAS float*)(lds + 272 * 128 + 16 * 264 * 2);
    const bf16_t* bp0 = W1f + (size_t)(2 * wave) * 64 * 512 + lane * 8; const bf16_t* bp1 = bp0 + 64 * 512;
    bf16x8 bb[4][8];
#define CMP_LOADB(buf, ch) do { _Pragma("unroll") for (int q_ = 0; q_ < 4; ++q_) { bb[buf][2 * q_] = *(const bf16x8*)(bp0 + (size_t)(4 * (ch) + q_) * 512); bb[buf][2 * q_ + 1] = *(const bf16x8*)(bp1 + (size_t)(4 * (ch) + q_) * 512); } } while (0)
    CMP_LOADB(0, 0); CMP_LOADB(1, 1); CMP_LOADB(2, 2);
#pragma unroll
    for (int i = 0; i < 5; ++i) { const int idx = tid + 512 * i;
        if (idx < 2176) { const int t = idx >> 3, c = idx & 7; const uint4 v = *(const uint4*)(X + (size_t)t * 64 + c * 8);
            *(LAS v4u*)(xs + t * 128 + ((c ^ ((t >> 4) & 7)) << 4)) = (v4u){v.x, v.y, v.z, v.w}; } }
    __syncthreads();
    {
        const int n0 = 32 * wave;
        f32x4 acc0 = {0.f, 0.f, 0.f, 0.f}, acc1 = {0.f, 0.f, 0.f, 0.f};
#pragma unroll
        for (int ch = 0; ch < 16; ++ch) {
            if (ch + 3 < 16) CMP_LOADB((ch + 3) & 3, ch + 3);
#pragma unroll
            for (int q = 0; q < 4; ++q) {
                const int ks = 4 * ch + q, tau = ks >> 1, c = (ks & 1) * 4 + fq, t = 16 * fr + tau;
                const bf16x8 a = *(const LAS bf16x8*)(xs + t * 128 + ((c ^ ((t >> 4) & 7)) << 4));
                acc0 = __builtin_amdgcn_mfma_f32_16x16x32_bf16(a, bb[ch & 3][2 * q], acc0, 0, 0, 0);
                acc1 = __builtin_amdgcn_mfma_f32_16x16x32_bf16(a, bb[ch & 3][2 * q + 1], acc1, 0, 0, 0);
            }
        }
#undef CMP_LOADB
        const float* b1 = kv == 0 ? P.c_k_b1 : P.c_v_b1;
#pragma unroll
        for (int f = 0; f < 2; ++f) {
            const int n = n0 + 16 * f + fr;
            float bias = b1[n];
#pragma unroll
            for (int kc = 0; kc < 16; ++kc) bias += B1P[kc * 256 + n];
#pragma unroll
            for (int r = 0; r < 4; ++r) { const float v = (f == 0 ? acc0[r] : acc1[r]) + bias; hidS[(4 * fq + r) * 264 + n] = f2bf(fast_silu(v)); }
        }
    }
    __syncthreads();
    if (wave < 4) {
        const int d0 = 16 * wave;
        f32x4 acc = {0.f, 0.f, 0.f, 0.f};
#pragma unroll
        for (int k0 = 0; k0 < 256; k0 += 32) {
            const bf16x8 a = *(const LAS bf16x8*)(hidS + fr * 264 + k0 + 8 * fq);
            const bf16x8 b = *(const bf16x8*)(W2t + (size_t)(d0 + fr) * 256 + k0 + 8 * fq);
            acc = __builtin_amdgcn_mfma_f32_16x16x32_bf16(a, b, acc, 0, 0, 0);
        }
        const float b2 = (kv == 0 ? P.c_k_b2 : P.c_v_b2)[d0 + fr];
#pragma unroll
        for (int r = 0; r < 4; ++r) outS[(4 * fq + r) * 65 + d0 + fr] = acc[r] + b2;
    }
    __syncthreads();
    {
        bf16_t* dst = (bf16_t*)(P.ws + (kv == 0 ? WS_KC : WS_VC)) + (size_t)bg * 128 * 64;
#pragma unroll
        for (int k = 0; k < 2; ++k) {
            const int row = 2 * wave + k, c = 16 * rb + row;
            float v = outS[row * 65 + lane];
            if (kv == 0) { const float ss = wave_sum(v * v); v = v * __builtin_amdgcn_rsqf(ss * (1.0f / 64) + EPSF) * P.c_knorm_cmp_g[lane]; }
            const size_t off = kv == 0 ? (size_t)(c >> 6) * 4096 + (lane >> 3) * 512 + (c & 63) * 8 + (lane & 7)
                                       : (size_t)(c >> 6) * 4096 + (lane >> 5) * 2048 + (c & 63) * 32 + (lane & 31);
            dst[off] = c < 127 ? f2bf(v) : (bf16_t)0;
        }
    }
    __syncthreads();
}

__device__ __forceinline__ void gate_unit(const KArgs& P, LAS unsigned char* lds, int u, int tid, int wave, int lane) {
    const bf16_t* XB = (const bf16_t*)(P.ws + WS_XB); const bf16_t* WG = (const bf16_t*)(P.ws + WS_WGATE); const float* SSQ = (const float*)(P.ws + WS_SSQ); float* GT = (float*)(P.ws + WS_GT);
    const int fr = lane & 15, fq = lane >> 4, mf = wave & 3, kh = wave >> 2, t0 = 64 * u + 16 * mf;
    constexpr int ROWB = 2064;
    LAS float* part = (LAS float*)(lds + 32 * ROWB);
#pragma unroll
    for (int i = 0; i < 8; ++i) { const int idx = tid + 512 * i, n = idx >> 7, ch = idx & 127;
        const uint4 v = *(const uint4*)(WG + (size_t)n * DM + ch * 8);
        *(LAS v4u*)(lds + n * ROWB + ch * 16) = (v4u){v.x, v.y, v.z, v.w}; }
    bf16x8 a[16];
    const bf16_t* ap = XB + (size_t)(t0 + fr) * DM + kh * 512 + 8 * fq;
#pragma unroll
    for (int i = 0; i < 16; ++i) a[i] = *(const bf16x8*)(ap + 32 * i);
    __syncthreads();
    f32x4 acc0 = {0.f, 0.f, 0.f, 0.f}, acc1 = {0.f, 0.f, 0.f, 0.f};
    const LAS unsigned char* bp = lds + fr * ROWB + (kh * 512 + 8 * fq) * 2;
#pragma unroll
    for (int i = 0; i < 16; ++i) {
        const bf16x8 b0 = *(const LAS bf16x8*)(bp + 64 * i), b1 = *(const LAS bf16x8*)(bp + 16 * ROWB + 64 * i);
        acc0 = __builtin_amdgcn_mfma_f32_16x16x32_bf16(a[i], b0, acc0, 0, 0, 0);
        acc1 = __builtin_amdgcn_mfma_f32_16x16x32_bf16(a[i], b1, acc1, 0, 0, 0);
    }
    if (kh == 1) {
#pragma unroll
        for (int r = 0; r < 4; ++r) { part[(mf * 64 + lane) * 8 + r] = acc0[r]; part[(mf * 64 + lane) * 8 + 4 + r] = acc1[r]; }
    }
    __syncthreads();
    if (kh == 0) {
#pragma unroll
        for (int r = 0; r < 4; ++r) {
            const int t = t0 + 4 * fq + r;
            const float4* sq = (const float4*)(SSQ + (size_t)t * 16);
            const float4 q0 = sq[0], q1 = sq[1], q2 = sq[2], q3 = sq[3];
            const float ssq = ((q0.x + q0.y) + (q0.z + q0.w)) + ((q1.x + q1.y) + (q1.z + q1.w)) + ((q2.x + q2.y) + (q2.z + q2.w)) + ((q3.x + q3.y) + (q3.z + q3.w));
            const float rstd = __builtin_amdgcn_rsqf(ssq * (1.0f / DM) + EPSF);
            GT[(size_t)t * 32 + fr] = fast_sigmoid((acc0[r] + part[(mf * 64 + lane) * 8 + r]) * rstd);
            if (fr < 8) GT[(size_t)t * 32 + 16 + fr] = fast_sigmoid((acc1[r] + part[(mf * 64 + lane) * 8 + 4 + r]) * rstd);
        }
    }
    __syncthreads();
}

__device__ __forceinline__ void b1p_item(const KArgs& P, int it, int lane) {
    const int kv = it >> 6, kc = (it >> 2) & 15, n = (it & 3) * 64 + lane;
    const float* pos = kv == 0 ? P.c_pos_k : P.c_pos_v; const float* w1 = kv == 0 ? P.c_k_w1 : P.c_v_w1;
    float s = 0.f;
#pragma unroll 32
    for (int k = kc * 128; k < kc * 128 + 128; ++k) s += pos[k] * w1[(size_t)k * 256 + n];
    ((float*)(P.ws + WS_B1P))[((size_t)kv * 16 + kc) * 256 + n] = s;
}
__device__ __forceinline__ void w1f_item(const KArgs& P, int it, int lane) {
    const int kv = it >> 7, nf = (it >> 3) & 15, ks8 = it & 7, fr = lane & 15, fq = lane >> 4;
    const float* w1 = kv == 0 ? P.c_k_w1 : P.c_v_w1;
    bf16_t* dst = (bf16_t*)(P.ws + WS_CW1) + (size_t)kv * 256 * 2048 + (size_t)nf * 64 * 512 + lane * 8;
    float v[8][8];
#pragma unroll
    for (int q = 0; q < 8; ++q) {
        const float* src = w1 + (size_t)(32 * (ks8 * 8 + q) + 8 * fq) * 256 + 16 * nf + fr;
#pragma unroll
        for (int j = 0; j < 8; ++j) v[q][j] = src[j * 256];
    }
#pragma unroll
    for (int q = 0; q < 8; ++q) {
        uint4 o; o.x = pk2(v[q][0], v[q][1]); o.y = pk2(v[q][2], v[q][3]); o.z = pk2(v[q][4], v[q][5]); o.w = pk2(v[q][6], v[q][7]);
        *(uint4*)(dst + (size_t)(ks8 * 8 + q) * 512) = o;
    }
}
}
__device__ __forceinline__ NvGroup fast_group(const KArgs& P, int layer, int pn, int wc) {
    if (layer == 0) {
        if (pn < 4) { NvGroup g; g.gain = nullptr; g.scale = 1.f; g.width = 32; g.type = 4; g.col = 128 * pn + 32 * wc; g.col2 = 512 + g.col; g.dkind = 0; g.dst = P.ws + WS_G0; g.ld = 512; g.idx = 0; return g; }
        return nv_group0(P, 8 + 4 * (pn - 4) + wc);
    }
    int gi;
    if (pn < 2) gi = 4 * pn + wc;
    else if (pn < 4) gi = 21 + 4 * (pn - 2) + wc;
    else if (pn < 6) gi = 29 + 4 * (pn - 4) + wc;
    else if (pn < 8) gi = 41 + 4 * (pn - 6) + wc;
    else if (pn == 8) gi = 8 + wc;
    else if (pn == 9) gi = wc < 2 ? 12 + wc : 16 + (wc - 2);
    else if (pn == 10) gi = wc < 2 ? 14 + wc : 18 + (wc - 2);
    else if (pn == 11) gi = wc < 2 ? 37 + wc : 39 + (wc - 2);
    else { NvGroup g; g.gain = nullptr; g.scale = 1.f; g.width = 0; g.type = 5; g.col = 0; g.col2 = 0; g.dkind = 0; g.dst = nullptr; g.ld = 0; g.idx = 0; return g; }
    return nv_group1(P, gi);
}
constexpr int NTILE_IN0 = 14, NTILE_IN1 = 12;


struct EpiIn {
    static constexpr bool PERM = true, AFTER_DRAIN = false;
    KArgs P; int layer;
    __device__ __forceinline__ void operator()(const pg8::f32x4 (&acc)[2][2][4][2], const pg8::Unit& u, int wr, int wc, int fr, int fq) const {
        const NvGroup g = fast_group(P, layer, u.pn, wc);
        if (g.type == 5) return;
        const float* SSQ = (const float*)(P.ws + WS_SSQ);
        const bool do_km = (layer == 0 && g.type == 2 && u.pn >= 8);
        float gn[16], km[16];
#pragma unroll
        for (int i = 0; i < 16; ++i) { gn[i] = 1.f; km[i] = 0.f; }
        if (g.type == 2) {
#pragma unroll
            for (int bj = 0; bj < 2; ++bj)
#pragma unroll
                for (int i = 0; i < 8; ++i) gn[8 * bj + i] = g.gain[32 * bj + 8 * fq + i] * g.scale;
        }
#pragma unroll
        for (int ai = 0; ai < 2; ++ai)
#pragma unroll
            for (int m = 0; m < 4; ++m) {
                const int t = u.pm * 256 + ai * 128 + wr * 64 + m * 16 + fr, b = t >> 11, s = t & 2047;
                const float4 qp = ((const float4*)(SSQ + (size_t)t * 16))[fq];
                float ssq = (qp.x + qp.y) + (qp.z + qp.w);
                ssq += __shfl_xor(ssq, 16); ssq += __shfl_xor(ssq, 32);
                const float rstd = __builtin_amdgcn_rsqf(ssq * (1.0f / DM) + EPSF);
                float v[16];
#pragma unroll
                for (int bj = 0; bj < 2; ++bj)
#pragma unroll
                    for (int n = 0; n < 2; ++n)
#pragma unroll
                        for (int r = 0; r < 4; ++r) v[8 * bj + 4 * n + r] = acc[ai][bj][m][n][r] * rstd;
                if (g.type == 4) {
                    pg8::u32x4 w;
                    float o[8];
#pragma unroll
                    for (int i = 0; i < 8; ++i) o[i] = v[i] * fast_sigmoid(v[8 + i]);
                    w.x = pg8::cvt_pk_bf16(o[0], o[1]); w.y = pg8::cvt_pk_bf16(o[2], o[3]); w.z = pg8::cvt_pk_bf16(o[4], o[5]); w.w = pg8::cvt_pk_bf16(o[6], o[7]);
                    *(pg8::u32x4*)((bf16_t*)g.dst + (size_t)t * 512 + g.col + 8 * fq) = w;
                    continue;
                }
                if (g.type == 3) {
                    if (fq < 3) {
                        float4 o0, o1;
                        o0.x = fast_sigmoid(v[0]); o0.y = fast_sigmoid(v[1]); o0.z = fast_sigmoid(v[2]); o0.w = fast_sigmoid(v[3]);
                        o1.x = fast_sigmoid(v[4]); o1.y = fast_sigmoid(v[5]); o1.z = fast_sigmoid(v[6]); o1.w = fast_sigmoid(v[7]);
                        float* gp = (float*)g.dst + (size_t)t * 32 + 8 * fq;
                        *(float4*)gp = o0; *(float4*)(gp + 4) = o1;
                    }
                    continue;
                }
                if (g.type == 1) {
#pragma unroll
                    for (int i = 0; i < 16; ++i) v[i] = fast_silu(v[i]);
                } else if (g.type == 2) {
                    float ss = 0.f;
#pragma unroll
                    for (int i = 0; i < 16; ++i) ss += v[i] * v[i];
                    ss += __shfl_xor(ss, 16); ss += __shfl_xor(ss, 32);
                    const float nrm = __builtin_amdgcn_rsqf(ss * (1.0f / 64) + EPSF);
#pragma unroll
                    for (int i = 0; i < 16; ++i) v[i] = v[i] * nrm * gn[i];
                    if (do_km) {
#pragma unroll
                        for (int i = 0; i < 16; ++i) km[i] += v[i];
                    }
                }
                bf16_t* dp = g.dkind == 0 ? (bf16_t*)g.dst + (size_t)t * g.ld + g.idx * 64 + 8 * fq
                                          : (bf16_t*)g.dst + ((size_t)(b * g.ld + g.idx) * SEQ + s) * 64 + 8 * fq;
                int bjstep = 32;
                if (g.dkind == 3) { dp = (bf16_t*)g.dst + (size_t)(b * g.ld + g.idx) * SEQ * 64 + (size_t)(s >> 6) * 4096 + fq * 512 + (s & 63) * 8; bjstep = 2048; }
                else if (g.dkind == 4) { dp = (bf16_t*)g.dst + (size_t)(b * g.ld + g.idx) * SEQ * 64 + (size_t)(s >> 6) * 4096 + (s & 63) * 32 + 8 * fq; bjstep = 2048; }
#pragma unroll
                for (int bj = 0; bj < 2; ++bj) {
                    pg8::u32x4 w;
                    w.x = pg8::cvt_pk_bf16(v[8 * bj + 0], v[8 * bj + 1]); w.y = pg8::cvt_pk_bf16(v[8 * bj + 2], v[8 * bj + 3]);
                    w.z = pg8::cvt_pk_bf16(v[8 * bj + 4], v[8 * bj + 5]); w.w = pg8::cvt_pk_bf16(v[8 * bj + 6], v[8 * bj + 7]);
                    *(pg8::u32x4*)(dp + bjstep * bj) = w;
                }
            }
        if (do_km) {
#pragma unroll
            for (int i = 0; i < 16; ++i) { float a = km[i]; a += __shfl_xor(a, 1); a += __shfl_xor(a, 2); a += __shfl_xor(a, 4); a += __shfl_xor(a, 8); km[i] = a * (1.0f / 256); }
            if (fr == 0) {
                float* kp = (float*)(P.ws + WS_KMP) + ((size_t)wr * 64 + u.pm) * 512 + g.idx * 64 + 8 * fq;
#pragma unroll
                for (int bj = 0; bj < 2; ++bj) {
                    float4 o0, o1; o0.x = km[8 * bj + 0]; o0.y = km[8 * bj + 1]; o0.z = km[8 * bj + 2]; o0.w = km[8 * bj + 3];
                    o1.x = km[8 * bj + 4]; o1.y = km[8 * bj + 5]; o1.z = km[8 * bj + 6]; o1.w = km[8 * bj + 7];
                    *(float4*)(kp + 32 * bj) = o0; *(float4*)(kp + 32 * bj + 4) = o1;
                }
            }
        }
    }
};

struct EpiOut {
    static constexpr bool PERM = true, AFTER_DRAIN = false;
    float* out; bf16_t* XB; float* SSQ; int layer;
    __device__ __forceinline__ void operator()(const pg8::f32x4 (&acc)[2][2][4][2], const pg8::Unit& u, int wr, int wc, int fr, int fq) const {
        const int col0 = u.pn * 256 + wc * 32 + 8 * fq;
#pragma unroll
        for (int ai = 0; ai < 2; ++ai)
#pragma unroll
            for (int m = 0; m < 4; ++m) {
                const int t = u.pm * 256 + ai * 128 + wr * 64 + m * 16 + fr;
                float ss = 0.f;
#pragma unroll
                for (int bj = 0; bj < 2; ++bj) {
                    const size_t o = (size_t)t * DM + col0 + 128 * bj;
                    const pg8::u32x4 rb = *(const pg8::u32x4*)(XB + o);
                    pg8::f32x4 x0, x1;
                    x0[0] = bf2f(rb.x & 0xffff) + acc[ai][bj][m][0][0]; x0[1] = bf2f(rb.x >> 16) + acc[ai][bj][m][0][1]; x0[2] = bf2f(rb.y & 0xffff) + acc[ai][bj][m][0][2]; x0[3] = bf2f(rb.y >> 16) + acc[ai][bj][m][0][3];
                    x1[0] = bf2f(rb.z & 0xffff) + acc[ai][bj][m][1][0]; x1[1] = bf2f(rb.z >> 16) + acc[ai][bj][m][1][1]; x1[2] = bf2f(rb.w & 0xffff) + acc[ai][bj][m][1][2]; x1[3] = bf2f(rb.w >> 16) + acc[ai][bj][m][1][3];
                    if (layer == 0) {
                        pg8::u32x4 w; w.x = pg8::cvt_pk_bf16(x0[0], x0[1]); w.y = pg8::cvt_pk_bf16(x0[2], x0[3]); w.z = pg8::cvt_pk_bf16(x1[0], x1[1]); w.w = pg8::cvt_pk_bf16(x1[2], x1[3]);
                        *(pg8::u32x4*)(XB + o) = w;
                        ss += (x0[0] * x0[0] + x0[1] * x0[1]) + (x0[2] * x0[2] + x0[3] * x0[3]) + (x1[0] * x1[0] + x1[1] * x1[1]) + (x1[2] * x1[2] + x1[3] * x1[3]);
                    } else { *(pg8::f32x4*)(out + o) = x0; *(pg8::f32x4*)(out + o + 4) = x1; }
                }
                if (layer == 0) { ss += __shfl_xor(ss, 16); ss += __shfl_xor(ss, 32); if (fq == 0) SSQ[(size_t)t * 16 + u.pn * 4 + wc] = ss; }
            }
    }
};

__device__ __forceinline__ void cvt_item(const float* __restrict__ W, int ldw, const float* __restrict__ gain, bf16_t* __restrict__ Bt, int Kd, int k0, int drow0, int src0, int vw, LAS float* scr, int lane) {
    {
        const int c = lane & 31, h = lane >> 5;
        if (vw == 32) {
            float v[32];
#pragma unroll
            for (int i = 0; i < 32; ++i) v[i] = W[(size_t)(k0 + 2 * i + h) * ldw + src0 + c];
            if (gain) {
#pragma unroll
                for (int i = 0; i < 32; ++i) v[i] *= gain[k0 + 2 * i + h];
            }
#pragma unroll
            for (int i = 0; i < 32; ++i) scr[(2 * i + h) * 33 + c] = v[i];
        } else {
            const int cc = c < vw ? c : (vw > 0 ? vw - 1 : 0);
#pragma unroll 8
            for (int i = 0; i < 32; ++i) { const int kk = 2 * i + h;
                float v = vw > 0 ? W[(size_t)(k0 + kk) * ldw + src0 + cc] : 0.f; if (gain) v *= gain[k0 + kk];
                scr[kk * 33 + c] = c < vw ? v : 0.f; }
        }
    }
    LDS_WAIT(); asm volatile("" ::: "memory");
    const int c = lane & 7;
#pragma unroll
    for (int j = 0; j < 4; ++j) { const int n = (lane >> 3) + 8 * j; const LAS float* s = scr + (8 * c) * 33 + n;
        v4u o; o.x = pk2(s[0 * 33], s[1 * 33]); o.y = pk2(s[2 * 33], s[3 * 33]); o.z = pk2(s[4 * 33], s[5 * 33]); o.w = pk2(s[6 * 33], s[7 * 33]);
        *(v4u*)(Bt + (size_t)(drow0 + n) * Kd + k0 + 8 * c) = o; }
    LDS_WAIT(); asm volatile("" ::: "memory");
}
__device__ __forceinline__ void cvt_in_item(const KArgs& P, int layer, int it, LAS float* scr, int lane) {
    const int kb = it & 15, blk = it >> 4, pn = blk >> 3, pb = blk & 7, wc = pb & 3, bj = pb >> 2;
    const NvGroup g = fast_group(P, layer, pn, wc);
    int src0 = 0, vw = 0;
    if (g.type == 4) { src0 = bj ? g.col2 : g.col; vw = 32; }
    else if (g.type != 5) { src0 = g.col + 32 * bj; vw = g.width - 32 * bj; vw = vw < 0 ? 0 : (vw > 32 ? 32 : vw); }
    const float* W = layer == 0 ? P.e_w_in : P.o_w_in; const int ldw = layer == 0 ? 3584 : 3096;
    bf16_t* Bt = (bf16_t*)(P.ws + (layer == 0 ? WS_WIN0 : WS_WIN1));
    cvt_item(W, ldw, P.norm_g + layer * DM, Bt, DM, 64 * kb, 256 * pn + 128 * bj + 32 * wc, src0, vw, scr, lane);
}
__device__ __forceinline__ void p0_deferred_item(const KArgs& P, int r, LAS float* scr, int lane) {
    constexpr int I_B1P = 128, I_WG = 16, I_IN1 = NTILE_IN1 * 8 * 16, I_OUT = 32 * 16, I_W1 = 128, I_W2 = 2 * 4;
    if (r < I_B1P) { fm::b1p_item(P, r, lane); return; } r -= I_B1P;
    if (r < I_WG) { cvt_item(P.o_w_in, 3096, P.norm_g + DM, (bf16_t*)(P.ws + WS_WGATE), DM, 64 * r, 0, 1280, 24, scr, lane); return; } r -= I_WG;
    if (r < 2 * I_W2) { const int kv = r / I_W2; r -= kv * I_W2; const int kb = r & 3, nb = r >> 2;
        cvt_item(kv == 0 ? P.c_k_w2 : P.c_v_w2, 64, nullptr, (bf16_t*)(P.ws + WS_CW2) + (size_t)kv * 64 * 256, 256, 64 * kb, 32 * nb, 32 * nb, 32, scr, lane); return; }
    r -= 2 * I_W2;
    if (r < 2 * I_W1) { fm::w1f_item(P, r, lane); return; } r -= 2 * I_W1;
    if (r < 2 * I_OUT) { const int l = r / I_OUT; r -= l * I_OUT; const int kb = r & 15, nb = r >> 4;
        cvt_item(P.w_out + (size_t)l * DM * DM, DM, nullptr, (bf16_t*)(P.ws + (l == 0 ? WS_WOUT0 : WS_WOUT1)), DM, 64 * kb, 32 * nb, 32 * nb, 32, scr, lane); return; }
    r -= 2 * I_OUT;
    cvt_in_item(P, 1, r, scr, lane);
}
constexpr int N_EARLY = 128 + 16 + 16;
constexpr int N_DEFERRED = 2 * 512 + NTILE_IN1 * 128 + 256 + 128 + 16 + 16;
constexpr int CW_WQD = 8192 + 2048;
__device__ __forceinline__ void p0_deferred(const KArgs& P, LAS unsigned char* lds, volatile LAS unsigned* MISC, int nwg, int G, int c, int tid, int wave, int lane) {
    const int maxu = (nwg + G - 1) / G, c0 = nwg - (maxu - 1) * G;
    if (c0 < G && c < c0) return;
    LAS float* scr = (LAS float*)(lds + wave * 16384);
    unsigned* ctr = (unsigned*)(P.ws + WS_CTL) + CW_WQD;
    for (;;) {
        __syncthreads();
        if (tid == 0) MISC[13] = __hip_atomic_fetch_add(ctr, 8u, __ATOMIC_RELAXED, __HIP_MEMORY_SCOPE_AGENT);
        __syncthreads();
        const int base = N_EARLY + (int)MISC[13];
        if (base >= N_DEFERRED) break;
        { const int r = base + wave; if (r < N_DEFERRED) p0_deferred_item(P, r, scr, lane); }
    }
}
__device__ __forceinline__ void p0_prologue(const KArgs& P, LAS unsigned char* lds, int vcu, int G, int wave, int lane) {
    LAS float* scr = (LAS float*)(lds + wave * 16384);
    const int gw = vcu * 8 + wave, NGW = G * 8;
    constexpr int I_IN0 = NTILE_IN0 * 8 * 16;
    for (int it = vcu + G * wave; it < N_EARLY + I_IN0; it += NGW) {
        if (it < N_EARLY) p0_deferred_item(P, it, scr, lane); else cvt_in_item(P, 0, it - N_EARLY, scr, lane);
    }
    bf16_t* XB = (bf16_t*)(P.ws + WS_XB); float* SSQ = (float*)(P.ws + WS_SSQ);
    const int rows_per_wave = (NT + NGW - 1) / NGW;
    for (int m0 = gw * rows_per_wave; m0 < (gw + 1) * rows_per_wave && m0 < NT; m0 += 4) {
        float4 v[4][4];
#pragma unroll
        for (int q = 0; q < 4; ++q) { const int m = m0 + q < NT ? m0 + q : NT - 1; const float4* r = (const float4*)(P.x + (size_t)m * DM) + 2 * lane;
            v[q][0] = r[0]; v[q][1] = r[1]; v[q][2] = r[128]; v[q][3] = r[129]; }
#pragma unroll
        for (int q = 0; q < 4; ++q) {
            const int m = m0 + q;
            float s = 0.f;
#pragma unroll
            for (int j = 0; j < 4; ++j) s += (v[q][j].x * v[q][j].x + v[q][j].y * v[q][j].y) + (v[q][j].z * v[q][j].z + v[q][j].w * v[q][j].w);
#pragma unroll
            for (int o = 1; o < 64; o <<= 1) s += __shfl_xor(s, o);
            if (m < NT && m < (gw + 1) * rows_per_wave) {
                uint4 o0, o1;
                o0.x = pg8::cvt_pk_bf16(v[q][0].x, v[q][0].y); o0.y = pg8::cvt_pk_bf16(v[q][0].z, v[q][0].w); o0.z = pg8::cvt_pk_bf16(v[q][1].x, v[q][1].y); o0.w = pg8::cvt_pk_bf16(v[q][1].z, v[q][1].w);
                o1.x = pg8::cvt_pk_bf16(v[q][2].x, v[q][2].y); o1.y = pg8::cvt_pk_bf16(v[q][2].z, v[q][2].w); o1.z = pg8::cvt_pk_bf16(v[q][3].x, v[q][3].y); o1.w = pg8::cvt_pk_bf16(v[q][3].z, v[q][3].w);
                *(uint4*)(XB + (size_t)m * DM + 8 * lane) = o0; *(uint4*)(XB + (size_t)m * DM + 512 + 8 * lane) = o1;
                if (lane < 4) { float4 z; z.x = lane == 0 ? s : 0.f; z.y = 0.f; z.z = 0.f; z.w = 0.f; *(float4*)(SSQ + (size_t)m * 16 + lane * 4) = z; }
            }
        }
    }
}

constexpr int CW_WQ2 = 8192, CW_WQ2C = 8192 + 512, CW_WQ6 = 8192 + 1024;
#define WQ_FIRST(ctrptr) unsigned* ctr_ = (ctrptr); \
        if (tid == 0) MISC[12] = __hip_atomic_fetch_add(ctr_, 1u, __ATOMIC_RELAXED, __HIP_MEMORY_SCOPE_AGENT); \
        __syncthreads(); \
        int it_ = (int)MISC[12];
#define WQ_WHILE(LIMIT, ...) while (it_ < (LIMIT)) { \
            unsigned nx_ = 0u; if (tid == 0) nx_ = __hip_atomic_fetch_add(ctr_, 1u, __ATOMIC_RELAXED, __HIP_MEMORY_SCOPE_AGENT);     \
            { const int it = it_; __VA_ARGS__ } \
            __syncthreads(); if (tid == 0) MISC[12] = nx_; __syncthreads(); it_ = (int)MISC[12]; \
        }
#define WQ_QUEUES(cwbase, QLEN, ...) do { const int xcc_ = (int)(xb_xcc_id() & 7u); unsigned* qb_ = (unsigned*)(P.ws + WS_CTL) + (cwbase); \
        for (int qi_ = 0; qi_ < 8; ++qi_) { const int q = (xcc_ + qi_) & 7; \
            if (qi_ == 1) { __syncthreads(); if (tid < 8) MISC[24 + tid] = __hip_atomic_load(qb_ + 64 * tid, __ATOMIC_RELAXED, __HIP_MEMORY_SCOPE_AGENT); __syncthreads(); } \
            if (qi_ >= 1 && MISC[24 + q] >= (unsigned)(QLEN)) continue; \
            WQ_FIRST(qb_ + 64 * q) __VA_ARGS__ } } while (0)

constexpr int RING_BYTES = 131072, LDSCTL_OFF = RING_BYTES, MISC_OFF = LDSCTL_OFF + 320, LDS_BYTES = 147456;
constexpr int CW_BAR = 4096;
constexpr int NPHASE = 8;

__global__ void __launch_bounds__(512, 2) mk_fwd(KArgs P) {
    extern __shared__ __attribute__((aligned(16))) unsigned char lds_raw[];
    LAS unsigned char* lds = (LAS unsigned char*)lds_raw;
    volatile LAS unsigned* MISC = (volatile LAS unsigned*)(lds + MISC_OFF);
    const int tid = threadIdx.x, lane = tid & 63, wave = __builtin_amdgcn_readfirstlane(tid >> 6);
    const int G = gridDim.x, bx = blockIdx.x, vcu = (G % 8 == 0) ? (bx % 8) * (G / 8) + bx / 8 : bx;
    for (int u = tid; u < (LDS_BYTES - LDSCTL_OFF) / 4; u += 512) ((LAS unsigned*)(lds + LDSCTL_OFF))[u] = 0u;
    __syncthreads();
#ifdef PROBE_A
#ifndef PROBE_BX
#define PROBE_BX 0
#endif
#define STAMP(n) do { if (bx == PROBE_BX && tid == 0) { MISC[40 + (n)] = (unsigned)__builtin_amdgcn_s_memrealtime(); MISC[80 + (n)] = (unsigned)__builtin_amdgcn_s_memtime(); } } while (0)
#else
#define STAMP(n) do {} while (0)
#endif
    {
        if (lane == 0) MISC[100 + wave] = ((unsigned)__builtin_amdgcn_s_getreg(63492) >> 4) & 3u;
        __syncthreads();
        unsigned role = 0;
        for (int w = 0; w < 8; ++w) if (w < wave && MISC[100 + w] == MISC[100 + wave]) role = 1;
        if (lane == 0) MISC[110 + wave] = role;
        __syncthreads();
    }
    const int lo = P.ph_lo, hi = P.ph_hi;
    STAMP(0);
    XcdBarrier bar; bar.bar = (unsigned*)(P.ws + WS_CTL) + CW_BAR; bar.x = 0; bar.st = nullptr;
    if (hi - lo > 1) bar = xcd_barrier_post((unsigned*)(P.ws + WS_CTL) + CW_BAR, MISC + 8);
#define IN(k) (lo <= (k) && (k) < hi)
#define SEAM(k) do { STAMP(2 * (k) + 1); if (IN(k) && IN((k) + 1)) xcd_barrier(bar); STAMP(2 * (k) + 2); } while (0)

    if (IN(0)) {
        p0_prologue(P, lds, vcu, G, wave, lane); SEAM(0);
    }
    if (IN(1)) {
        pg8::Gemm g{(const bf16_t*)(P.ws + WS_XB), (const bf16_t*)(P.ws + WS_WIN0), NT, NTILE_IN0 * 256, DM}; pg8::StaticOrder S; S.init(NT, NTILE_IN0 * 256, G, bx);
        EpiIn E{P, 0};
        pg8::gemm_phase<EpiIn, pg8::StaticOrder, true, true>(lds, g, S, E);
        p0_deferred(P, lds, MISC, (NT / 256) * NTILE_IN0, G, bx, tid, wave, lane);
        SEAM(1);
    }
    if (IN(2)) {
        for (int k = vcu; k < 512; k += G) { const int kk = k < 256 ? k : k - 256, bh = kk >> 2, own = k < 256 ? 7 - (kk & 3) : (kk & 3);
            fa::moba_unit(P, (fa::lds_ptr)lds, bh >> 3, bh & 7, own, wave, lane); }
        STAMP(20);
        {
            fm::ConvW cw; fm::conv_load_w(P, cw, tid, lane);
            WQ_QUEUES(CW_WQ2C, 64, WQ_WHILE(64, fm::conv_unit(P, lds, 64 * q + it, cw, tid, wave, lane);));
        }
        SEAM(2);
    }
    if (IN(3)) {
        pg8::Gemm g{(const bf16_t*)(P.ws + WS_Y), (const bf16_t*)(P.ws + WS_WOUT0), NT, DM, DM}; pg8::StaticOrder S; S.init(NT, DM, G, bx);
        EpiOut E{P.out, (bf16_t*)(P.ws + WS_XB), (float*)(P.ws + WS_SSQ), 0};
        pg8::gemm_phase<EpiOut, pg8::StaticOrder, true, true>(lds, g, S, E);
        SEAM(3);
    }
    if (IN(4)) {
        pg8::Gemm g{(const bf16_t*)(P.ws + WS_XB), (const bf16_t*)(P.ws + WS_WIN1), NT, NTILE_IN1 * 256, DM}; pg8::StaticOrder S; S.init(NT, NTILE_IN1 * 256, G, bx);
        EpiIn E{P, 1};
        pg8::gemm_phase<EpiIn, pg8::StaticOrder, true, true>(lds, g, S, E);
        SEAM(4);
    }
    if (IN(5)) {
        for (int k = vcu; k < 256; k += G) fm::gate_unit(P, lds, k, tid, wave, lane);
        STAMP(21);
        if (P.flags & 16) for (int k = vcu; k < 256; k += G) fm::cmp_unit(P, lds, k, tid, wave, lane);
        SEAM(5);
    }
    if (IN(6)) {
        for (int k = vcu; k < 512; k += G) { const int kk = k < 256 ? k : k - 256, bg = kk >> 4, c = k < 256 ? 31 - (kk & 15) : (kk & 15);
            fa::nsa_unit(P, (fa::lds_ptr)lds, bg >> 1, bg & 1, c, wave, lane, tid); }
        STAMP(22);
        WQ_QUEUES(CW_WQ6, 64, WQ_WHILE(64, fa::swa_unit(P, (fa::lds_ptr)lds, q, it & 1, 31 - (it >> 1), wave, lane);));
        SEAM(6);
    }
    if (IN(7)) {
        pg8::Gemm g{(const bf16_t*)(P.ws + WS_Y), (const bf16_t*)(P.ws + WS_WOUT1), NT, DM, DM}; pg8::StaticOrder S; S.init(NT, DM, G, bx);
        EpiOut E{P.out, (bf16_t*)(P.ws + WS_XB), nullptr, 1};
        pg8::gemm_phase<EpiOut, pg8::StaticOrder, true, true>(lds, g, S, E);
    }
#ifdef PROBE_A
    if (bx == PROBE_BX && tid == 0) {
#ifdef PROBE_CLK
        const unsigned dt = (unsigned)(1000.f * (float)(MISC[80 + PROBE_B] - MISC[80 + PROBE_A]) / (float)(MISC[40 + PROBE_B] - MISC[40 + PROBE_A])), t0 = (unsigned)__builtin_amdgcn_s_memrealtime();
#else
        const unsigned dt = (MISC[40 + PROBE_B] - MISC[40 + PROBE_A]) * 8u, t0 = (unsigned)__builtin_amdgcn_s_memrealtime();
#endif
        while ((unsigned)__builtin_amdgcn_s_memrealtime() - t0 < dt) __builtin_amdgcn_s_sleep(8);
    }
#endif
#undef IN
#undef SEAM
}
static void fill_args(KArgs& a, void* const* d_in, void* d_out, void* d_ws) {
    const float** p = (const float**)&a;
    for (int i = 0; i < 28; ++i) p[i] = (const float*)d_in[i];
    a.out = (float*)d_out; a.ws = (unsigned char*)d_ws; a.ph_lo = 0; a.ph_hi = NPHASE; a.flags = 31; a.pad = 0;
}
static int g_grid = 0;
extern "C" void kernel_launch(void* const* d_in, const int* in_sizes, int n_in, void* d_out, int out_size, void* d_ws, size_t ws_size, hipStream_t stream) {
    if (n_in != 28 || out_size != NT * DM || ws_size < WS_END) { fprintf(stderr, "kernel_launch: unexpected shapes n_in %d out %d ws %zu\n", n_in, out_size, ws_size); return; }
    if (g_grid == 0) {
        int dev = 0, cus = 0;
        if (hipGetDevice(&dev) != hipSuccess || hipDeviceGetAttribute(&cus, hipDeviceAttributeMultiprocessorCount, dev) != hipSuccess) { fprintf(stderr, "kernel_launch: device query failed\n"); g_grid = -1; return; }
        if (hipFuncSetAttribute((const void*)mk_fwd, hipFuncAttributeMaxDynamicSharedMemorySize, LDS_BYTES) != hipSuccess) { fprintf(stderr, "kernel_launch: hipFuncSetAttribute failed\n"); g_grid = -1; return; }
        int per_cu = 0;
        if (hipOccupancyMaxActiveBlocksPerMultiprocessor(&per_cu, (const void*)mk_fwd, 512, LDS_BYTES) != hipSuccess || per_cu < 1) { fprintf(stderr, "kernel_launch: occupancy query says %d blocks/CU\n", per_cu); }
        (void)hipGetLastError();
        g_grid = cus;
    }
    if (g_grid < 0) return;
    KArgs a{}; fill_args(a, d_in, d_out, d_ws);
    (void)hipMemsetAsync((char*)d_ws + WS_CTL, 0, 64 * 1024, stream);
    hipLaunchKernelGGL(mk_fwd, dim3(g_grid), dim3(512), LDS_BYTES, stream, a);
}
```
